# Optimizing an MI355X kernel written in HIP

```python
import jax, jax.numpy as jnp
from jax import lax
import numpy as np

D_MODEL = 1024
BATCH = 8
SEQ = 2048
DEPTH = 4

HEAD_DIM = 64
CONV_HEADS = 4
ATTN_HEADS = 8
SGU_HEADS = 4
CONV_W = CONV_HEADS * HEAD_DIM
ATTN_W = ATTN_HEADS * HEAD_DIM
SGU_W = SGU_HEADS * HEAD_DIM
D_MIX = CONV_W + ATTN_W + SGU_W
D_IN_PROJ = 3 * CONV_W + 3 * ATTN_W + 2 * SGU_W
CONV_WIDTH = 3
Q_BLOCK = 128
CHUNK = 128
D_FF = 4 * D_MODEL
PLE_DIM = 256
EPS = 1e-6

kernel_name = "hybrid_conv_stickbreak_sgu_block"


def rms_norm(x, g):
    xf = x.astype(jnp.float32)
    y = xf * lax.rsqrt(jnp.mean(xf * xf, axis=-1, keepdims=True) + EPS)
    return (y * g.astype(jnp.float32)).astype(x.dtype)


def short_conv(x, w):
    s = x.shape[1]
    xp = jnp.pad(x, ((0, 0), (CONV_WIDTH - 1, 0), (0, 0)))
    out = w[0] * xp[:, 0:s]
    for j in range(1, CONV_WIDTH):
        out = out + w[j] * xp[:, j:j + s]
    return out


def stick_breaking_attention(q, k, v):
    s_len = q.shape[1]
    scale = HEAD_DIM ** -0.5
    outs = []
    for qb in range(s_len // Q_BLOCK):
        start = qb * Q_BLOCK
        end = start + Q_BLOCK
        qi = q[:, start:end].astype(jnp.float32)
        kj = k[:, :end].astype(jnp.float32)
        vj = v[:, :end].astype(jnp.float32)
        z = jnp.einsum('bqhd,bkhd->bhqk', qi, kj) * scale
        t_pos = start + jnp.arange(Q_BLOCK)[:, None]
        s_pos = jnp.arange(end)[None, :]
        causal = s_pos < t_pos
        log_beta = jax.nn.log_sigmoid(z)
        log_rem = jnp.where(causal, jax.nn.log_sigmoid(-z), 0.0)
        suffix = lax.cumsum(log_rem, axis=3, reverse=True) - log_rem
        weights = jnp.where(causal, jnp.exp(log_beta + suffix), 0.0)
        o = jnp.einsum('bhqk,bkhd->bqhd', weights, vj)
        outs.append(o.astype(v.dtype))
    return jnp.concatenate(outs, axis=1)


def spatial_gating(u, v, g_v, w_s, b_s):
    bsz, s_len, _ = u.shape
    v = v.reshape(bsz, s_len, SGU_HEADS, HEAD_DIM)
    v = rms_norm(v, g_v.reshape(SGU_HEADS, HEAD_DIM))
    v = v.reshape(bsz, s_len // CHUNK, CHUNK, SGU_HEADS, HEAD_DIM)
    mask = jnp.tril(jnp.ones((CHUNK, CHUNK), dtype=w_s.dtype))
    w = w_s * mask
    sv = jnp.einsum('gts,bcsge->bctge', w, v) + b_s.T[:, :, None]
    return u * sv.reshape(bsz, s_len, SGU_W)


def setup_inputs(seed: int = 0) -> dict:
    key = jax.random.key(seed)
    ks = jax.random.split(key, 17)

    def nrm(k, shape, scale):
        return jax.random.normal(k, shape, jnp.float32) * scale

    def gain(k, shape):
        return 1.0 + 0.05 * jax.random.normal(k, shape, jnp.float32)

    return {
        "x": nrm(ks[0], (BATCH, SEQ, D_MODEL), 1.0),
        "p": nrm(ks[1], (DEPTH, BATCH, SEQ, PLE_DIM), 1.0),
        "norm1_g": gain(ks[2], (DEPTH, D_MODEL)),
        "w_in": nrm(ks[3], (DEPTH, D_MODEL, D_IN_PROJ), D_MODEL ** -0.5),
        "conv_w": nrm(ks[4], (DEPTH, CONV_WIDTH, CONV_W), CONV_WIDTH ** -0.5),
        "q_norm_g": gain(ks[5], (DEPTH, HEAD_DIM)),
        "k_norm_g": gain(ks[6], (DEPTH, HEAD_DIM)),
        "sgu_norm_g": gain(ks[7], (DEPTH, SGU_W)),
        "sgu_w": nrm(ks[8], (DEPTH, SGU_HEADS, CHUNK, CHUNK), CHUNK ** -0.5),
        "sgu_b": gain(ks[9], (DEPTH, SGU_HEADS, CHUNK)),
        "w_out": nrm(ks[10], (DEPTH, D_MIX, D_MODEL), D_MIX ** -0.5),
        "norm2_g": gain(ks[11], (DEPTH, D_MODEL)),
        "w_ff1": nrm(ks[12], (DEPTH, D_MODEL, D_FF), D_MODEL ** -0.5),
        "w_ff2": nrm(ks[13], (DEPTH, D_FF, D_MODEL), D_FF ** -0.5),
        "norm3_g": gain(ks[14], (DEPTH, D_MODEL)),
        "w_ple_gate": nrm(ks[15], (DEPTH, D_MODEL, D_MODEL), D_MODEL ** -0.5),
        "w_ple_proj": nrm(ks[16], (DEPTH, PLE_DIM, D_MODEL), PLE_DIM ** -0.5),
    }


def reference(x, p, norm1_g, w_in, conv_w, q_norm_g, k_norm_g, sgu_norm_g, sgu_w, sgu_b,
              w_out, norm2_g, w_ff1, w_ff2, norm3_g, w_ple_gate, w_ple_proj):
    bsz, s_len, _ = x.shape
    split_idx = list(np.cumsum([CONV_W, CONV_W, CONV_W, ATTN_W, ATTN_W, ATTN_W, SGU_W]))
    h = x
    for i in range(DEPTH):
        hn = rms_norm(h, norm1_g[i])
        proj = hn @ w_in[i]
        a_b, a_c, a_h, q, k, v, c_u, c_v = jnp.split(proj, split_idx, axis=-1)
        y_a = a_b * short_conv(a_c * a_h, conv_w[i])
        q = rms_norm(q.reshape(bsz, s_len, ATTN_HEADS, HEAD_DIM), q_norm_g[i])
        k = rms_norm(k.reshape(bsz, s_len, ATTN_HEADS, HEAD_DIM), k_norm_g[i])
        v = v.reshape(bsz, s_len, ATTN_HEADS, HEAD_DIM)
        y_b = stick_breaking_attention(q, k, v).reshape(bsz, s_len, ATTN_W)
        y_c = spatial_gating(jax.nn.gelu(c_u, approximate=False),
                             jax.nn.gelu(c_v, approximate=False),
                             sgu_norm_g[i], sgu_w[i], sgu_b[i])
        h = h + jnp.concatenate([y_a, y_b, y_c], axis=-1) @ w_out[i]
        f = jnp.square(jax.nn.relu(rms_norm(h, norm2_g[i]) @ w_ff1[i]))
        h = h + f @ w_ff2[i]
        gate = jax.nn.sigmoid(rms_norm(h, norm3_g[i]) @ w_ple_gate[i])
        h = h + gate * (p[i] @ w_ple_proj[i])
    return h
```

```cpp
#include <hip/hip_runtime.h>
#include <hip/hip_cooperative_groups.h>
#include <cstdio>
#include <cstdint>
namespace cg = cooperative_groups;
namespace pg8 {
#define PG8_LAS __attribute__((address_space(3)))
typedef unsigned short bf16_t;
typedef short bf16x8 __attribute__((ext_vector_type(8)));
typedef float f32x4 __attribute__((ext_vector_type(4)));
typedef unsigned u32x4 __attribute__((ext_vector_type(4)));
constexpr int BM = 256, BK = 64, HALF = 128, HTB = HALF * BK * 2  , STAGE_BYTES = 8 * HTB, NXCD = 8, WGM = 8;

__host__ __device__ __forceinline__ int lds_byte(int r, int c) { const int st = (r >> 4) * 2 + (c >> 5), rr = r & 15, cc = c & 31, ob = rr * 64 + cc * 2; return st * 1024 + (ob ^ (((ob >> 9) & 1) << 5)); }
__host__ __device__ __forceinline__ void stage_rc(int b, int& R, int& C) { const int st = b / 1024, sb = b % 1024, swz = sb ^ (((sb >> 9) & 1) << 5); R = (st >> 1) * 16 + swz / 64; C = (st & 1) * 32 + (swz % 64) / 2; }
__host__ __device__ __forceinline__ int perm32(int rho) { const int n = rho >> 4, i = rho & 15; return 8 * (i >> 2) + 4 * n + (i & 3); }

struct Unit { int pm, pn; };
struct Gemm { const bf16_t* A; const bf16_t* Bt; int M, N, K; };

struct StaticOrder {
    int nM, nN, nwg, G, c;
    __host__ __device__ void init(int M, int N, int G_, int c_) { nM = M / BM; nN = N / BM; nwg = nM * nN; G = G_; c = c_; }
    __host__ __device__ bool next(int i, Unit& u) const {
        const long L = (long)i * G + c; if (L >= nwg) return false;
        int wgid = (int)L; { const int q = nwg / NXCD, r = nwg % NXCD, xcd = wgid % NXCD, off = wgid / NXCD; wgid = (xcd < r ? xcd * (q + 1) : r * (q + 1) + (xcd - r) * q) + off; }
        const int nig = WGM * nN, gid = wgid / nig, fm = gid * WGM, gsz = (nM - fm) < WGM ? (nM - fm) : WGM;
        u.pm = fm + ((wgid % nig) % gsz); u.pn = (wgid % nig) / gsz; return true;
    }
    __device__ __forceinline__ void a_ready(const Unit&) const {}
    __device__ __forceinline__ void done(const Unit&) const {}
};

__device__ __forceinline__ unsigned cvt_pk_bf16(float lo, float hi) { unsigned r; asm volatile("v_cvt_pk_bf16_f32 %0, %1, %2" : "=v"(r) : "v"(lo), "v"(hi)); return r; }
typedef float f32x2 __attribute__((ext_vector_type(2)));
__device__ __forceinline__ f32x2 gelu_pk(f32x2 v) {
    const f32x2 av = __builtin_elementwise_abs(v), d = av * 0.2316418882f + 1.0f;
    f32x2 t; t.x = __builtin_amdgcn_rcpf(d.x); t.y = __builtin_amdgcn_rcpf(d.y);
    f32x2 q = t * 0.5307027145f + (-0.7265760135f); q = q * t + 0.7107068705f; q = q * t + (-0.142248368f); q = q * t + 0.127414796f; q = q * t;
    const f32x2 s = (v * v) * (-0.72134752044f);
    f32x2 e; e.x = __builtin_amdgcn_exp2f(s.x); e.y = __builtin_amdgcn_exp2f(s.y);
    const f32x2 m = v * (q * e), r = v - m;
    f32x2 o; o.x = v.x < 0.f ? m.x : r.x; o.y = v.y < 0.f ? m.y : r.y; return o;
}

template <int ACT  > struct EpiBf16 {
    static constexpr bool PERM = true, AFTER_DRAIN = false; static_assert(ACT == 0 || ACT == 1, "EpiBf16: ACT is 0 (none) or 1 (gelu_pk)");
    bf16_t* O; int ldc; const float* bias; int split_cols; size_t split_stride; float scale0;
    __device__ __forceinline__ void operator()(const f32x4 (&acc)[2][2][4][2], const Unit& u, int wr, int wc, int fr, int fq) const {
        const int row0 = u.pm * BM + wr * 64 + fr; int colt = u.pn * BM; bf16_t* base = O;
        float sc = 1.f; if (split_cols) { const int t = colt / split_cols; base += (size_t)t * split_stride; colt -= t * split_cols; if (t == 0) sc = scale0; }
        const int col0 = colt + wc * 32 + 8 * fq, bcol0 = u.pn * BM + wc * 32 + 8 * fq;
        f32x4 bv[2][2];
#pragma unroll
        for (int bj = 0; bj < 2; ++bj)
#pragma unroll
            for (int n = 0; n < 2; ++n) bv[bj][n] = bias ? *(const f32x4*)(bias + bcol0 + bj * HALF + 4 * n) : (f32x4){0.f, 0.f, 0.f, 0.f};
#pragma unroll
        for (int ai = 0; ai < 2; ++ai)
#pragma unroll
            for (int m = 0; m < 4; ++m) { bf16_t* rowp = base + (size_t)(row0 + ai * HALF + m * 16) * ldc + col0;
#pragma unroll
                for (int bj = 0; bj < 2; ++bj) { f32x4 v0 = acc[ai][bj][m][0] + bv[bj][0], v1 = acc[ai][bj][m][1] + bv[bj][1];
                    if (ACT == 1) { f32x2 a = gelu_pk((f32x2){v0[0], v0[1]}), b = gelu_pk((f32x2){v0[2], v0[3]}), c = gelu_pk((f32x2){v1[0], v1[1]}), d = gelu_pk((f32x2){v1[2], v1[3]});
                        v0 = (f32x4){a.x, a.y, b.x, b.y}; v1 = (f32x4){c.x, c.y, d.x, d.y}; }
                    v0 = v0 * sc; v1 = v1 * sc; u32x4 w; w.x = cvt_pk_bf16(v0[0], v0[1]); w.y = cvt_pk_bf16(v0[2], v0[3]); w.z = cvt_pk_bf16(v1[0], v1[1]); w.w = cvt_pk_bf16(v1[2], v1[3]);
                    *(u32x4*)(rowp + bj * HALF) = w; } }
    }
};
template <class Epi, class Sched, bool ALIGN_EPI = false, bool SP2 = false>
__device__ __forceinline__ void gemm_phase(PG8_LAS unsigned char* lds, const Gemm g, const Sched& S, const Epi& E) {
    int tid_ = threadIdx.x; asm volatile("" : "+v"(tid_));
    const int tid = tid_, wid = __builtin_amdgcn_readfirstlane(tid >> 6), lane = tid & 63, wr = wid >> 2, wc = wid & 3, fr = lane & 15, fq = lane >> 4;
    const int K = g.K, nt = K / BK;
    unsigned voffA[2], voffB[2];
#pragma unroll
    for (int i = 0; i < 2; ++i) { int R, C; stage_rc(tid * 16 + i * 8192, R, C); const int Rb = Epi::PERM ? ((R & ~31) + perm32(R & 31)) : R;
        voffA[i] = (unsigned)(R * K + C) * 2u; voffB[i] = (unsigned)(Rb * K + C) * 2u; }
    const size_t kstep = (size_t)(BK * 2);
    const size_t hstep = (size_t)HALF * K * 2;
    const size_t tstep = 2 * hstep;
    const unsigned ldsw = (unsigned)wid * 1024u;
    const int aoff = lds_byte(wr * 64 + fr, fq * 8), boff = lds_byte(wc * 32 + fr, fq * 8);
#define PG8_SA(b, h) (((b) * 2 + (h)) * HTB)
#define PG8_SB(b, h) ((4 + (b) * 2 + (h)) * HTB)
#define PG8_STAGE(bufoff, gbase, voff) do { _Pragma("unroll") for (int _i = 0; _i < 2; ++_i) \
        __builtin_amdgcn_global_load_lds((const unsigned*)((const char*)(gbase) + (voff)[_i]), (PG8_LAS unsigned*)(lds + (bufoff) + ldsw + _i * 8192), 16, 0, 0); } while (0)
#define PG8_LDA(dst, b, h) do { _Pragma("unroll") for (int m = 0; m < 4; ++m) _Pragma("unroll") for (int k = 0; k < 2; ++k) dst[m][k] = *(const PG8_LAS bf16x8*)(lds + PG8_SA(b, h) + aoff + m * 2048 + k * 1024); } while (0)
#define PG8_LDB(dst, b, h) do { _Pragma("unroll") for (int n = 0; n < 2; ++n) _Pragma("unroll") for (int k = 0; k < 2; ++k) dst[n][k] = *(const PG8_LAS bf16x8*)(lds + PG8_SB(b, h) + boff + n * 2048 + k * 1024); } while (0)
#define PG8_MMA(ai, bj, At, Bt) do { __builtin_amdgcn_s_setprio(1); _Pragma("unroll") for (int m = 0; m < 4; ++m) _Pragma("unroll") for (int n = 0; n < 2; ++n) _Pragma("unroll") for (int k = 0; k < 2; ++k) \
        acc[ai][bj][m][n] = __builtin_amdgcn_mfma_f32_16x16x32_bf16(Bt[n][k], At[m][k], acc[ai][bj][m][n], 0, 0, 0); __builtin_amdgcn_s_setprio(0); } while (0)
#define PG8_WAIT_V(n) asm volatile("s_waitcnt vmcnt(" #n ")" ::: "memory")
#define PG8_WAIT_L(n) asm volatile("s_waitcnt lgkmcnt(" #n ")" ::: "memory")
#define PG8_BAR __builtin_amdgcn_s_barrier()
#define PG8_SCHED __builtin_amdgcn_sched_barrier(0)
    Unit cur, nxt; int ui = 0;
    if (!S.next(0, cur)) return;
    f32x4 acc[2][2][4][2];
#pragma unroll
    for (int a = 0; a < 2; ++a)
#pragma unroll
        for (int b = 0; b < 2; ++b)
#pragma unroll
            for (int m = 0; m < 4; ++m)
#pragma unroll
                for (int n = 0; n < 2; ++n) acc[a][b][m][n] = (f32x4){0.f, 0.f, 0.f, 0.f};
    bf16x8 At[4][2], B0[2][2], B1[2][2];
    const char* cA = (const char*)g.A + (size_t)cur.pm * tstep; const char* cB = (const char*)g.Bt + (size_t)cur.pn * tstep;
    S.a_ready(cur);
    if constexpr (SP2) {
        PG8_STAGE(PG8_SB(0, 0), cB, voffB); PG8_STAGE(PG8_SB(0, 1), cB + hstep, voffB); PG8_STAGE(PG8_SA(0, 0), cA, voffA); PG8_STAGE(PG8_SA(0, 1), cA + hstep, voffA);
        if (wr == 1) PG8_BAR;
        PG8_WAIT_V(2); PG8_BAR;
        PG8_STAGE(PG8_SB(1, 0), cB + kstep, voffB); PG8_STAGE(PG8_SA(1, 0), cA + kstep, voffA); PG8_STAGE(PG8_SB(1, 1), cB + hstep + kstep, voffB);
        PG8_WAIT_V(6); PG8_BAR;
    } else {
        PG8_STAGE(PG8_SB(0, 0), cB, voffB); PG8_STAGE(PG8_SA(0, 0), cA, voffA); PG8_STAGE(PG8_SB(0, 1), cB + hstep, voffB); PG8_STAGE(PG8_SA(0, 1), cA + hstep, voffA);
        if (wr == 1) PG8_BAR;
        PG8_WAIT_V(4); PG8_BAR;
        PG8_STAGE(PG8_SB(1, 0), cB + kstep, voffB); PG8_STAGE(PG8_SA(1, 0), cA + kstep, voffA); PG8_STAGE(PG8_SB(1, 1), cB + hstep + kstep, voffB);
        PG8_WAIT_V(6); PG8_BAR;
    }
    for (;;) {
        const bool has_next = S.next(ui + 1, nxt);
        const char* nA = has_next ? (const char*)g.A + (size_t)nxt.pm * tstep : cA; const char* nB = has_next ? (const char*)g.Bt + (size_t)nxt.pn * tstep : cB;
        for (int t = 0; t < nt; t += 2) {
            const bool last = (t == nt - 2);
            const char* a1 = cA + (size_t)(t + 1) * kstep;
            const char* a2 = last ? nA : cA + (size_t)(t + 2) * kstep; const char* b2 = last ? nB : cB + (size_t)(t + 2) * kstep;
            const char* a3 = a2 + kstep; const char* b3 = b2 + kstep;
            if (last && has_next) S.a_ready(nxt);
            if constexpr (SP2) {
            PG8_LDB(B0, 0, 0); PG8_LDB(B1, 0, 1); PG8_SCHED; PG8_LDA(At, 0, 0); PG8_STAGE(PG8_SA(1, 1), a1 + hstep, voffA);
            PG8_WAIT_V(8); PG8_WAIT_L(0); PG8_BAR; PG8_MMA(0, 0, At, B0); PG8_MMA(0, 1, At, B1); PG8_BAR; PG8_SCHED;
            PG8_LDA(At, 0, 1); PG8_STAGE(PG8_SB(0, 0), b2, voffB); PG8_STAGE(PG8_SB(0, 1), b2 + hstep, voffB); PG8_STAGE(PG8_SA(0, 0), a2, voffA);
            PG8_WAIT_V(8); PG8_WAIT_L(0); PG8_BAR; PG8_MMA(1, 0, At, B0); PG8_MMA(1, 1, At, B1); PG8_BAR; PG8_SCHED;
            PG8_LDB(B0, 1, 0); PG8_LDB(B1, 1, 1); PG8_SCHED; PG8_LDA(At, 1, 0); PG8_STAGE(PG8_SA(0, 1), a2 + hstep, voffA);
            PG8_WAIT_V(8); PG8_WAIT_L(0); PG8_BAR; PG8_MMA(0, 0, At, B0); PG8_MMA(0, 1, At, B1); PG8_BAR; PG8_SCHED;
            PG8_LDA(At, 1, 1); PG8_STAGE(PG8_SB(1, 0), b3, voffB); PG8_STAGE(PG8_SB(1, 1), b3 + hstep, voffB); PG8_STAGE(PG8_SA(1, 0), a3, voffA);
            PG8_WAIT_V(8); PG8_WAIT_L(0); PG8_BAR; PG8_MMA(1, 0, At, B0); PG8_MMA(1, 1, At, B1); PG8_BAR; PG8_SCHED;
            } else {
            PG8_LDB(B0, 0, 0); PG8_SCHED; PG8_LDA(At, 0, 0); PG8_STAGE(PG8_SA(1, 1), a1 + hstep, voffA);
            PG8_WAIT_L(8); PG8_BAR; PG8_WAIT_L(0); PG8_MMA(0, 0, At, B0); PG8_BAR; PG8_SCHED;
            PG8_LDB(B1, 0, 1); PG8_STAGE(PG8_SB(0, 0), b2, voffB);
            PG8_BAR; PG8_WAIT_L(0); PG8_MMA(0, 1, At, B1); PG8_BAR;
            PG8_LDA(At, 0, 1); PG8_STAGE(PG8_SA(0, 0), a2, voffA);
            PG8_BAR; PG8_WAIT_L(0); PG8_MMA(1, 0, At, B0); PG8_BAR; PG8_SCHED;
            PG8_STAGE(PG8_SB(0, 1), b2 + hstep, voffB);
            PG8_WAIT_V(6); PG8_BAR; PG8_MMA(1, 1, At, B1); PG8_BAR;
            PG8_LDB(B0, 1, 0); PG8_SCHED; PG8_LDA(At, 1, 0); PG8_STAGE(PG8_SA(0, 1), a2 + hstep, voffA);
            PG8_WAIT_L(8); PG8_BAR; PG8_WAIT_L(0); PG8_MMA(0, 0, At, B0); PG8_BAR; PG8_SCHED;
            PG8_LDB(B1, 1, 1); PG8_STAGE(PG8_SB(1, 0), b3, voffB);
            PG8_BAR; PG8_WAIT_L(0); PG8_MMA(0, 1, At, B1); PG8_BAR;
            PG8_LDA(At, 1, 1); PG8_STAGE(PG8_SA(1, 0), a3, voffA);
            PG8_BAR; PG8_WAIT_L(0); PG8_MMA(1, 0, At, B0); PG8_BAR; PG8_SCHED;
            PG8_STAGE(PG8_SB(1, 1), b3 + hstep, voffB);
            PG8_WAIT_V(6); PG8_BAR; PG8_MMA(1, 1, At, B1); PG8_BAR;
            }
        }
        if constexpr (ALIGN_EPI) { if (wr == 0) PG8_BAR; }
        if constexpr (!Epi::AFTER_DRAIN) { E(acc, cur, wr, wc, fr, fq); S.done(cur); }
        if (!has_next) break;
#pragma unroll
        for (int a = 0; a < 2; ++a)
#pragma unroll
            for (int b = 0; b < 2; ++b)
#pragma unroll
                for (int m = 0; m < 4; ++m)
#pragma unroll
                    for (int n = 0; n < 2; ++n) acc[a][b][m][n] = (f32x4){0.f, 0.f, 0.f, 0.f};
        cur = nxt; cA = nA; cB = nB; ++ui;
        if constexpr (ALIGN_EPI) { if (wr == 1) PG8_BAR; }
    }
    PG8_WAIT_V(0);
    if constexpr (!ALIGN_EPI) { if (wr == 0) PG8_BAR; }
    PG8_BAR;
    if constexpr (Epi::AFTER_DRAIN) { E.fused(acc, cur, wr, wc, fr, fq, lds, wid, lane); S.done(cur); }
#undef PG8_SA
#undef PG8_SB
#undef PG8_STAGE
#undef PG8_LDA
#undef PG8_LDB
#undef PG8_MMA
#undef PG8_WAIT_V
#undef PG8_WAIT_L
#undef PG8_BAR
#undef PG8_SCHED
}
}

#ifndef MK_N_LAUNCHES
#define MK_N_LAUNCHES 1
#endif
#ifndef ATT_EARLY_EXIT
#define ATT_EARLY_EXIT 1
#endif
constexpr int NWAVES = 8;
constexpr int M = 16384, DM = 1024, SEQ = 2048, DEPTH = 4, NIN = 2816, DFF = 4096, PLE = 256;
constexpr float EPS = 1e-6f;
constexpr float C2 = 0.125f * 1.4426950408889634f;
constexpr int NPHASE = 1 + 6 * DEPTH;
#ifndef PROBE_B
#define PROBE_B 1
#endif
#ifndef PROBE_SYNC
#define PROBE_SYNC 1
#endif
#ifndef PROBE_P
#define PROBE_P 1
#endif
#ifndef PROBE_A
#define PROBE_A 1
#endif
#ifndef PROBE_D
#define PROBE_D 1
#endif

typedef unsigned short bf16;
#define LAS __attribute__((address_space(3)))
typedef unsigned v4u __attribute__((ext_vector_type(4)));
typedef unsigned v2u __attribute__((ext_vector_type(2)));
typedef float f32x4 __attribute__((ext_vector_type(4)));
typedef float f32x2 __attribute__((ext_vector_type(2)));
typedef float f32x16 __attribute__((ext_vector_type(16)));
typedef short bf16x8 __attribute__((ext_vector_type(8)));
typedef short s16x4 __attribute__((ext_vector_type(4)));
#define LDS_WAIT() asm volatile("s_waitcnt lgkmcnt(0)" ::: "memory")

constexpr size_t E_WIN = 0, E_WOUT = (size_t)NIN * DM, E_W1 = E_WOUT + (size_t)DM * DM, E_W2 = E_W1 + (size_t)DFF * DM, E_WG = E_W2 + (size_t)DFF * DM, E_WP = E_WG + (size_t)DM * DM,
                 E_WLAYER = E_WP + (size_t)PLE * DM;
constexpr size_t WS_W = 0, WS_WSB = WS_W + (size_t)DEPTH * E_WLAYER * 2, WS_SS = WS_WSB + (size_t)DEPTH * 4 * 128 * 128 * 2, WS_HB = WS_SS + (size_t)3 * M * 16 * 4,
                 WS_PB = WS_HB + (size_t)M * DM * 2, WS_XB = WS_PB + (size_t)M * PLE * 2, WS_BIG = WS_XB + (size_t)M * DM * 2, WS_END = WS_BIG + (size_t)M * DFF * 2;
constexpr size_t B_CONV = 0, B_Q = B_CONV + (size_t)3 * M * 256 * 2, B_K = B_Q + (size_t)M * 512 * 2, B_VT = B_K + (size_t)M * 512 * 2, B_CU = B_VT + (size_t)M * 512 * 2,
                 B_VNT = B_CU + (size_t)M * 256 * 2, B_Y = B_VNT + (size_t)M * 256 * 2, B_ENDMIX = B_Y + (size_t)M * DM * 2;
static_assert(B_ENDMIX <= (size_t)M * DFF * 2, "mixer tensors fit under the F overlay");
constexpr size_t WS_CTL = WS_END, CTL_BYTES = 16384, WS_TOTAL = WS_CTL + CTL_BYTES;
constexpr int RING_BYTES = 131072, LDS_BYTES = 132096;

__device__ __forceinline__ unsigned f2bf(float f) { unsigned u = __builtin_bit_cast(unsigned, f); return (u + 0x7fffu + ((u >> 16) & 1u)) >> 16; }
typedef __bf16 bf16x2_t __attribute__((ext_vector_type(2)));
__device__ __forceinline__ unsigned pk2(float lo, float hi) { f32x2 v = {lo, hi}; bf16x2_t b = __builtin_convertvector(v, bf16x2_t); return __builtin_bit_cast(unsigned, b); }
__device__ __forceinline__ float bflo(unsigned u) { return __builtin_bit_cast(float, u << 16); }
__device__ __forceinline__ float bfhi(unsigned u) { return __builtin_bit_cast(float, u & 0xffff0000u); }
__device__ __forceinline__ float wave_sum(float v) {
#pragma unroll
    for (int o = 1; o < 64; o <<= 1) v += __shfl_xor(v, o);
    return v;
}

__device__ __forceinline__ float row_rs(const float* ssp, int r) {
    const f32x4* q = (const f32x4*)(ssp + (size_t)r * 16); const f32x4 a = q[0], b = q[1], c = q[2], d = q[3];
    const float s = ((a[0] + a[1]) + (a[2] + a[3])) + ((b[0] + b[1]) + (b[2] + b[3])) + ((c[0] + c[1]) + (c[2] + c[3])) + ((d[0] + d[1]) + (d[2] + d[3]));
    return rsqrtf(s * (1.f / 1024.f) + EPS);
}
struct EpiInProj {
    static constexpr bool PERM = true, AFTER_DRAIN = false;
    const float* ss; bf16* conv; bf16* q; bf16* k; bf16* vt; bf16* cu; bf16* vnt; const float* qg; const float* kg; const float* sg;
    __device__ __forceinline__ void operator()(const pg8::f32x4 (&acc)[2][2][4][2], const pg8::Unit& u, int wr, int wc, int fr, int fq) const {
        const int sec = u.pn;
        const int row0 = u.pm * 256 + wr * 64 + fr;
        const int cw = 64 * wc + 8 * fq;
        const bool normed = (sec >= 3 && sec < 7) || sec == 10;
        float rsv[8];
#pragma unroll
        for (int g = 0; g < 8; ++g) { rsv[g] = row_rs(ss, row0 + (g >> 2) * 128 + (g & 3) * 16); if (g & 1) asm volatile("" : "+v"(rsv[g - 1]), "+v"(rsv[g]) :: "memory"); }
        f32x4 gv[2][2];
#pragma unroll
        for (int bj = 0; bj < 2; ++bj)
#pragma unroll
            for (int n = 0; n < 2; ++n) {
                if (sec >= 3 && sec < 7) { const float* g = sec < 5 ? qg : kg; const float sc = sec < 5 ? C2 : 1.f; gv[bj][n] = *(const f32x4*)(g + 32 * bj + 8 * fq + 4 * n) * sc; }
                else if (sec == 10) gv[bj][n] = *(const f32x4*)(sg + cw + 32 * bj + 4 * n);
                else gv[bj][n] = (f32x4){1.f, 1.f, 1.f, 1.f};
            }
#pragma unroll
        for (int ai = 0; ai < 2; ++ai)
#pragma unroll
            for (int m = 0; m < 4; ++m) {
                const int r = row0 + ai * 128 + m * 16;
                const float rs = rsv[ai * 4 + m];
                f32x4 v[2][2];
#pragma unroll
                for (int bj = 0; bj < 2; ++bj)
#pragma unroll
                    for (int n = 0; n < 2; ++n) v[bj][n] = acc[ai][bj][m][n] * rs;
                if (sec >= 9) {
#pragma unroll
                    for (int bj = 0; bj < 2; ++bj)
#pragma unroll
                        for (int n = 0; n < 2; ++n) { const pg8::f32x2 a = pg8::gelu_pk((pg8::f32x2){v[bj][n][0], v[bj][n][1]}), b = pg8::gelu_pk((pg8::f32x2){v[bj][n][2], v[bj][n][3]}); v[bj][n] = (f32x4){a.x, a.y, b.x, b.y}; }
                }
                if (normed) {
                    float s2 = 0.f;
#pragma unroll
                    for (int bj = 0; bj < 2; ++bj)
#pragma unroll
                        for (int n = 0; n < 2; ++n) { const f32x4 x = v[bj][n]; s2 += (x[0] * x[0] + x[1] * x[1]) + (x[2] * x[2] + x[3] * x[3]); }
                    s2 += __shfl_xor(s2, 16); s2 += __shfl_xor(s2, 32);
                    const float rn = rsqrtf(s2 * (1.f / 64.f) + EPS);
#pragma unroll
                    for (int bj = 0; bj < 2; ++bj)
#pragma unroll
                        for (int n = 0; n < 2; ++n) v[bj][n] = v[bj][n] * rn * gv[bj][n];
                }
                if (sec == 7 || sec == 8 || sec == 10) {
                    const int b = r >> 11, s = r & 2047;
                    bf16* base = (sec == 10) ? vnt + ((size_t)(b * 4 + wc) * 64) * SEQ + s : vt + ((size_t)(b * 8 + 4 * (sec - 7) + wc) * 64) * SEQ + s;
#pragma unroll
                    for (int bj = 0; bj < 2; ++bj)
#pragma unroll
                        for (int n = 0; n < 2; ++n)
#pragma unroll
                            for (int j = 0; j < 4; ++j) base[(size_t)(32 * bj + 8 * fq + 4 * n + j) * SEQ] = (bf16)f2bf(v[bj][n][j]);
                } else {
                    bf16* dst; int ld;
                    if (sec < 3) { dst = conv + (size_t)sec * M * 256 + cw; ld = 256; }
                    else if (sec < 5) { dst = q + (sec - 3) * 256 + cw; ld = 512; }
                    else if (sec < 7) { dst = k + (sec - 5) * 256 + cw; ld = 512; }
                    else { dst = cu + cw; ld = 256; }
                    dst += (size_t)r * ld;
#pragma unroll
                    for (int bj = 0; bj < 2; ++bj) { v4u w; w.x = pk2(v[bj][0][0], v[bj][0][1]); w.y = pk2(v[bj][0][2], v[bj][0][3]); w.z = pk2(v[bj][1][0], v[bj][1][1]); w.w = pk2(v[bj][1][2], v[bj][1][3]);
                        *(v4u*)(dst + 32 * bj) = w; }
                }
            }
    }
};

struct EpiRes {
    static constexpr bool PERM = true, AFTER_DRAIN = false;
    const float* base; float* out; bf16* outb; float* ssout;
    __device__ __forceinline__ void operator()(const pg8::f32x4 (&acc)[2][2][4][2], const pg8::Unit& u, int wr, int wc, int fr, int fq) const {
        const int row0 = u.pm * 256 + wr * 64 + fr, col0 = u.pn * 256 + wc * 32 + 8 * fq;
        constexpr int LA = 2;
        f32x4 bq[8][4];
#pragma unroll
        for (int g = 0; g < LA; ++g) { const size_t off = (size_t)(row0 + (g >> 2) * 128 + (g & 3) * 16) * DM + col0;
#pragma unroll
            for (int bj = 0; bj < 2; ++bj) { bq[g][2 * bj] = *(const f32x4*)(base + off + bj * 128); bq[g][2 * bj + 1] = *(const f32x4*)(base + off + bj * 128 + 4); } }
#pragma unroll
        for (int g = 0; g < 8; ++g) {
            if (g + LA < 8) { const int gn = g + LA; const size_t off = (size_t)(row0 + (gn >> 2) * 128 + (gn & 3) * 16) * DM + col0;
#pragma unroll
                for (int bj = 0; bj < 2; ++bj) { bq[gn][2 * bj] = *(const f32x4*)(base + off + bj * 128); bq[gn][2 * bj + 1] = *(const f32x4*)(base + off + bj * 128 + 4); } }
            const int ai = g >> 2, m = g & 3;
            const int r = row0 + ai * 128 + m * 16; const size_t off = (size_t)r * DM + col0; float s2 = 0.f;
#pragma unroll
            for (int bj = 0; bj < 2; ++bj) {
                const f32x4 h0 = bq[g][2 * bj] + acc[ai][bj][m][0], h1 = bq[g][2 * bj + 1] + acc[ai][bj][m][1];
                *(f32x4*)(out + off + bj * 128) = h0; *(f32x4*)(out + off + bj * 128 + 4) = h1;
                v4u w; w.x = pk2(h0[0], h0[1]); w.y = pk2(h0[2], h0[3]); w.z = pk2(h1[0], h1[1]); w.w = pk2(h1[2], h1[3]); *(v4u*)(outb + off + bj * 128) = w;
                s2 += (h0[0] * h0[0] + h0[1] * h0[1]) + (h0[2] * h0[2] + h0[3] * h0[3]) + (h1[0] * h1[0] + h1[1] * h1[1]) + (h1[2] * h1[2] + h1[3] * h1[3]);
            }
            s2 += __shfl_xor(s2, 16); s2 += __shfl_xor(s2, 32);
            if (fq == 0) ssout[(size_t)r * 16 + u.pn * 4 + wc] = s2;
            asm volatile("" ::: "memory");
        }
    }
};
struct EpiFF1 {
    static constexpr bool PERM = true, AFTER_DRAIN = false;
    const float* ss; bf16* f;
    __device__ __forceinline__ void operator()(const pg8::f32x4 (&acc)[2][2][4][2], const pg8::Unit& u, int wr, int wc, int fr, int fq) const {
        const int row0 = u.pm * 256 + wr * 64 + fr, col0 = u.pn * 256 + wc * 32 + 8 * fq;
        float rsv[8];
#pragma unroll
        for (int g = 0; g < 8; ++g) { rsv[g] = row_rs(ss, row0 + (g >> 2) * 128 + (g & 3) * 16); if (g & 1) asm volatile("" : "+v"(rsv[g - 1]), "+v"(rsv[g]) :: "memory"); }
#pragma unroll
        for (int ai = 0; ai < 2; ++ai)
#pragma unroll
            for (int m = 0; m < 4; ++m) {
                const int r = row0 + ai * 128 + m * 16; const float rs = rsv[ai * 4 + m]; bf16* dst = f + (size_t)r * DFF + col0;
#pragma unroll
                for (int bj = 0; bj < 2; ++bj) {
                    f32x4 a = acc[ai][bj][m][0] * rs, b = acc[ai][bj][m][1] * rs;
#pragma unroll
                    for (int j = 0; j < 4; ++j) { a[j] = fmaxf(a[j], 0.f); a[j] *= a[j]; b[j] = fmaxf(b[j], 0.f); b[j] *= b[j]; }
                    v4u w; w.x = pk2(a[0], a[1]); w.y = pk2(a[2], a[3]); w.z = pk2(b[0], b[1]); w.w = pk2(b[2], b[3]); *(v4u*)(dst + bj * 128) = w;
                }
            }
    }
};
struct EpiT {
    static constexpr bool PERM = true, AFTER_DRAIN = false;
    bf16* t;
    __device__ __forceinline__ void operator()(const pg8::f32x4 (&acc)[2][2][4][2], const pg8::Unit& u, int wr, int wc, int fr, int fq) const {
        const int row0 = u.pm * 256 + wr * 64 + fr, col0 = u.pn * 256 + wc * 32 + 8 * fq;
#pragma unroll
        for (int ai = 0; ai < 2; ++ai)
#pragma unroll
            for (int m = 0; m < 4; ++m) {
                bf16* dst = t + (size_t)(row0 + ai * 128 + m * 16) * DM + col0;
#pragma unroll
                for (int bj = 0; bj < 2; ++bj) { const f32x4 a = acc[ai][bj][m][0], b = acc[ai][bj][m][1];
                    v4u w; w.x = pk2(a[0], a[1]); w.y = pk2(a[2], a[3]); w.z = pk2(b[0], b[1]); w.w = pk2(b[2], b[3]); *(v4u*)(dst + bj * 128) = w; }
            }
    }
};
struct EpiGate {
    static constexpr bool PERM = true, AFTER_DRAIN = false;
    const float* ss; float* h; bf16* tx; float* ssout;
    __device__ __forceinline__ void operator()(const pg8::f32x4 (&acc)[2][2][4][2], const pg8::Unit& u, int wr, int wc, int fr, int fq) const {
        const int row0 = u.pm * 256 + wr * 64 + fr, col0 = u.pn * 256 + wc * 32 + 8 * fq;
        float rsv[8];
#pragma unroll
        for (int g = 0; g < 8; ++g) { rsv[g] = row_rs(ss, row0 + (g >> 2) * 128 + (g & 3) * 16) * (-1.4426950408889634f); if (g & 1) asm volatile("" : "+v"(rsv[g - 1]), "+v"(rsv[g]) :: "memory"); }
        constexpr int LA = 1;
        f32x4 hq[8][4]; v4u tq[8][2];
#pragma unroll
        for (int g = 0; g < LA; ++g) { const size_t off = (size_t)(row0 + (g >> 2) * 128 + (g & 3) * 16) * DM + col0;
#pragma unroll
            for (int bj = 0; bj < 2; ++bj) { tq[g][bj] = *(const v4u*)(tx + off + bj * 128); hq[g][2 * bj] = *(const f32x4*)(h + off + bj * 128); hq[g][2 * bj + 1] = *(const f32x4*)(h + off + bj * 128 + 4); } }
#pragma unroll
        for (int g = 0; g < 8; ++g) {
            if (g + LA < 8) { const int gn = g + LA; const size_t off = (size_t)(row0 + (gn >> 2) * 128 + (gn & 3) * 16) * DM + col0;
#pragma unroll
                for (int bj = 0; bj < 2; ++bj) { tq[gn][bj] = *(const v4u*)(tx + off + bj * 128); hq[gn][2 * bj] = *(const f32x4*)(h + off + bj * 128); hq[gn][2 * bj + 1] = *(const f32x4*)(h + off + bj * 128 + 4); } }
            const int ai = g >> 2, m = g & 3;
            const int r = row0 + ai * 128 + m * 16; const float rs = rsv[g]; const size_t off = (size_t)r * DM + col0; float s2 = 0.f;
#pragma unroll
            for (int bj = 0; bj < 2; ++bj) {
                const v4u tw = tq[g][bj];
                const f32x4 t0 = (f32x4){bflo(tw.x), bfhi(tw.x), bflo(tw.y), bfhi(tw.y)}, t1 = (f32x4){bflo(tw.z), bfhi(tw.z), bflo(tw.w), bfhi(tw.w)};
                f32x4 g0 = acc[ai][bj][m][0] * rs, g1 = acc[ai][bj][m][1] * rs;
#pragma unroll
                for (int j = 0; j < 4; ++j) { g0[j] = __builtin_amdgcn_rcpf(1.f + __builtin_amdgcn_exp2f(g0[j])); g1[j] = __builtin_amdgcn_rcpf(1.f + __builtin_amdgcn_exp2f(g1[j])); }
                const f32x4 h0 = hq[g][2 * bj] + g0 * t0, h1 = hq[g][2 * bj + 1] + g1 * t1;
                *(f32x4*)(h + off + bj * 128) = h0; *(f32x4*)(h + off + bj * 128 + 4) = h1;
                v4u w; w.x = pk2(h0[0], h0[1]); w.y = pk2(h0[2], h0[3]); w.z = pk2(h1[0], h1[1]); w.w = pk2(h1[2], h1[3]); *(v4u*)(tx + off + bj * 128) = w;
                s2 += (h0[0] * h0[0] + h0[1] * h0[1]) + (h0[2] * h0[2] + h0[3] * h0[3]) + (h1[0] * h1[0] + h1[1] * h1[1]) + (h1[2] * h1[2] + h1[3] * h1[3]);
            }
            s2 += __shfl_xor(s2, 16); s2 += __shfl_xor(s2, 32);
            if (fq == 0) ssout[(size_t)r * 16 + u.pn * 4 + wc] = s2;
            asm volatile("" ::: "memory");
        }
    }
};

__device__ __forceinline__ void tr_item(const float* W, int K, int N, bf16* WT, LAS float* scr, int item, int lane, const float* g, bool hperm) {
    const int nblk = N / 32, kb = item / nblk, nb = item % nblk, k0 = 64 * kb, n0 = 32 * nb;
    const int kr = lane >> 3, nq = (lane & 7) * 4;
    f32x4 v[8];
#pragma unroll
    for (int i = 0; i < 8; ++i) v[i] = *(const f32x4*)(W + (size_t)(k0 + 8 * i + kr) * N + n0 + nq);
    if (g) {
#pragma unroll
        for (int i = 0; i < 8; ++i) v[i] = v[i] * g[k0 + 8 * i + kr];
    }
#pragma unroll
    for (int i = 0; i < 8; ++i) { LAS float* d = scr + (8 * i + kr) * 33 + nq; d[0] = v[i][0]; d[1] = v[i][1]; d[2] = v[i][2]; d[3] = v[i][3]; }
    LDS_WAIT(); asm volatile("" ::: "memory");
    int d0 = n0; if (hperm) { const int gi = (n0 >> 5) & 7; d0 = (n0 & ~255) + 32 * (4 * (gi & 1) + (gi >> 1)); }
    const int c = lane & 7;
#pragma unroll
    for (int j = 0; j < 4; ++j) { const int n = (lane >> 3) + 8 * j; const LAS float* sp = scr + (8 * c) * 33 + n;
        v4u o; o.x = pk2(sp[0 * 33], sp[1 * 33]); o.y = pk2(sp[2 * 33], sp[3 * 33]); o.z = pk2(sp[4 * 33], sp[5 * 33]); o.w = pk2(sp[6 * 33], sp[7 * 33]);
        *(v4u*)(WT + (size_t)(d0 + n) * K + k0 + 8 * c) = o; }
    LDS_WAIT(); asm volatile("" ::: "memory");
}

__device__ __forceinline__ int crow(int r, int hf) { return (r & 3) + 8 * (r >> 2) + 4 * hf; }
__device__ __forceinline__ void attn_task(const bf16* Q, const bf16* K, const bf16* VT, bf16* Y, int b, int h, int qb, int lane) {
    const int t = lane & 31, hf = lane >> 5, q0 = qb * 32;
    const bf16* qp = Q + (size_t)(b * SEQ + q0 + t) * 512 + h * 64 + 8 * hf;
    bf16x8 qr[4];
#pragma unroll
    for (int kk = 0; kk < 4; ++kk) qr[kk] = *(const bf16x8*)(qp + 16 * kk);
    const bf16* kbase = K + (size_t)(b * SEQ + t) * 512 + h * 64 + 8 * hf;
    const bf16* vbase = VT + (size_t)((b * 8 + h) * 64 + t) * SEQ + 4 * hf;
    f32x16 o0, o1;
#pragma unroll
    for (int r = 0; r < 16; ++r) { o0[r] = 0.f; o1[r] = 0.f; }
    float carry = 1.f;
    bf16x8 kn[4]; s16x4 vn[2][4];
#pragma unroll
    for (int kk = 0; kk < 4; ++kk) kn[kk] = *(const bf16x8*)(kbase + (size_t)q0 * 512 + 16 * kk);
#pragma unroll
    for (int db = 0; db < 2; ++db)
#pragma unroll
        for (int g = 0; g < 4; ++g) vn[db][g] = *(const s16x4*)(vbase + (size_t)db * 32 * SEQ + q0 + 8 * g);
    for (int j = qb; j >= 0; --j) {
        bf16x8 kf[4]; s16x4 vv[2][4];
#pragma unroll
        for (int kk = 0; kk < 4; ++kk) kf[kk] = kn[kk];
#pragma unroll
        for (int db = 0; db < 2; ++db)
#pragma unroll
            for (int g = 0; g < 4; ++g) vv[db][g] = vn[db][g];
        { const int sn = 32 * (j > 0 ? j - 1 : 0);
#pragma unroll
          for (int kk = 0; kk < 4; ++kk) kn[kk] = *(const bf16x8*)(kbase + (size_t)sn * 512 + 16 * kk);
#pragma unroll
          for (int db = 0; db < 2; ++db)
#pragma unroll
              for (int g = 0; g < 4; ++g) vn[db][g] = *(const s16x4*)(vbase + (size_t)db * 32 * SEQ + sn + 8 * g); }
        f32x16 z;
#pragma unroll
        for (int r = 0; r < 16; ++r) z[r] = 0.f;
#pragma unroll
        for (int kk = 0; kk < 4; ++kk) z = __builtin_amdgcn_mfma_f32_32x32x16_bf16(kf[kk], qr[kk], z, 0, 0, 0);
        float om[16], be[16];
        const bool diag = (j == qb);
#pragma unroll
        for (int r = 0; r < 16; ++r) {
            const float e = __builtin_amdgcn_exp2f(fminf(z[r], 100.f));
            float o = __builtin_amdgcn_rcpf(1.f + e), bt = e * o;
            if (diag) { const bool valid = crow(r, hf) < t; o = valid ? o : 1.f; bt = valid ? bt : 0.f; }
            om[r] = o; be[r] = bt;
        }
        float R[4], w[16];
#pragma unroll
        for (int g = 0; g < 4; ++g) {
            const float x2 = om[4 * g + 3], x1 = x2 * om[4 * g + 2], x0 = x1 * om[4 * g + 1];
            w[4 * g + 3] = be[4 * g + 3]; w[4 * g + 2] = be[4 * g + 2] * x2; w[4 * g + 1] = be[4 * g + 1] * x1; w[4 * g] = be[4 * g] * x0;
            R[g] = x0 * om[4 * g];
        }
        float Rp[4], T[4];
#pragma unroll
        for (int g = 0; g < 4; ++g) { Rp[g] = __shfl_xor(R[g], 32); T[g] = R[g] * Rp[g]; }
        float L[4]; L[3] = carry; L[2] = L[3] * T[3]; L[1] = L[2] * T[2]; L[0] = L[1] * T[1]; carry = L[0] * T[0];
#pragma unroll
        for (int g = 0; g < 4; ++g) { const float lg = hf ? L[g] : L[g] * Rp[g];
#pragma unroll
            for (int c = 0; c < 4; ++c) w[4 * g + c] *= lg; }
#pragma unroll
        for (int ks = 0; ks < 2; ++ks) {
            v4u pw; pw.x = pk2(w[8 * ks], w[8 * ks + 1]); pw.y = pk2(w[8 * ks + 2], w[8 * ks + 3]); pw.z = pk2(w[8 * ks + 4], w[8 * ks + 5]); pw.w = pk2(w[8 * ks + 6], w[8 * ks + 7]);
            const bf16x8 pf = __builtin_bit_cast(bf16x8, pw);
            const bf16x8 v0 = (bf16x8){vv[0][2 * ks][0], vv[0][2 * ks][1], vv[0][2 * ks][2], vv[0][2 * ks][3], vv[0][2 * ks + 1][0], vv[0][2 * ks + 1][1], vv[0][2 * ks + 1][2], vv[0][2 * ks + 1][3]};
            const bf16x8 v1 = (bf16x8){vv[1][2 * ks][0], vv[1][2 * ks][1], vv[1][2 * ks][2], vv[1][2 * ks][3], vv[1][2 * ks + 1][0], vv[1][2 * ks + 1][1], vv[1][2 * ks + 1][2], vv[1][2 * ks + 1][3]};
            o0 = __builtin_amdgcn_mfma_f32_32x32x16_bf16(v0, pf, o0, 0, 0, 0);
            o1 = __builtin_amdgcn_mfma_f32_32x32x16_bf16(v1, pf, o1, 0, 0, 0);
        }
#if ATT_EARLY_EXIT
        if (__all(carry == 0.f)) break;
#endif
    }
    bf16* yp = Y + (size_t)(b * SEQ + q0 + t) * DM + 256 + h * 64 + 4 * hf;
#pragma unroll
    for (int g = 0; g < 4; ++g) {
        v2u a; a.x = pk2(o0[4 * g], o0[4 * g + 1]); a.y = pk2(o0[4 * g + 2], o0[4 * g + 3]); *(v2u*)(yp + 8 * g) = a;
        v2u c; c.x = pk2(o1[4 * g], o1[4 * g + 1]); c.y = pk2(o1[4 * g + 2], o1[4 * g + 3]); *(v2u*)(yp + 32 + 8 * g) = c;
    }
}
__device__ __forceinline__ void sgu_task(const bf16* VNT, const bf16* WSB, const bf16* CU, const float* bias, bf16* Y, int task, int lane) {
    const int tb = task & 3, g = (task >> 2) & 3, c = (task >> 4) & 15, b = task >> 8;
    const int t = lane & 31, hf = lane >> 5;
    const bf16* ap = VNT + (size_t)((b * 4 + g) * 64 + t) * SEQ + 128 * c + 8 * hf;
    const bf16* bp = WSB + (size_t)(g * 128 + 32 * tb + t) * 128 + 8 * hf;
    f32x16 a0, a1;
#pragma unroll
    for (int r = 0; r < 16; ++r) { a0[r] = 0.f; a1[r] = 0.f; }
    bf16x8 bfr[8], af0[8], af1[8];
#pragma unroll
    for (int ks = 0; ks < 8; ++ks) { bfr[ks] = *(const bf16x8*)(bp + 16 * ks); af0[ks] = *(const bf16x8*)(ap + 16 * ks); af1[ks] = *(const bf16x8*)(ap + (size_t)32 * SEQ + 16 * ks); }
#pragma unroll
    for (int ks = 0; ks < 8; ++ks) {
        a0 = __builtin_amdgcn_mfma_f32_32x32x16_bf16(af0[ks], bfr[ks], a0, 0, 0, 0);
        a1 = __builtin_amdgcn_mfma_f32_32x32x16_bf16(af1[ks], bfr[ks], a1, 0, 0, 0);
    }
    const int tok = b * SEQ + 128 * c + 32 * tb + t;
    const float bs = bias[g * 128 + 32 * tb + t];
    const bf16* up = CU + (size_t)tok * 256 + 64 * g + 4 * hf;
    bf16* yp = Y + (size_t)tok * DM + 768 + 64 * g + 4 * hf;
#pragma unroll
    for (int gg = 0; gg < 4; ++gg) {
        const v2u u0 = *(const v2u*)(up + 8 * gg), u1 = *(const v2u*)(up + 32 + 8 * gg);
        v2u a; a.x = pk2(bflo(u0.x) * (a0[4 * gg] + bs), bfhi(u0.x) * (a0[4 * gg + 1] + bs)); a.y = pk2(bflo(u0.y) * (a0[4 * gg + 2] + bs), bfhi(u0.y) * (a0[4 * gg + 3] + bs)); *(v2u*)(yp + 8 * gg) = a;
        v2u d; d.x = pk2(bflo(u1.x) * (a1[4 * gg] + bs), bfhi(u1.x) * (a1[4 * gg + 1] + bs)); d.y = pk2(bflo(u1.y) * (a1[4 * gg + 2] + bs), bfhi(u1.y) * (a1[4 * gg + 3] + bs)); *(v2u*)(yp + 32 + 8 * gg) = d;
    }
}
__device__ __forceinline__ void unpack8(const v4u w, float (&f)[8]) { f[0] = bflo(w.x); f[1] = bfhi(w.x); f[2] = bflo(w.y); f[3] = bfhi(w.y); f[4] = bflo(w.z); f[5] = bfhi(w.z); f[6] = bflo(w.w); f[7] = bfhi(w.w); }
__device__ __forceinline__ void conv_task(const bf16* CONV, const float* cwt, bf16* Y, int task, int lane) {
    const int ch = (lane & 31) * 8;
    float w0[8], w1[8], w2[8];
#pragma unroll
    for (int e = 0; e < 8; ++e) { w0[e] = cwt[ch + e]; w1[e] = cwt[256 + ch + e]; w2[e] = cwt[512 + ch + e]; }
    const bf16* ab = CONV; const bf16* ac = CONV + (size_t)M * 256; const bf16* ah = CONV + (size_t)2 * M * 256;
#pragma unroll 2
    for (int it = 0; it < 8; ++it) {
        const int tok = task * 16 + it * 2 + (lane >> 5), s = tok & (SEQ - 1);
        const size_t o = (size_t)tok * 256 + ch;
        float fb[8], c0[8], h0[8], c1[8], h1[8], c2[8], h2[8];
        unpack8(*(const v4u*)(ab + o), fb); unpack8(*(const v4u*)(ac + o), c0); unpack8(*(const v4u*)(ah + o), h0);
        const v4u zz = (v4u){0u, 0u, 0u, 0u};
        unpack8(s >= 1 ? *(const v4u*)(ac + o - 256) : zz, c1); unpack8(s >= 1 ? *(const v4u*)(ah + o - 256) : zz, h1);
        unpack8(s >= 2 ? *(const v4u*)(ac + o - 512) : zz, c2); unpack8(s >= 2 ? *(const v4u*)(ah + o - 512) : zz, h2);
        float y[8];
#pragma unroll
        for (int e = 0; e < 8; ++e) y[e] = fb[e] * (w2[e] * (c0[e] * h0[e]) + w1[e] * (c1[e] * h1[e]) + w0[e] * (c2[e] * h2[e]));
        v4u w; w.x = pk2(y[0], y[1]); w.y = pk2(y[2], y[3]); w.z = pk2(y[4], y[5]); w.w = pk2(y[6], y[7]);
        *(v4u*)(Y + (size_t)tok * DM + ch) = w;
    }
}

#define RLX_AGENT __ATOMIC_RELAXED, __HIP_MEMORY_SCOPE_AGENT
#define XB_TMO      128
#define XB_XCNT(j)  (256  + 64 * (j))
#define XB_XSUB(j)  (1280 + 64 * (j))
#define XB_XGEN(j)  (2304 + 64 * (j))
#define XB_TOP      3328
#define XB_TOPGEN   3392
#define XCD_BAR_WORDS 3456
#define XB_SPIN_CAP (1u << 18)

__device__ __forceinline__ unsigned xb_ld(unsigned* p)              { return __hip_atomic_load(p, __ATOMIC_RELAXED, __HIP_MEMORY_SCOPE_AGENT); }
__device__ __forceinline__ unsigned xb_add(unsigned* p, unsigned v) { return __hip_atomic_fetch_add(p, v, __ATOMIC_RELAXED, __HIP_MEMORY_SCOPE_AGENT); }
__device__ __forceinline__ unsigned xb_xcc_id() { return (unsigned)__builtin_amdgcn_s_getreg((3 << 11) | 20) & 0xFu; }
#define XB_SPIN(cond, bar) do { unsigned _sp = 0; while (cond) { __builtin_amdgcn_s_sleep(1); \
    if ((++_sp & 255u) == 0u) { if (xb_ld(&(bar)[XB_TMO])) break; if (_sp > XB_SPIN_CAP) { atomicAdd(&(bar)[XB_TMO], 1u); break; } } } } while (0)

struct XcdBarrier {
    unsigned* bar; unsigned x;
    volatile LAS unsigned* st;
};

__device__ __forceinline__ XcdBarrier xcd_barrier_post(unsigned* bar, volatile LAS unsigned* st) {
    XcdBarrier b; b.bar = bar; b.x = xb_xcc_id(); b.st = st;
    if (threadIdx.x == 0) (void)xb_add(&bar[XB_XCNT(b.x)], 1u);
    return b;
}
__device__ __forceinline__ void xcd_barrier_complete(unsigned* bar, unsigned x, unsigned& nloc, unsigned& nx) {
    const unsigned G = gridDim.x * gridDim.y * gridDim.z;
    unsigned sum, cnt, mine, sp = 0u;
    for (;;) {
        sum = 0u; cnt = 0u; mine = 0u;
#pragma unroll
        for (unsigned j = 0; j < 16; ++j) { const unsigned c = xb_ld(&bar[XB_XCNT(j)]); sum += c; cnt += (c > 0u) ? 1u : 0u; mine = (j == x) ? c : mine; }
        if (sum == G) break;
        __builtin_amdgcn_s_sleep(1);
        if ((++sp & 255u) == 0u) { if (xb_ld(&bar[XB_TMO])) break; if (sp > XB_SPIN_CAP) { atomicAdd(&bar[XB_TMO], 1u); break; } }
    }
    nloc = mine > 0u ? mine : 1u; nx = cnt > 0u ? cnt : 1u;
}

__device__ __forceinline__ void xcd_barrier(const XcdBarrier& b) {
    asm volatile("s_waitcnt vmcnt(0)" ::: "memory");
    __syncthreads();
    if (threadIdx.x == 0) {
        unsigned* bar = b.bar;
        __builtin_amdgcn_s_waitcnt(0);
        unsigned nloc = b.st[0], nx = b.st[1];
        if (nloc == 0u) { xcd_barrier_complete(bar, b.x, nloc, nx); b.st[0] = nloc; b.st[1] = nx; }
        const unsigned old = xb_add(&bar[XB_XSUB(b.x)], 1u);
        const unsigned gen = old / nloc;
        if (old + 1u == (gen + 1u) * nloc) {
            __builtin_amdgcn_fence(__ATOMIC_RELEASE, "agent");
            asm volatile("s_waitcnt vmcnt(0)" ::: "memory");
            const unsigned og = xb_add(&bar[XB_TOP], 1u);
            const unsigned tg = og / nx;
            if (og + 1u == (tg + 1u) * nx) xb_add(&bar[XB_TOPGEN], 1u);
            else XB_SPIN(xb_ld(&bar[XB_TOPGEN]) == tg, bar);
            __builtin_amdgcn_fence(__ATOMIC_ACQUIRE, "agent");
            xb_add(&bar[XB_XGEN(b.x)], 1u);
            asm volatile("s_waitcnt vmcnt(0)" ::: "memory");
        } else {
            XB_SPIN(xb_ld(&bar[XB_XGEN(b.x)]) == gen, bar);
            __builtin_amdgcn_fence(__ATOMIC_ACQUIRE, "agent");
            asm volatile("s_waitcnt vmcnt(0)" ::: "memory");
        }
    }
    __syncthreads();
}

struct Args { const float* in[17]; float* out; unsigned char* ws; int ph_lo, ph_hi; };
__global__ void __launch_bounds__(NWAVES * 64, 2) mk_fwd(Args a) {
    extern __shared__ __attribute__((aligned(16))) unsigned char lds_raw[];
    LAS unsigned char* lds = (LAS unsigned char*)lds_raw;
    const int tid = threadIdx.x, lane = tid & 63, wave = __builtin_amdgcn_readfirstlane(tid >> 6);
    const int G = gridDim.x; const int bx = blockIdx.x; const int vcu = (G % 8 == 0) ? (bx % 8) * (G / 8) + bx / 8 : bx;
    const int gw = vcu * NWAVES + wave, NGW = G * NWAVES;
    const int lo = a.ph_lo, hi = a.ph_hi;
    volatile LAS unsigned* bst = (volatile LAS unsigned*)(lds + RING_BYTES);
    if (tid < 4) bst[tid] = 0u;
    __syncthreads();
    XcdBarrier bar = xcd_barrier_post((unsigned*)(a.ws + WS_CTL), bst);
    unsigned char* ws = a.ws;
    const float* x = a.in[0]; const float* p = a.in[1];
    bf16* Wb = (bf16*)(ws + WS_W); bf16* WSBb = (bf16*)(ws + WS_WSB); float* SS = (float*)(ws + WS_SS);
    bf16* HB = (bf16*)(ws + WS_HB); bf16* PB = (bf16*)(ws + WS_PB); bf16* XB = (bf16*)(ws + WS_XB);
    unsigned char* big = ws + WS_BIG;
    bf16* CONV = (bf16*)(big + B_CONV); bf16* Qb = (bf16*)(big + B_Q); bf16* Kb = (bf16*)(big + B_K); bf16* VTb = (bf16*)(big + B_VT); bf16* CUb = (bf16*)(big + B_CU);
    bf16* VNTb = (bf16*)(big + B_VNT); bf16* Yb = (bf16*)(big + B_Y); bf16* Fb = (bf16*)big;
    float* H = a.out;
#define IN(k) (lo <= (k) && (k) < hi)
#define SEAM(k) do { if (IN(k) && IN((k) + 1)) { if ((k) == 0) cg::this_grid().sync(); else xcd_barrier(bar); } } while (0)

    if (IN(0)) for (int rep_ = 0; rep_ < PROBE_P; ++rep_) {
        LAS float* scr = (LAS float*)(lds + wave * 16384);
        constexpr int I_IN = (DM / 64) * (NIN / 32), I_OUT = (DM / 64) * (DM / 32), I_1 = (DM / 64) * (DFF / 32), I_2 = (DFF / 64) * (DM / 32), I_G = I_OUT, I_P = (PLE / 64) * (DM / 32);
        constexpr int I_LAYER = I_IN + I_OUT + I_1 + I_2 + I_G + I_P;
        for (int it = gw; it < DEPTH * I_LAYER; it += NGW) {
            const int l = it / I_LAYER; int r = it % I_LAYER; bf16* wl = Wb + (size_t)l * E_WLAYER;
            if (r < I_IN) { tr_item(a.in[3] + (size_t)l * DM * NIN, DM, NIN, wl + E_WIN, scr, r, lane, a.in[2] + l * DM, true); continue; } r -= I_IN;
            if (r < I_OUT) { tr_item(a.in[10] + (size_t)l * DM * DM, DM, DM, wl + E_WOUT, scr, r, lane, nullptr, false); continue; } r -= I_OUT;
            if (r < I_1) { tr_item(a.in[12] + (size_t)l * DM * DFF, DM, DFF, wl + E_W1, scr, r, lane, a.in[11] + l * DM, false); continue; } r -= I_1;
            if (r < I_2) { tr_item(a.in[13] + (size_t)l * DFF * DM, DFF, DM, wl + E_W2, scr, r, lane, nullptr, false); continue; } r -= I_2;
            if (r < I_G) { tr_item(a.in[15] + (size_t)l * DM * DM, DM, DM, wl + E_WG, scr, r, lane, a.in[14] + l * DM, false); continue; } r -= I_G;
            tr_item(a.in[16] + (size_t)l * PLE * DM, PLE, DM, wl + E_WP, scr, r, lane, nullptr, false);
        }
        for (int i = gw * 64 + lane; i < DEPTH * 4 * 128 * 128; i += NGW * 64) { const int s = i & 127, t = (i >> 7) & 127; WSBb[i] = (bf16)f2bf(s <= t ? a.in[8][i] : 0.f); }
        for (int m = gw; m < M; m += NGW) {
            const f32x4* xr = (const f32x4*)(x + (size_t)m * DM) + lane; f32x4 v[4]; float s = 0.f;
#pragma unroll
            for (int j = 0; j < 4; ++j) { v[j] = xr[64 * j]; s += (v[j].x * v[j].x + v[j].y * v[j].y) + (v[j].z * v[j].z + v[j].w * v[j].w); }
            s = wave_sum(s);
            v2u* o8 = (v2u*)(XB + (size_t)m * DM) + lane;
#pragma unroll
            for (int j = 0; j < 4; ++j) { v2u w; w.x = pk2(v[j].x, v[j].y); w.y = pk2(v[j].z, v[j].w); o8[64 * j] = w; }
            if (lane < 16) SS[(size_t)m * 16 + lane] = lane == 0 ? s : 0.f;
        }
        asm volatile("s_waitcnt vmcnt(0) lgkmcnt(0)" ::: "memory"); __syncthreads();
    }
    SEAM(0);

    for (int l = 0; l < DEPTH; ++l) {
        const int pb = 1 + 6 * l;
        const bf16* wl = Wb + (size_t)l * E_WLAYER;
        float* ss1 = SS; float* ss2 = SS + (size_t)M * 16; float* ss3 = SS + (size_t)2 * M * 16; float* ss1n = ss1;
        if (IN(pb)) for (int rep_ = 0; rep_ < PROBE_A; ++rep_) {
#ifndef NO_A
            pg8::Gemm g{XB, wl + E_WIN, M, NIN, DM}; pg8::StaticOrder S; S.init(M, NIN, G, bx);
            EpiInProj E{ss1, CONV, Qb, Kb, VTb, CUb, VNTb, a.in[5] + l * 64, a.in[6] + l * 64, a.in[7] + l * 256};
            pg8::gemm_phase<EpiInProj, pg8::StaticOrder, true, true>(lds, g, S, E);
#endif
        }
        SEAM(pb);
        if (IN(pb + 1)) for (int rep_ = 0; rep_ < PROBE_B; ++rep_) {
            int lane_ = lane; asm volatile("" : "+v"(lane_));
#ifndef NO_ATT
            for (int pr = gw; pr < 2048; pr += NGW) { const int bh = pr >> 5, i = pr & 31;
                attn_task(Qb, Kb, VTb, Yb, bh >> 3, bh & 7, 63 - i, lane_);
                attn_task(Qb, Kb, VTb, Yb, bh >> 3, bh & 7, i, lane_); }
#endif
#ifndef NO_SGU
            for (int tk = gw; tk < 2048; tk += NGW) sgu_task(VNTb, WSBb + (size_t)l * 4 * 128 * 128, CUb, a.in[9] + l * 512, Yb, tk, lane_);
#endif
#ifndef NO_CONV
            for (int tk = gw; tk < 1024; tk += NGW) conv_task(CONV, a.in[4] + l * 768, Yb, tk, lane_);
#endif
            const float* pl = p + (size_t)l * M * PLE;
#pragma unroll 4
            for (int it = gw; it < M * PLE / 512; it += NGW) { const size_t o = (size_t)it * 512 + lane_ * 8; const f32x4 u0 = *(const f32x4*)(pl + o), u1 = *(const f32x4*)(pl + o + 4);
                v4u w; w.x = pk2(u0.x, u0.y); w.y = pk2(u0.z, u0.w); w.z = pk2(u1.x, u1.y); w.w = pk2(u1.z, u1.w); *(v4u*)(PB + o) = w; }
            asm volatile("s_waitcnt vmcnt(0) lgkmcnt(0)" ::: "memory"); __syncthreads();
        }
        SEAM(pb + 1);
        if (IN(pb + 2)) {
#ifndef NO_C
#ifndef NO_O
            { pg8::Gemm g{Yb, wl + E_WOUT, M, DM, DM}; pg8::StaticOrder S; S.init(M, DM, G, bx);
              EpiRes E{l == 0 ? x : (const float*)H, H, HB, ss2};
              pg8::gemm_phase<EpiRes, pg8::StaticOrder, true, true>(lds, g, S, E); }
#endif
#ifndef NO_T
            { int kp = PLE; asm volatile("" : "+s"(kp)); pg8::Gemm g{PB, wl + E_WP, M, DM, kp}; pg8::StaticOrder S; S.init(M, DM, G, bx);
              EpiT E{XB};
              pg8::gemm_phase<EpiT, pg8::StaticOrder, true, true>(lds, g, S, E); }
#endif
#endif
        }
        SEAM(pb + 2);
        if (IN(pb + 3)) for (int rep_ = 0; rep_ < PROBE_D; ++rep_) {
#ifndef NO_D
            pg8::Gemm g{HB, wl + E_W1, M, DFF, DM}; pg8::StaticOrder S; S.init(M, DFF, G, bx);
            EpiFF1 E{ss2, Fb};
            pg8::gemm_phase<EpiFF1, pg8::StaticOrder, true, true>(lds, g, S, E);
#endif
        }
        SEAM(pb + 3);
        if (IN(pb + 4)) {
#ifndef NO_E
            pg8::Gemm g{Fb, wl + E_W2, M, DM, DFF}; pg8::StaticOrder S; S.init(M, DM, G, bx);
            EpiRes E{H, H, HB, ss3};
            pg8::gemm_phase<EpiRes, pg8::StaticOrder, true, true>(lds, g, S, E);
#endif
        }
        SEAM(pb + 4);
        if (IN(pb + 5)) {
#ifndef NO_F
            pg8::Gemm g{HB, wl + E_WG, M, DM, DM}; pg8::StaticOrder S; S.init(M, DM, G, bx);
            EpiGate E{ss3, H, XB, ss1n};
            pg8::gemm_phase<EpiGate, pg8::StaticOrder, true, true>(lds, g, S, E);
#endif
        }
        SEAM(pb + 5);
    }
#undef IN
#undef SEAM
}

extern "C" void kernel_launch(void* const* d_in, const int* in_sizes, int n_in, void* d_out, int out_size, void* d_ws, size_t ws_size, hipStream_t stream) {
    static int grid = 0;
    if (grid == 0) {
        if (n_in != 17 || in_sizes[0] != M * DM || out_size != M * DM || ws_size < WS_TOTAL) { fprintf(stderr, "kernel_launch: unexpected shapes (n_in %d, in0 %d, out %d, ws %zu, need %zu)\n", n_in, n_in > 0 ? in_sizes[0] : -1, out_size, ws_size, (size_t)WS_TOTAL); grid = -1; return; }
        int dev = 0, cus = 0, per_cu = 0;
        hipGetDevice(&dev); hipDeviceGetAttribute(&cus, hipDeviceAttributeMultiprocessorCount, dev);
        if (hipFuncSetAttribute((const void*)mk_fwd, hipFuncAttributeMaxDynamicSharedMemorySize, LDS_BYTES) != hipSuccess) { fprintf(stderr, "kernel_launch: hipFuncSetAttribute failed\n"); grid = -1; return; }
        if (hipOccupancyMaxActiveBlocksPerMultiprocessor(&per_cu, (const void*)mk_fwd, NWAVES * 64, LDS_BYTES) != hipSuccess || per_cu < 1) { fprintf(stderr, "kernel_launch: occupancy query says %d\n", per_cu); per_cu = 1; }
        (void)hipGetLastError();
        grid = cus * 1;
    }
    if (grid < 0) return;
#ifdef DBG_MEMSET
    (void)hipMemsetAsync(d_ws, 0xAA, WS_END, stream); (void)hipMemsetAsync(d_out, 0xAA, (size_t)M * DM * 4, stream);
#endif
    if (hipMemsetAsync((char*)d_ws + WS_CTL, 0, CTL_BYTES, stream) != hipSuccess) { fprintf(stderr, "kernel_launch: memset of the barrier words failed\n"); return; }
    Args a{};
    for (int i = 0; i < 17; ++i) a.in[i] = (const float*)d_in[i];
    a.out = (float*)d_out; a.ws = (unsigned char*)d_ws;
#if MK_N_LAUNCHES == 1
    a.ph_lo = 0; a.ph_hi = NPHASE;
    void* args[] = {&a};
    hipError_t e = hipLaunchCooperativeKernel((const void*)mk_fwd, dim3(grid), dim3(NWAVES * 64), args, LDS_BYTES, stream);
    if (e != hipSuccess) fprintf(stderr, "cooperative launch failed: %s (grid %d)\n", hipGetErrorString(e), grid);
#else
    for (int ph = 0; ph < NPHASE; ++ph) { a.ph_lo = ph; a.ph_hi = ph + 1; hipLaunchKernelGGL(mk_fwd, dim3(grid), dim3(NWAVES * 64), LDS_BYTES, stream, a); }
#endif
}
```

```cpp
#include <hip/hip_runtime.h>
#include <hip/hip_cooperative_groups.h>
#include <cstdio>
#include <cstdint>
namespace cg = cooperative_groups;
namespace pg8 {
#define PG8_LAS __attribute__((address_space(3)))
typedef unsigned short bf16_t;
typedef short bf16x8 __attribute__((ext_vector_type(8)));
typedef float f32x4 __attribute__((ext_vector_type(4)));
typedef unsigned u32x4 __attribute__((ext_vector_type(4)));
constexpr int BM = 256, BK = 64, HALF = 128, HTB = HALF * BK * 2  , STAGE_BYTES = 8 * HTB, NXCD = 8, WGM = 8;

__host__ __device__ __forceinline__ int lds_byte(int r, int c) { const int st = (r >> 4) * 2 + (c >> 5), rr = r & 15, cc = c & 31, ob = rr * 64 + cc * 2; return st * 1024 + (ob ^ (((ob >> 9) & 1) << 5)); }
__host__ __device__ __forceinline__ void stage_rc(int b, int& R, int& C) { const int st = b / 1024, sb = b % 1024, swz = sb ^ (((sb >> 9) & 1) << 5); R = (st >> 1) * 16 + swz / 64; C = (st & 1) * 32 + (swz % 64) / 2; }
__host__ __device__ __forceinline__ int perm32(int rho) { const int n = rho >> 4, i = rho & 15; return 8 * (i >> 2) + 4 * n + (i & 3); }

struct Unit { int pm, pn; };
struct Gemm { const bf16_t* A; const bf16_t* Bt; int M, N, K; };

struct StaticOrder {
    int nM, nN, nwg, G, c;
    __host__ __device__ void init(int M, int N, int G_, int c_) { nM = M / BM; nN = N / BM; nwg = nM * nN; G = G_; c = c_; }
    __host__ __device__ bool next(int i, Unit& u) const {
        const long L = (long)i * G + c; if (L >= nwg) return false;
        int wgid = (int)L; { const int q = nwg / NXCD, r = nwg % NXCD, xcd = wgid % NXCD, off = wgid / NXCD; wgid = (xcd < r ? xcd * (q + 1) : r * (q + 1) + (xcd - r) * q) + off; }
        const int nig = WGM * nN, gid = wgid / nig, fm = gid * WGM, gsz = (nM - fm) < WGM ? (nM - fm) : WGM;
        u.pm = fm + ((wgid % nig) % gsz); u.pn = (wgid % nig) / gsz; return true;
    }
    __device__ __forceinline__ void a_ready(const Unit&) const {}
    __device__ __forceinline__ void done(const Unit&) const {}
};

__device__ __forceinline__ unsigned cvt_pk_bf16(float lo, float hi) { unsigned r; asm volatile("v_cvt_pk_bf16_f32 %0, %1, %2" : "=v"(r) : "v"(lo), "v"(hi)); return r; }
typedef float f32x2 __attribute__((ext_vector_type(2)));
__device__ __forceinline__ f32x2 gelu_pk(f32x2 v) {
    const f32x2 av = __builtin_elementwise_abs(v), d = av * 0.2316418882f + 1.0f;
    f32x2 t; t.x = __builtin_amdgcn_rcpf(d.x); t.y = __builtin_amdgcn_rcpf(d.y);
    f32x2 q = t * 0.5307027145f + (-0.7265760135f); q = q * t + 0.7107068705f; q = q * t + (-0.142248368f); q = q * t + 0.127414796f; q = q * t;
    const f32x2 s = (v * v) * (-0.72134752044f);
    f32x2 e; e.x = __builtin_amdgcn_exp2f(s.x); e.y = __builtin_amdgcn_exp2f(s.y);
    const f32x2 m = v * (q * e), r = v - m;
    f32x2 o; o.x = v.x < 0.f ? m.x : r.x; o.y = v.y < 0.f ? m.y : r.y; return o;
}

template <int ACT  > struct EpiBf16 {
    static constexpr bool PERM = true, AFTER_DRAIN = false; static_assert(ACT == 0 || ACT == 1, "EpiBf16: ACT is 0 (none) or 1 (gelu_pk)");
    bf16_t* O; int ldc; const float* bias; int split_cols; size_t split_stride; float scale0;
    __device__ __forceinline__ void operator()(const f32x4 (&acc)[2][2][4][2], const Unit& u, int wr, int wc, int fr, int fq) const {
        const int row0 = u.pm * BM + wr * 64 + fr; int colt = u.pn * BM; bf16_t* base = O;
        float sc = 1.f; if (split_cols) { const int t = colt / split_cols; base += (size_t)t * split_stride; colt -= t * split_cols; if (t == 0) sc = scale0; }
        const int col0 = colt + wc * 32 + 8 * fq, bcol0 = u.pn * BM + wc * 32 + 8 * fq;
        f32x4 bv[2][2];
#pragma unroll
        for (int bj = 0; bj < 2; ++bj)
#pragma unroll
            for (int n = 0; n < 2; ++n) bv[bj][n] = bias ? *(const f32x4*)(bias + bcol0 + bj * HALF + 4 * n) : (f32x4){0.f, 0.f, 0.f, 0.f};
#pragma unroll
        for (int ai = 0; ai < 2; ++ai)
#pragma unroll
            for (int m = 0; m < 4; ++m) { bf16_t* rowp = base + (size_t)(row0 + ai * HALF + m * 16) * ldc + col0;
#pragma unroll
                for (int bj = 0; bj < 2; ++bj) { f32x4 v0 = acc[ai][bj][m][0] + bv[bj][0], v1 = acc[ai][bj][m][1] + bv[bj][1];
                    if (ACT == 1) { f32x2 a = gelu_pk((f32x2){v0[0], v0[1]}), b = gelu_pk((f32x2){v0[2], v0[3]}), c = gelu_pk((f32x2){v1[0], v1[1]}), d = gelu_pk((f32x2){v1[2], v1[3]});
                        v0 = (f32x4){a.x, a.y, b.x, b.y}; v1 = (f32x4){c.x, c.y, d.x, d.y}; }
                    v0 = v0 * sc; v1 = v1 * sc; u32x4 w; w.x = cvt_pk_bf16(v0[0], v0[1]); w.y = cvt_pk_bf16(v0[2], v0[3]); w.z = cvt_pk_bf16(v1[0], v1[1]); w.w = cvt_pk_bf16(v1[2], v1[3]);
                    *(u32x4*)(rowp + bj * HALF) = w; } }
    }
};
template <class Epi, class Sched, bool ALIGN_EPI = false, bool SP2 = false>
__device__ __forceinline__ void gemm_phase(PG8_LAS unsigned char* lds, const Gemm g, const Sched& S, const Epi& E) {
    int tid_ = threadIdx.x; asm volatile("" : "+v"(tid_));
    const int tid = tid_, wid = __builtin_amdgcn_readfirstlane(tid >> 6), lane = tid & 63, wr = wid >> 2, wc = wid & 3, fr = lane & 15, fq = lane >> 4;
    const int K = g.K, nt = K / BK;
    unsigned voffA[2], voffB[2];
#pragma unroll
    for (int i = 0; i < 2; ++i) { int R, C; stage_rc(tid * 16 + i * 8192, R, C); const int Rb = Epi::PERM ? ((R & ~31) + perm32(R & 31)) : R;
        voffA[i] = (unsigned)(R * K + C) * 2u; voffB[i] = (unsigned)(Rb * K + C) * 2u; }
    const size_t kstep = (size_t)(BK * 2);
    const size_t hstep = (size_t)HALF * K * 2;
    const size_t tstep = 2 * hstep;
    const unsigned ldsw = (unsigned)wid * 1024u;
    const int aoff = lds_byte(wr * 64 + fr, fq * 8), boff = lds_byte(wc * 32 + fr, fq * 8);
#define PG8_SA(b, h) (((b) * 2 + (h)) * HTB)
#define PG8_SB(b, h) ((4 + (b) * 2 + (h)) * HTB)
#define PG8_STAGE(bufoff, gbase, voff) do { _Pragma("unroll") for (int _i = 0; _i < 2; ++_i) \
        __builtin_amdgcn_global_load_lds((const unsigned*)((const char*)(gbase) + (voff)[_i]), (PG8_LAS unsigned*)(lds + (bufoff) + ldsw + _i * 8192), 16, 0, 0); } while (0)
#define PG8_LDA(dst, b, h) do { _Pragma("unroll") for (int m = 0; m < 4; ++m) _Pragma("unroll") for (int k = 0; k < 2; ++k) dst[m][k] = *(const PG8_LAS bf16x8*)(lds + PG8_SA(b, h) + aoff + m * 2048 + k * 1024); } while (0)
#define PG8_LDB(dst, b, h) do { _Pragma("unroll") for (int n = 0; n < 2; ++n) _Pragma("unroll") for (int k = 0; k < 2; ++k) dst[n][k] = *(const PG8_LAS bf16x8*)(lds + PG8_SB(b, h) + boff + n * 2048 + k * 1024); } while (0)
#define PG8_MMA(ai, bj, At, Bt) do { __builtin_amdgcn_s_setprio(1); _Pragma("unroll") for (int m = 0; m < 4; ++m) _Pragma("unroll") for (int n = 0; n < 2; ++n) _Pragma("unroll") for (int k = 0; k < 2; ++k) \
        acc[ai][bj][m][n] = __builtin_amdgcn_mfma_f32_16x16x32_bf16(Bt[n][k], At[m][k], acc[ai][bj][m][n], 0, 0, 0); __builtin_amdgcn_s_setprio(0); } while (0)
#define PG8_WAIT_V(n) asm volatile("s_waitcnt vmcnt(" #n ")" ::: "memory")
#define PG8_WAIT_L(n) asm volatile("s_waitcnt lgkmcnt(" #n ")" ::: "memory")
#define PG8_BAR __builtin_amdgcn_s_barrier()
#define PG8_SCHED __builtin_amdgcn_sched_barrier(0)
    Unit cur, nxt; int ui = 0;
    if (!S.next(0, cur)) return;
    f32x4 acc[2][2][4][2];
#pragma unroll
    for (int a = 0; a < 2; ++a)
#pragma unroll
        for (int b = 0; b < 2; ++b)
#pragma unroll
            for (int m = 0; m < 4; ++m)
#pragma unroll
                for (int n = 0; n < 2; ++n) acc[a][b][m][n] = (f32x4){0.f, 0.f, 0.f, 0.f};
    bf16x8 At[4][2], B0[2][2], B1[2][2];
    const char* cA = (const char*)g.A + (size_t)cur.pm * tstep; const char* cB = (const char*)g.Bt + (size_t)cur.pn * tstep;
    S.a_ready(cur);
    if constexpr (SP2) {
        PG8_STAGE(PG8_SB(0, 0), cB, voffB); PG8_STAGE(PG8_SB(0, 1), cB + hstep, voffB); PG8_STAGE(PG8_SA(0, 0), cA, voffA); PG8_STAGE(PG8_SA(0, 1), cA + hstep, voffA);
        if (wr == 1) PG8_BAR;
        PG8_WAIT_V(2); PG8_BAR;
        PG8_STAGE(PG8_SB(1, 0), cB + kstep, voffB); PG8_STAGE(PG8_SA(1, 0), cA + kstep, voffA); PG8_STAGE(PG8_SB(1, 1), cB + hstep + kstep, voffB);
        PG8_WAIT_V(6); PG8_BAR;
    } else {
        PG8_STAGE(PG8_SB(0, 0), cB, voffB); PG8_STAGE(PG8_SA(0, 0), cA, voffA); PG8_STAGE(PG8_SB(0, 1), cB + hstep, voffB); PG8_STAGE(PG8_SA(0, 1), cA + hstep, voffA);
        if (wr == 1) PG8_BAR;
        PG8_WAIT_V(4); PG8_BAR;
        PG8_STAGE(PG8_SB(1, 0), cB + kstep, voffB); PG8_STAGE(PG8_SA(1, 0), cA + kstep, voffA); PG8_STAGE(PG8_SB(1, 1), cB + hstep + kstep, voffB);
        PG8_WAIT_V(6); PG8_BAR;
    }
    for (;;) {
        const bool has_next = S.next(ui + 1, nxt);
        const char* nA = has_next ? (const char*)g.A + (size_t)nxt.pm * tstep : cA; const char* nB = has_next ? (const char*)g.Bt + (size_t)nxt.pn * tstep : cB;
        for (int t = 0; t < nt; t += 2) {
            const bool last = (t == nt - 2);
            const char* a1 = cA + (size_t)(t + 1) * kstep;
            const char* a2 = last ? nA : cA + (size_t)(t + 2) * kstep; const char* b2 = last ? nB : cB + (size_t)(t + 2) * kstep;
            const char* a3 = a2 + kstep; const char* b3 = b2 + kstep;
            if (last && has_next) S.a_ready(nxt);
            if constexpr (SP2) {
            PG8_LDB(B0, 0, 0); PG8_LDB(B1, 0, 1); PG8_SCHED; PG8_LDA(At, 0, 0); PG8_STAGE(PG8_SA(1, 1), a1 + hstep, voffA);
            PG8_WAIT_V(8); PG8_WAIT_L(0); PG8_BAR; PG8_MMA(0, 0, At, B0); PG8_MMA(0, 1, At, B1); PG8_BAR; PG8_SCHED;
            PG8_LDA(At, 0, 1); PG8_STAGE(PG8_SB(0, 0), b2, voffB); PG8_STAGE(PG8_SB(0, 1), b2 + hstep, voffB); PG8_STAGE(PG8_SA(0, 0), a2, voffA);
            PG8_WAIT_V(8); PG8_WAIT_L(0); PG8_BAR; PG8_MMA(1, 0, At, B0); PG8_MMA(1, 1, At, B1); PG8_BAR; PG8_SCHED;
            PG8_LDB(B0, 1, 0); PG8_LDB(B1, 1, 1); PG8_SCHED; PG8_LDA(At, 1, 0); PG8_STAGE(PG8_SA(0, 1), a2 + hstep, voffA);
            PG8_WAIT_V(8); PG8_WAIT_L(0); PG8_BAR; PG8_MMA(0, 0, At, B0); PG8_MMA(0, 1, At, B1); PG8_BAR; PG8_SCHED;
            PG8_LDA(At, 1, 1); PG8_STAGE(PG8_SB(1, 0), b3, voffB); PG8_STAGE(PG8_SB(1, 1), b3 + hstep, voffB); PG8_STAGE(PG8_SA(1, 0), a3, voffA);
            PG8_WAIT_V(8); PG8_WAIT_L(0); PG8_BAR; PG8_MMA(1, 0, At, B0); PG8_MMA(1, 1, At, B1); PG8_BAR; PG8_SCHED;
            } else {
            PG8_LDB(B0, 0, 0); PG8_SCHED; PG8_LDA(At, 0, 0); PG8_STAGE(PG8_SA(1, 1), a1 + hstep, voffA);
            PG8_WAIT_L(8); PG8_BAR; PG8_WAIT_L(0); PG8_MMA(0, 0, At, B0); PG8_BAR; PG8_SCHED;
            PG8_LDB(B1, 0, 1); PG8_STAGE(PG8_SB(0, 0), b2, voffB);
            PG8_BAR; PG8_WAIT_L(0); PG8_MMA(0, 1, At, B1); PG8_BAR;
            PG8_LDA(At, 0, 1); PG8_STAGE(PG8_SA(0, 0), a2, voffA);
            PG8_BAR; PG8_WAIT_L(0); PG8_MMA(1, 0, At, B0); PG8_BAR; PG8_SCHED;
            PG8_STAGE(PG8_SB(0, 1), b2 + hstep, voffB);
            PG8_WAIT_V(6); PG8_BAR; PG8_MMA(1, 1, At, B1); PG8_BAR;
            PG8_LDB(B0, 1, 0); PG8_SCHED; PG8_LDA(At, 1, 0); PG8_STAGE(PG8_SA(0, 1), a2 + hstep, voffA);
            PG8_WAIT_L(8); PG8_BAR; PG8_WAIT_L(0); PG8_MMA(0, 0, At, B0); PG8_BAR; PG8_SCHED;
            PG8_LDB(B1, 1, 1); PG8_STAGE(PG8_SB(1, 0), b3, voffB);
            PG8_BAR; PG8_WAIT_L(0); PG8_MMA(0, 1, At, B1); PG8_BAR;
            PG8_LDA(At, 1, 1); PG8_STAGE(PG8_SA(1, 0), a3, voffA);
            PG8_BAR; PG8_WAIT_L(0); PG8_MMA(1, 0, At, B0); PG8_BAR; PG8_SCHED;
            PG8_STAGE(PG8_SB(1, 1), b3 + hstep, voffB);
            PG8_WAIT_V(6); PG8_BAR; PG8_MMA(1, 1, At, B1); PG8_BAR;
            }
        }
        if constexpr (ALIGN_EPI) { if (wr == 0) PG8_BAR; }
        if constexpr (!Epi::AFTER_DRAIN) { E(acc, cur, wr, wc, fr, fq); S.done(cur); }
        if (!has_next) break;
#pragma unroll
        for (int a = 0; a < 2; ++a)
#pragma unroll
            for (int b = 0; b < 2; ++b)
#pragma unroll
                for (int m = 0; m < 4; ++m)
#pragma unroll
                    for (int n = 0; n < 2; ++n) acc[a][b][m][n] = (f32x4){0.f, 0.f, 0.f, 0.f};
        cur = nxt; cA = nA; cB = nB; ++ui;
        if constexpr (ALIGN_EPI) { if (wr == 1) PG8_BAR; }
    }
    PG8_WAIT_V(0);
    if constexpr (!ALIGN_EPI) { if (wr == 0) PG8_BAR; }
    PG8_BAR;
    if constexpr (Epi::AFTER_DRAIN) { E.fused(acc, cur, wr, wc, fr, fq, lds, wid, lane); S.done(cur); }
#undef PG8_SA
#undef PG8_SB
#undef PG8_STAGE
#undef PG8_LDA
#undef PG8_LDB
#undef PG8_MMA
#undef PG8_WAIT_V
#undef PG8_WAIT_L
#undef PG8_BAR
#undef PG8_SCHED
}
}

#ifndef MK_N_LAUNCHES
#define MK_N_LAUNCHES 1
#endif
#ifndef ATT_EARLY_EXIT
#define ATT_EARLY_EXIT 1
#endif
constexpr int NWAVES = 8;
constexpr int M = 16384, DM = 1024, SEQ = 2048, DEPTH = 4, NIN = 2816, DFF = 4096, PLE = 256;
constexpr float EPS = 1e-6f;
constexpr float C2 = 0.125f * 1.4426950408889634f;
constexpr int NPHASE = 1 + 6 * DEPTH;
#ifndef PROBE_B
#define PROBE_B 1
#endif
#ifndef PROBE_SYNC
#define PROBE_SYNC 1
#endif
#ifndef PROBE_P
#define PROBE_P 1
#endif
#ifndef PROBE_A
#define PROBE_A 1
#endif
#ifndef PROBE_D
#define PROBE_D 1
#endif

typedef unsigned short bf16;
#define LAS __attribute__((address_space(3)))
typedef unsigned v4u __attribute__((ext_vector_type(4)));
typedef unsigned v2u __attribute__((ext_vector_type(2)));
typedef float f32x4 __attribute__((ext_vector_type(4)));
typedef float f32x2 __attribute__((ext_vector_type(2)));
typedef float f32x16 __attribute__((ext_vector_type(16)));
typedef short bf16x8 __attribute__((ext_vector_type(8)));
typedef short s16x4 __attribute__((ext_vector_type(4)));
#define LDS_WAIT() asm volatile("s_waitcnt lgkmcnt(0)" ::: "memory")

constexpr size_t E_WIN = 0, E_WOUT = (size_t)NIN * DM, E_W1 = E_WOUT + (size_t)DM * DM, E_W2 = E_W1 + (size_t)DFF * DM, E_WG = E_W2 + (size_t)DFF * DM, E_WP = E_WG + (size_t)DM * DM,
                 E_WLAYER = E_WP + (size_t)PLE * DM;
constexpr size_t WS_W = 0, WS_WSB = WS_W + (size_t)DEPTH * E_WLAYER * 2, WS_SS = WS_WSB + (size_t)DEPTH * 4 * 128 * 128 * 2, WS_HB = WS_SS + (size_t)3 * M * 16 * 4,
                 WS_PB = WS_HB + (size_t)M * DM * 2, WS_XB = WS_PB + (size_t)M * PLE * 2, WS_BIG = WS_XB + (size_t)M * DM * 2, WS_END = WS_BIG + (size_t)M * DFF * 2;
constexpr size_t B_CONV = 0, B_Q = B_CONV + (size_t)3 * M * 256 * 2, B_K = B_Q + (size_t)M * 512 * 2, B_VT = B_K + (size_t)M * 512 * 2, B_CU = B_VT + (size_t)M * 512 * 2,
                 B_VNT = B_CU + (size_t)M * 256 * 2, B_Y = B_VNT + (size_t)M * 256 * 2, B_ENDMIX = B_Y + (size_t)M * DM * 2;
static_assert(B_ENDMIX <= (size_t)M * DFF * 2, "mixer tensors fit under the F overlay");
constexpr size_t WS_CTL = WS_END, CTL_BYTES = 16384, WS_TOTAL = WS_CTL + CTL_BYTES;
constexpr int RING_BYTES = 131072, LDS_BYTES = 132096;

__device__ __forceinline__ unsigned f2bf(float f) { unsigned u = __builtin_bit_cast(unsigned, f); return (u + 0x7fffu + ((u >> 16) & 1u)) >> 16; }
typedef __bf16 bf16x2_t __attribute__((ext_vector_type(2)));
__device__ __forceinline__ unsigned pk2(float lo, float hi) { f32x2 v = {lo, hi}; bf16x2_t b = __builtin_convertvector(v, bf16x2_t); return __builtin_bit_cast(unsigned, b); }
__device__ __forceinline__ float bflo(unsigned u) { return __builtin_bit_cast(float, u << 16); }
__device__ __forceinline__ float bfhi(unsigned u) { return __builtin_bit_cast(float, u & 0xffff0000u); }
__device__ __forceinline__ float wave_sum(float v) {
#pragma unroll
    for (int o = 1; o < 64; o <<= 1) v += __shfl_xor(v, o);
    return v;
}

__device__ __forceinline__ float row_rs(const float* ssp, int r) {
    const f32x4* q = (const f32x4*)(ssp + (size_t)r * 16); const f32x4 a = q[0], b = q[1], c = q[2], d = q[3];
    const float s = ((a[0] + a[1]) + (a[2] + a[3])) + ((b[0] + b[1]) + (b[2] + b[3])) + ((c[0] + c[1]) + (c[2] + c[3])) + ((d[0] + d[1]) + (d[2] + d[3]));
    return rsqrtf(s * (1.f / 1024.f) + EPS);
}
struct EpiInProj {
    static constexpr bool PERM = true, AFTER_DRAIN = false;
    const float* ss; bf16* conv; bf16* q; bf16* k; bf16* vt; bf16* cu; bf16* vnt; const float* qg; const float* kg; const float* sg;
    __device__ __forceinline__ void operator()(const pg8::f32x4 (&acc)[2][2][4][2], const pg8::Unit& u, int wr, int wc, int fr, int fq) const {
        const int sec = u.pn;
        const int row0 = u.pm * 256 + wr * 64 + fr;
        const int cw = 64 * wc + 8 * fq;
        const bool normed = (sec >= 3 && sec < 7) || sec == 10;
        float rsv[8];
#pragma unroll
        for (int g = 0; g < 8; ++g) { rsv[g] = row_rs(ss, row0 + (g >> 2) * 128 + (g & 3) * 16); if (g & 1) asm volatile("" : "+v"(rsv[g - 1]), "+v"(rsv[g]) :: "memory"); }
        f32x4 gv[2][2];
#pragma unroll
        for (int bj = 0; bj < 2; ++bj)
#pragma unroll
            for (int n = 0; n < 2; ++n) {
                if (sec >= 3 && sec < 7) { const float* g = sec < 5 ? qg : kg; const float sc = sec < 5 ? C2 : 1.f; gv[bj][n] = *(const f32x4*)(g + 32 * bj + 8 * fq + 4 * n) * sc; }
                else if (sec == 10) gv[bj][n] = *(const f32x4*)(sg + cw + 32 * bj + 4 * n);
                else gv[bj][n] = (f32x4){1.f, 1.f, 1.f, 1.f};
            }
#pragma unroll
        for (int ai = 0; ai < 2; ++ai)
#pragma unroll
            for (int m = 0; m < 4; ++m) {
                const int r = row0 + ai * 128 + m * 16;
                const float rs = rsv[ai * 4 + m];
                f32x4 v[2][2];
#pragma unroll
                for (int bj = 0; bj < 2; ++bj)
#pragma unroll
                    for (int n = 0; n < 2; ++n) v[bj][n] = acc[ai][bj][m][n] * rs;
                if (sec >= 9) {
#pragma unroll
                    for (int bj = 0; bj < 2; ++bj)
#pragma unroll
                        for (int n = 0; n < 2; ++n) { const pg8::f32x2 a = pg8::gelu_pk((pg8::f32x2){v[bj][n][0], v[bj][n][1]}), b = pg8::gelu_pk((pg8::f32x2){v[bj][n][2], v[bj][n][3]}); v[bj][n] = (f32x4){a.x, a.y, b.x, b.y}; }
                }
                if (normed) {
                    float s2 = 0.f;
#pragma unroll
                    for (int bj = 0; bj < 2; ++bj)
#pragma unroll
                        for (int n = 0; n < 2; ++n) { const f32x4 x = v[bj][n]; s2 += (x[0] * x[0] + x[1] * x[1]) + (x[2] * x[2] + x[3] * x[3]); }
                    s2 += __shfl_xor(s2, 16); s2 += __shfl_xor(s2, 32);
                    const float rn = rsqrtf(s2 * (1.f / 64.f) + EPS);
#pragma unroll
                    for (int bj = 0; bj < 2; ++bj)
#pragma unroll
                        for (int n = 0; n < 2; ++n) v[bj][n] = v[bj][n] * rn * gv[bj][n];
                }
                const int b = r >> 11, s = r & 2047;
                if (sec == 10) {
                    bf16* base = vnt + ((size_t)(b * 4 + wc) * 64) * SEQ + s;
#pragma unroll
                    for (int bj = 0; bj < 2; ++bj)
#pragma unroll
                        for (int n = 0; n < 2; ++n)
#pragma unroll
                            for (int j = 0; j < 4; ++j) base[(size_t)(32 * bj + 8 * fq + 4 * n + j) * SEQ] = (bf16)f2bf(v[bj][n][j]);
                } else if (sec == 7 || sec == 8) {
                    const int kk_ = s & 31;
                    bf16* base = vt + (((size_t)((b * 8 + 4 * (sec - 7) + wc) * 64 + (s >> 5)) * 4 + (kk_ >> 4)) * 64 + ((kk_ >> 3) & 1) * 32 + 8 * fq) * 8 + (kk_ & 7);
#pragma unroll
                    for (int bj = 0; bj < 2; ++bj)
#pragma unroll
                        for (int n = 0; n < 2; ++n)
#pragma unroll
                            for (int j = 0; j < 4; ++j) base[(size_t)bj * 2 * 64 * 8 + (4 * n + j) * 8] = (bf16)f2bf(v[bj][n][j]);
                } else if (sec >= 3 && sec < 7) {
                    const bool isq = sec < 5;
                    const int sl = s & 31, pos = isq ? sl : ((sl & 0x13) | ((sl & 4) << 1) | ((sl & 8) >> 1));
                    bf16* base = (isq ? q : k) + (((size_t)((b * 8 + 4 * ((sec - 3) & 1) + wc) * 64 + (s >> 5)) * 4 + (fq >> 1)) * 64 + (fq & 1) * 32 + pos) * 8;
#pragma unroll
                    for (int bj = 0; bj < 2; ++bj) { v4u w; w.x = pk2(v[bj][0][0], v[bj][0][1]); w.y = pk2(v[bj][0][2], v[bj][0][3]); w.z = pk2(v[bj][1][0], v[bj][1][1]); w.w = pk2(v[bj][1][2], v[bj][1][3]);
                        *(v4u*)(base + (size_t)bj * 2 * 64 * 8) = w; }
                } else {
                    bf16* dst; int ld;
                    if (sec < 3) { dst = conv + (size_t)sec * M * 256 + cw; ld = 256; }
                    else { dst = cu + cw; ld = 256; }
                    dst += (size_t)r * ld;
#pragma unroll
                    for (int bj = 0; bj < 2; ++bj) { v4u w; w.x = pk2(v[bj][0][0], v[bj][0][1]); w.y = pk2(v[bj][0][2], v[bj][0][3]); w.z = pk2(v[bj][1][0], v[bj][1][1]); w.w = pk2(v[bj][1][2], v[bj][1][3]);
                        *(v4u*)(dst + 32 * bj) = w; }
                }
            }
    }
};

struct EpiRes {
    static constexpr bool PERM = true, AFTER_DRAIN = false;
    const float* base; float* out; bf16* outb; float* ssout;
    __device__ __forceinline__ void operator()(const pg8::f32x4 (&acc)[2][2][4][2], const pg8::Unit& u, int wr, int wc, int fr, int fq) const {
        const int row0 = u.pm * 256 + wr * 64 + fr, col0 = u.pn * 256 + wc * 32 + 8 * fq;
        constexpr int LA = 2;
        f32x4 bq[8][4];
#pragma unroll
        for (int g = 0; g < LA; ++g) { const size_t off = (size_t)(row0 + (g >> 2) * 128 + (g & 3) * 16) * DM + col0;
#pragma unroll
            for (int bj = 0; bj < 2; ++bj) { bq[g][2 * bj] = *(const f32x4*)(base + off + bj * 128); bq[g][2 * bj + 1] = *(const f32x4*)(base + off + bj * 128 + 4); } }
#pragma unroll
        for (int g = 0; g < 8; ++g) {
            if (g + LA < 8) { const int gn = g + LA; const size_t off = (size_t)(row0 + (gn >> 2) * 128 + (gn & 3) * 16) * DM + col0;
#pragma unroll
                for (int bj = 0; bj < 2; ++bj) { bq[gn][2 * bj] = *(const f32x4*)(base + off + bj * 128); bq[gn][2 * bj + 1] = *(const f32x4*)(base + off + bj * 128 + 4); } }
            const int ai = g >> 2, m = g & 3;
            const int r = row0 + ai * 128 + m * 16; const size_t off = (size_t)r * DM + col0; float s2 = 0.f;
#pragma unroll
            for (int bj = 0; bj < 2; ++bj) {
                const f32x4 h0 = bq[g][2 * bj] + acc[ai][bj][m][0], h1 = bq[g][2 * bj + 1] + acc[ai][bj][m][1];
                *(f32x4*)(out + off + bj * 128) = h0; *(f32x4*)(out + off + bj * 128 + 4) = h1;
                v4u w; w.x = pk2(h0[0], h0[1]); w.y = pk2(h0[2], h0[3]); w.z = pk2(h1[0], h1[1]); w.w = pk2(h1[2], h1[3]); *(v4u*)(outb + off + bj * 128) = w;
                s2 += (h0[0] * h0[0] + h0[1] * h0[1]) + (h0[2] * h0[2] + h0[3] * h0[3]) + (h1[0] * h1[0] + h1[1] * h1[1]) + (h1[2] * h1[2] + h1[3] * h1[3]);
            }
            s2 += __shfl_xor(s2, 16); s2 += __shfl_xor(s2, 32);
            if (fq == 0) ssout[(size_t)r * 16 + u.pn * 4 + wc] = s2;
            asm volatile("" ::: "memory");
        }
    }
};
struct EpiFF1 {
    static constexpr bool PERM = true, AFTER_DRAIN = false;
    const float* ss; bf16* f;
    __device__ __forceinline__ void operator()(const pg8::f32x4 (&acc)[2][2][4][2], const pg8::Unit& u, int wr, int wc, int fr, int fq) const {
        const int row0 = u.pm * 256 + wr * 64 + fr, col0 = u.pn * 256 + wc * 32 + 8 * fq;
        float rsv[8];
#pragma unroll
        for (int g = 0; g < 8; ++g) { rsv[g] = row_rs(ss, row0 + (g >> 2) * 128 + (g & 3) * 16); if (g & 1) asm volatile("" : "+v"(rsv[g - 1]), "+v"(rsv[g]) :: "memory"); }
#pragma unroll
        for (int ai = 0; ai < 2; ++ai)
#pragma unroll
            for (int m = 0; m < 4; ++m) {
                const int r = row0 + ai * 128 + m * 16; const float rs = rsv[ai * 4 + m]; bf16* dst = f + (size_t)r * DFF + col0;
#pragma unroll
                for (int bj = 0; bj < 2; ++bj) {
                    f32x4 a = acc[ai][bj][m][0] * rs, b = acc[ai][bj][m][1] * rs;
#pragma unroll
                    for (int j = 0; j < 4; ++j) { a[j] = fmaxf(a[j], 0.f); a[j] *= a[j]; b[j] = fmaxf(b[j], 0.f); b[j] *= b[j]; }
                    v4u w; w.x = pk2(a[0], a[1]); w.y = pk2(a[2], a[3]); w.z = pk2(b[0], b[1]); w.w = pk2(b[2], b[3]); *(v4u*)(dst + bj * 128) = w;
                }
            }
    }
};
struct EpiT {
    static constexpr bool PERM = true, AFTER_DRAIN = false;
    bf16* t;
    __device__ __forceinline__ void operator()(const pg8::f32x4 (&acc)[2][2][4][2], const pg8::Unit& u, int wr, int wc, int fr, int fq) const {
        const int row0 = u.pm * 256 + wr * 64 + fr, col0 = u.pn * 256 + wc * 32 + 8 * fq;
#pragma unroll
        for (int ai = 0; ai < 2; ++ai)
#pragma unroll
            for (int m = 0; m < 4; ++m) {
                bf16* dst = t + (size_t)(row0 + ai * 128 + m * 16) * DM + col0;
#pragma unroll
                for (int bj = 0; bj < 2; ++bj) { const f32x4 a = acc[ai][bj][m][0], b = acc[ai][bj][m][1];
                    v4u w; w.x = pk2(a[0], a[1]); w.y = pk2(a[2], a[3]); w.z = pk2(b[0], b[1]); w.w = pk2(b[2], b[3]); *(v4u*)(dst + bj * 128) = w; }
            }
    }
};
struct EpiGate {
    static constexpr bool PERM = true, AFTER_DRAIN = false;
    const float* ss; float* h; bf16* tx; float* ssout;
    __device__ __forceinline__ void operator()(const pg8::f32x4 (&acc)[2][2][4][2], const pg8::Unit& u, int wr, int wc, int fr, int fq) const {
        const int row0 = u.pm * 256 + wr * 64 + fr, col0 = u.pn * 256 + wc * 32 + 8 * fq;
        float rsv[8];
#pragma unroll
        for (int g = 0; g < 8; ++g) { rsv[g] = row_rs(ss, row0 + (g >> 2) * 128 + (g & 3) * 16) * (-1.4426950408889634f); if (g & 1) asm volatile("" : "+v"(rsv[g - 1]), "+v"(rsv[g]) :: "memory"); }
        constexpr int LA = 1;
        f32x4 hq[8][4]; v4u tq[8][2];
#pragma unroll
        for (int g = 0; g < LA; ++g) { const size_t off = (size_t)(row0 + (g >> 2) * 128 + (g & 3) * 16) * DM + col0;
#pragma unroll
            for (int bj = 0; bj < 2; ++bj) { tq[g][bj] = *(const v4u*)(tx + off + bj * 128); hq[g][2 * bj] = *(const f32x4*)(h + off + bj * 128); hq[g][2 * bj + 1] = *(const f32x4*)(h + off + bj * 128 + 4); } }
#pragma unroll
        for (int g = 0; g < 8; ++g) {
            if (g + LA < 8) { const int gn = g + LA; const size_t off = (size_t)(row0 + (gn >> 2) * 128 + (gn & 3) * 16) * DM + col0;
#pragma unroll
                for (int bj = 0; bj < 2; ++bj) { tq[gn][bj] = *(const v4u*)(tx + off + bj * 128); hq[gn][2 * bj] = *(const f32x4*)(h + off + bj * 128); hq[gn][2 * bj + 1] = *(const f32x4*)(h + off + bj * 128 + 4); } }
            const int ai = g >> 2, m = g & 3;
            const int r = row0 + ai * 128 + m * 16; const float rs = rsv[g]; const size_t off = (size_t)r * DM + col0; float s2 = 0.f;
#pragma unroll
            for (int bj = 0; bj < 2; ++bj) {
                const v4u tw = tq[g][bj];
                const f32x4 t0 = (f32x4){bflo(tw.x), bfhi(tw.x), bflo(tw.y), bfhi(tw.y)}, t1 = (f32x4){bflo(tw.z), bfhi(tw.z), bflo(tw.w), bfhi(tw.w)};
                f32x4 g0 = acc[ai][bj][m][0] * rs, g1 = acc[ai][bj][m][1] * rs;
#pragma unroll
                for (int j = 0; j < 4; ++j) { g0[j] = __builtin_amdgcn_rcpf(1.f + __builtin_amdgcn_exp2f(g0[j])); g1[j] = __builtin_amdgcn_rcpf(1.f + __builtin_amdgcn_exp2f(g1[j])); }
                const f32x4 h0 = hq[g][2 * bj] + g0 * t0, h1 = hq[g][2 * bj + 1] + g1 * t1;
                *(f32x4*)(h + off + bj * 128) = h0; *(f32x4*)(h + off + bj * 128 + 4) = h1;
                v4u w; w.x = pk2(h0[0], h0[1]); w.y = pk2(h0[2], h0[3]); w.z = pk2(h1[0], h1[1]); w.w = pk2(h1[2], h1[3]); *(v4u*)(tx + off + bj * 128) = w;
                s2 += (h0[0] * h0[0] + h0[1] * h0[1]) + (h0[2] * h0[2] + h0[3] * h0[3]) + (h1[0] * h1[0] + h1[1] * h1[1]) + (h1[2] * h1[2] + h1[3] * h1[3]);
            }
            s2 += __shfl_xor(s2, 16); s2 += __shfl_xor(s2, 32);
            if (fq == 0) ssout[(size_t)r * 16 + u.pn * 4 + wc] = s2;
            asm volatile("" ::: "memory");
        }
    }
};

struct TSched {
    int c, c0, G;
    __device__ __forceinline__ bool next(int i, pg8::Unit& u) const { if (c < c0) return false; const int un = (c - c0) + i * (G - c0); if (un >= 256) return false; u.pm = un >> 2; u.pn = un & 3; return true; }
    __device__ __forceinline__ void a_ready(const pg8::Unit&) const {}
    __device__ __forceinline__ void done(const pg8::Unit&) const {}
};
__device__ __forceinline__ void tr_item(const float* W, int K, int N, bf16* WT, LAS float* scr, int item, int lane, const float* g, bool hperm) {
    const int nblk = N / 32, kb = item / nblk, nb = item % nblk, k0 = 64 * kb, n0 = 32 * nb;
    const int kr = lane >> 3, nq = (lane & 7) * 4;
    f32x4 v[8];
#pragma unroll
    for (int i = 0; i < 8; ++i) v[i] = *(const f32x4*)(W + (size_t)(k0 + 8 * i + kr) * N + n0 + nq);
    if (g) {
#pragma unroll
        for (int i = 0; i < 8; ++i) v[i] = v[i] * g[k0 + 8 * i + kr];
    }
#pragma unroll
    for (int i = 0; i < 8; ++i) { LAS float* d = scr + (8 * i + kr) * 33 + nq; d[0] = v[i][0]; d[1] = v[i][1]; d[2] = v[i][2]; d[3] = v[i][3]; }
    LDS_WAIT(); asm volatile("" ::: "memory");
    int d0 = n0; if (hperm) { const int gi = (n0 >> 5) & 7; d0 = (n0 & ~255) + 32 * (4 * (gi & 1) + (gi >> 1)); }
    const int c = lane & 7;
#pragma unroll
    for (int j = 0; j < 4; ++j) { const int n = (lane >> 3) + 8 * j; const LAS float* sp = scr + (8 * c) * 33 + n;
        v4u o; o.x = pk2(sp[0 * 33], sp[1 * 33]); o.y = pk2(sp[2 * 33], sp[3 * 33]); o.z = pk2(sp[4 * 33], sp[5 * 33]); o.w = pk2(sp[6 * 33], sp[7 * 33]);
        *(v4u*)(WT + (size_t)(d0 + n) * K + k0 + 8 * c) = o; }
    LDS_WAIT(); asm volatile("" ::: "memory");
}

__device__ __forceinline__ int crow(int r, int hf) { return (r & 3) + 8 * (r >> 2) + 4 * hf; }
__device__ __forceinline__ void attn_task(const bf16* Q, const bf16* K, const bf16* VT, bf16* Y, int b, int h, int qb, int lane) {
    const int t = lane & 31, hf = lane >> 5, q0 = qb * 32;
    const size_t hb = (size_t)(b * 8 + h) * 64;
    const bf16* qp = Q + ((hb + qb) * 4 * 64 + lane) * 8;
    bf16x8 qr[4];
#pragma unroll
    for (int kk = 0; kk < 4; ++kk) qr[kk] = *(const bf16x8*)(qp + kk * 512);
    const bf16* kbase = K + (hb * 4 * 64 + lane) * 8;
    const bf16* vbase = VT + (hb * 4 * 64 + lane) * 8;
    f32x16 o0, o1;
#pragma unroll
    for (int r = 0; r < 16; ++r) { o0[r] = 0.f; o1[r] = 0.f; }
    float carry = 1.f;
    bf16x8 kn[4], vn[4];
#pragma unroll
    for (int i = 0; i < 4; ++i) { kn[i] = *(const bf16x8*)(kbase + (size_t)qb * 2048 + i * 512); vn[i] = *(const bf16x8*)(vbase + (size_t)qb * 2048 + i * 512); }
    for (int j = qb; j >= 0; --j) {
        bf16x8 kf[4], vf[4];
#pragma unroll
        for (int i = 0; i < 4; ++i) { kf[i] = kn[i]; vf[i] = vn[i]; }
        { const int jn = j > 0 ? j - 1 : 0;
#pragma unroll
          for (int i = 0; i < 4; ++i) { kn[i] = *(const bf16x8*)(kbase + (size_t)jn * 2048 + i * 512); vn[i] = *(const bf16x8*)(vbase + (size_t)jn * 2048 + i * 512); } }
        f32x16 z;
#pragma unroll
        for (int r = 0; r < 16; ++r) z[r] = 0.f;
#pragma unroll
        for (int kk = 0; kk < 4; ++kk) z = __builtin_amdgcn_mfma_f32_32x32x16_bf16(kf[kk], qr[kk], z, 0, 0, 0);
        float om[16], w[16];
        const bool diag = (j == qb);
#pragma unroll
        for (int r = 0; r < 16; ++r) {
            const float e = __builtin_amdgcn_exp2f(fminf(z[r], 100.f));
            float o = __builtin_amdgcn_rcpf(1.f + e), bt = e * o;
            if (diag) { const bool valid = (16 * (r >> 3) + 8 * hf + (r & 7)) < t; o = valid ? o : 1.f; bt = valid ? bt : 0.f; }
            om[r] = o; w[r] = bt;
        }
        float R[2];
#pragma unroll
        for (int ks = 0; ks < 2; ++ks) {
            float x = om[8 * ks + 7];
#pragma unroll
            for (int jj = 6; jj >= 0; --jj) { w[8 * ks + jj] *= x; x *= om[8 * ks + jj]; }
            R[ks] = x;
        }
        const float Rp0 = __shfl_xor(R[0], 32), Rp1 = __shfl_xor(R[1], 32);
        const float T1 = R[1] * Rp1, T0 = R[0] * Rp0;
        const float L1 = hf ? carry : carry * Rp1;
        const float c0 = carry * T1, L0 = hf ? c0 : c0 * Rp0;
        carry = c0 * T0;
#pragma unroll
        for (int jj = 0; jj < 8; ++jj) { w[jj] *= L0; w[8 + jj] *= L1; }
#pragma unroll
        for (int ks = 0; ks < 2; ++ks) {
            v4u pw; pw.x = pk2(w[8 * ks], w[8 * ks + 1]); pw.y = pk2(w[8 * ks + 2], w[8 * ks + 3]); pw.z = pk2(w[8 * ks + 4], w[8 * ks + 5]); pw.w = pk2(w[8 * ks + 6], w[8 * ks + 7]);
            const bf16x8 pf = __builtin_bit_cast(bf16x8, pw);
            o0 = __builtin_amdgcn_mfma_f32_32x32x16_bf16(vf[ks], pf, o0, 0, 0, 0);
            o1 = __builtin_amdgcn_mfma_f32_32x32x16_bf16(vf[2 + ks], pf, o1, 0, 0, 0);
        }
#if ATT_EARLY_EXIT
        if (__all(carry == 0.f)) break;
#endif
    }
    bf16* yp = Y + (size_t)(b * SEQ + q0 + t) * DM + 256 + h * 64 + 4 * hf;
#pragma unroll
    for (int g = 0; g < 4; ++g) {
        v2u a; a.x = pk2(o0[4 * g], o0[4 * g + 1]); a.y = pk2(o0[4 * g + 2], o0[4 * g + 3]); *(v2u*)(yp + 8 * g) = a;
        v2u c; c.x = pk2(o1[4 * g], o1[4 * g + 1]); c.y = pk2(o1[4 * g + 2], o1[4 * g + 3]); *(v2u*)(yp + 32 + 8 * g) = c;
    }
}
__device__ __forceinline__ void sgu_task(const bf16* VNT, const bf16* WSB, const bf16* CU, const float* bias, bf16* Y, int task, int lane) {
    const int tb = task & 3, g = (task >> 2) & 3, c = (task >> 4) & 15, b = task >> 8;
    const int t = lane & 31, hf = lane >> 5;
    const bf16* ap = VNT + (size_t)((b * 4 + g) * 64 + t) * SEQ + 128 * c + 8 * hf;
    const bf16* bp = WSB + (size_t)(g * 128 + 32 * tb + t) * 128 + 8 * hf;
    f32x16 a0, a1;
#pragma unroll
    for (int r = 0; r < 16; ++r) { a0[r] = 0.f; a1[r] = 0.f; }
    bf16x8 bfr[8], af0[8], af1[8];
#pragma unroll
    for (int ks = 0; ks < 8; ++ks) { bfr[ks] = *(const bf16x8*)(bp + 16 * ks); af0[ks] = *(const bf16x8*)(ap + 16 * ks); af1[ks] = *(const bf16x8*)(ap + (size_t)32 * SEQ + 16 * ks); }
#pragma unroll
    for (int ks = 0; ks < 8; ++ks) {
        a0 = __builtin_amdgcn_mfma_f32_32x32x16_bf16(af0[ks], bfr[ks], a0, 0, 0, 0);
        a1 = __builtin_amdgcn_mfma_f32_32x32x16_bf16(af1[ks], bfr[ks], a1, 0, 0, 0);
    }
    const int tok = b * SEQ + 128 * c + 32 * tb + t;
    const float bs = bias[g * 128 + 32 * tb + t];
    const bf16* up = CU + (size_t)tok * 256 + 64 * g + 4 * hf;
    bf16* yp = Y + (size_t)tok * DM + 768 + 64 * g + 4 * hf;
#pragma unroll
    for (int gg = 0; gg < 4; ++gg) {
        const v2u u0 = *(const v2u*)(up + 8 * gg), u1 = *(const v2u*)(up + 32 + 8 * gg);
        v2u a; a.x = pk2(bflo(u0.x) * (a0[4 * gg] + bs), bfhi(u0.x) * (a0[4 * gg + 1] + bs)); a.y = pk2(bflo(u0.y) * (a0[4 * gg + 2] + bs), bfhi(u0.y) * (a0[4 * gg + 3] + bs)); *(v2u*)(yp + 8 * gg) = a;
        v2u d; d.x = pk2(bflo(u1.x) * (a1[4 * gg] + bs), bfhi(u1.x) * (a1[4 * gg + 1] + bs)); d.y = pk2(bflo(u1.y) * (a1[4 * gg + 2] + bs), bfhi(u1.y) * (a1[4 * gg + 3] + bs)); *(v2u*)(yp + 32 + 8 * gg) = d;
    }
}
__device__ __forceinline__ void unpack8(const v4u w, float (&f)[8]) { f[0] = bflo(w.x); f[1] = bfhi(w.x); f[2] = bflo(w.y); f[3] = bfhi(w.y); f[4] = bflo(w.z); f[5] = bfhi(w.z); f[6] = bflo(w.w); f[7] = bfhi(w.w); }
__device__ __forceinline__ void conv_task(const bf16* CONV, const float* cwt, bf16* Y, int task, int lane) {
    const int ch = (lane & 31) * 8;
    float w0[8], w1[8], w2[8];
#pragma unroll
    for (int e = 0; e < 8; ++e) { w0[e] = cwt[ch + e]; w1[e] = cwt[256 + ch + e]; w2[e] = cwt[512 + ch + e]; }
    const bf16* ab = CONV; const bf16* ac = CONV + (size_t)M * 256; const bf16* ah = CONV + (size_t)2 * M * 256;
#pragma unroll 2
    for (int it = 0; it < 8; ++it) {
        const int tok = task * 16 + it * 2 + (lane >> 5), s = tok & (SEQ - 1);
        const size_t o = (size_t)tok * 256 + ch;
        float fb[8], c0[8], h0[8], c1[8], h1[8], c2[8], h2[8];
        unpack8(*(const v4u*)(ab + o), fb); unpack8(*(const v4u*)(ac + o), c0); unpack8(*(const v4u*)(ah + o), h0);
        const v4u zz = (v4u){0u, 0u, 0u, 0u};
        unpack8(s >= 1 ? *(const v4u*)(ac + o - 256) : zz, c1); unpack8(s >= 1 ? *(const v4u*)(ah + o - 256) : zz, h1);
        unpack8(s >= 2 ? *(const v4u*)(ac + o - 512) : zz, c2); unpack8(s >= 2 ? *(const v4u*)(ah + o - 512) : zz, h2);
        float y[8];
#pragma unroll
        for (int e = 0; e < 8; ++e) y[e] = fb[e] * (w2[e] * (c0[e] * h0[e]) + w1[e] * (c1[e] * h1[e]) + w0[e] * (c2[e] * h2[e]));
        v4u w; w.x = pk2(y[0], y[1]); w.y = pk2(y[2], y[3]); w.z = pk2(y[4], y[5]); w.w = pk2(y[6], y[7]);
        *(v4u*)(Y + (size_t)tok * DM + ch) = w;
    }
}

#define RLX_AGENT __ATOMIC_RELAXED, __HIP_MEMORY_SCOPE_AGENT
#define XB_TMO      128
#define XB_XCNT(j)  (256  + 64 * (j))
#define XB_XSUB(j)  (1280 + 64 * (j))
#define XB_XGEN(j)  (2304 + 64 * (j))
#define XB_TOP      3328
#define XB_TOPGEN   3392
#define XCD_BAR_WORDS 3456
#define XB_SPIN_CAP (1u << 18)

__device__ __forceinline__ unsigned xb_ld(unsigned* p)              { return __hip_atomic_load(p, __ATOMIC_RELAXED, __HIP_MEMORY_SCOPE_AGENT); }
__device__ __forceinline__ unsigned xb_add(unsigned* p, unsigned v) { return __hip_atomic_fetch_add(p, v, __ATOMIC_RELAXED, __HIP_MEMORY_SCOPE_AGENT); }
__device__ __forceinline__ unsigned xb_xcc_id() { return (unsigned)__builtin_amdgcn_s_getreg((3 << 11) | 20) & 0xFu; }
#define XB_SPIN(cond, bar) do { unsigned _sp = 0; while (cond) { __builtin_amdgcn_s_sleep(1); \
    if ((++_sp & 255u) == 0u) { if (xb_ld(&(bar)[XB_TMO])) break; if (_sp > XB_SPIN_CAP) { atomicAdd(&(bar)[XB_TMO], 1u); break; } } } } while (0)

struct XcdBarrier {
    unsigned* bar; unsigned x;
    volatile LAS unsigned* st;
};

__device__ __forceinline__ XcdBarrier xcd_barrier_post(unsigned* bar, volatile LAS unsigned* st) {
    XcdBarrier b; b.bar = bar; b.x = xb_xcc_id(); b.st = st;
    if (threadIdx.x == 0) (void)xb_add(&bar[XB_XCNT(b.x)], 1u);
    return b;
}
__device__ __forceinline__ void xcd_barrier_complete(unsigned* bar, unsigned x, unsigned& nloc, unsigned& nx) {
    const unsigned G = gridDim.x * gridDim.y * gridDim.z;
    unsigned sum, cnt, mine, sp = 0u;
    for (;;) {
        sum = 0u; cnt = 0u; mine = 0u;
#pragma unroll
        for (unsigned j = 0; j < 16; ++j) { const unsigned c = xb_ld(&bar[XB_XCNT(j)]); sum += c; cnt += (c > 0u) ? 1u : 0u; mine = (j == x) ? c : mine; }
        if (sum == G) break;
        __builtin_amdgcn_s_sleep(1);
        if ((++sp & 255u) == 0u) { if (xb_ld(&bar[XB_TMO])) break; if (sp > XB_SPIN_CAP) { atomicAdd(&bar[XB_TMO], 1u); break; } }
    }
    nloc = mine > 0u ? mine : 1u; nx = cnt > 0u ? cnt : 1u;
}

__device__ __forceinline__ void xcd_barrier(const XcdBarrier& b) {
    asm volatile("s_waitcnt vmcnt(0)" ::: "memory");
    __syncthreads();
    if (threadIdx.x == 0) {
        unsigned* bar = b.bar;
        __builtin_amdgcn_s_waitcnt(0);
        unsigned nloc = b.st[0], nx = b.st[1];
        if (nloc == 0u) { xcd_barrier_complete(bar, b.x, nloc, nx); b.st[0] = nloc; b.st[1] = nx; }
        const unsigned old = xb_add(&bar[XB_XSUB(b.x)], 1u);
        const unsigned gen = old / nloc;
        if (old + 1u == (gen + 1u) * nloc) {
            __builtin_amdgcn_fence(__ATOMIC_RELEASE, "agent");
            asm volatile("s_waitcnt vmcnt(0)" ::: "memory");
            const unsigned og = xb_add(&bar[XB_TOP], 1u);
            const unsigned tg = og / nx;
            if (og + 1u == (tg + 1u) * nx) xb_add(&bar[XB_TOPGEN], 1u);
            else XB_SPIN(xb_ld(&bar[XB_TOPGEN]) == tg, bar);
            __builtin_amdgcn_fence(__ATOMIC_ACQUIRE, "agent");
            xb_add(&bar[XB_XGEN(b.x)], 1u);
            asm volatile("s_waitcnt vmcnt(0)" ::: "memory");
        } else {
            XB_SPIN(xb_ld(&bar[XB_XGEN(b.x)]) == gen, bar);
            __builtin_amdgcn_fence(__ATOMIC_ACQUIRE, "agent");
            asm volatile("s_waitcnt vmcnt(0)" ::: "memory");
        }
    }
    __syncthreads();
}

struct Args { const float* in[17]; float* out; unsigned char* ws; int ph_lo, ph_hi; };
__global__ void __launch_bounds__(NWAVES * 64, 2) mk_fwd(Args a) {
    extern __shared__ __attribute__((aligned(16))) unsigned char lds_raw[];
    LAS unsigned char* lds = (LAS unsigned char*)lds_raw;
    const int tid = threadIdx.x, lane = tid & 63, wave = __builtin_amdgcn_readfirstlane(tid >> 6);
    const int G = gridDim.x; const int bx = blockIdx.x; const int vcu = (G % 8 == 0) ? (bx % 8) * (G / 8) + bx / 8 : bx;
    const int gw = vcu * NWAVES + wave, NGW = G * NWAVES;
    const int lo = a.ph_lo, hi = a.ph_hi;
    volatile LAS unsigned* bst = (volatile LAS unsigned*)(lds + RING_BYTES);
    if (tid < 4) bst[tid] = 0u;
    __syncthreads();
    XcdBarrier bar = xcd_barrier_post((unsigned*)(a.ws + WS_CTL), bst);
    unsigned char* ws = a.ws;
    const float* x = a.in[0]; const float* p = a.in[1];
    bf16* Wb = (bf16*)(ws + WS_W); bf16* WSBb = (bf16*)(ws + WS_WSB); float* SS = (float*)(ws + WS_SS);
    bf16* HB = (bf16*)(ws + WS_HB); bf16* PB = (bf16*)(ws + WS_PB); bf16* XB = (bf16*)(ws + WS_XB);
    unsigned char* big = ws + WS_BIG;
    bf16* CONV = (bf16*)(big + B_CONV); bf16* Qb = (bf16*)(big + B_Q); bf16* Kb = (bf16*)(big + B_K); bf16* VTb = (bf16*)(big + B_VT); bf16* CUb = (bf16*)(big + B_CU);
    bf16* VNTb = (bf16*)(big + B_VNT); bf16* Yb = (bf16*)(big + B_Y); bf16* Fb = (bf16*)big;
    float* H = a.out;
#define IN(k) (lo <= (k) && (k) < hi)
#define SEAM(k) do { if (IN(k) && IN((k) + 1)) { if ((k) == 0) cg::this_grid().sync(); else xcd_barrier(bar); } } while (0)

    if (IN(0)) for (int rep_ = 0; rep_ < PROBE_P; ++rep_) {
        LAS float* scr = (LAS float*)(lds + wave * 16384);
        constexpr int I_IN = (DM / 64) * (NIN / 32), I_OUT = (DM / 64) * (DM / 32), I_1 = (DM / 64) * (DFF / 32), I_2 = (DFF / 64) * (DM / 32), I_G = I_OUT, I_P = (PLE / 64) * (DM / 32);
        constexpr int I_LAYER = I_IN + I_OUT + I_1 + I_2 + I_G + I_P;
        for (int it = gw; it < DEPTH * I_LAYER; it += NGW) {
            const int l = it / I_LAYER; int r = it % I_LAYER; bf16* wl = Wb + (size_t)l * E_WLAYER;
            if (r < I_IN) { tr_item(a.in[3] + (size_t)l * DM * NIN, DM, NIN, wl + E_WIN, scr, r, lane, a.in[2] + l * DM, true); continue; } r -= I_IN;
            if (r < I_OUT) { tr_item(a.in[10] + (size_t)l * DM * DM, DM, DM, wl + E_WOUT, scr, r, lane, nullptr, false); continue; } r -= I_OUT;
            if (r < I_1) { tr_item(a.in[12] + (size_t)l * DM * DFF, DM, DFF, wl + E_W1, scr, r, lane, a.in[11] + l * DM, false); continue; } r -= I_1;
            if (r < I_2) { tr_item(a.in[13] + (size_t)l * DFF * DM, DFF, DM, wl + E_W2, scr, r, lane, nullptr, false); continue; } r -= I_2;
            if (r < I_G) { tr_item(a.in[15] + (size_t)l * DM * DM, DM, DM, wl + E_WG, scr, r, lane, a.in[14] + l * DM, false); continue; } r -= I_G;
            tr_item(a.in[16] + (size_t)l * PLE * DM, PLE, DM, wl + E_WP, scr, r, lane, nullptr, false);
        }
        for (int i = gw * 64 + lane; i < DEPTH * 4 * 128 * 128; i += NGW * 64) { const int s = i & 127, t = (i >> 7) & 127; WSBb[i] = (bf16)f2bf(s <= t ? a.in[8][i] : 0.f); }
        for (int m = gw; m < M; m += NGW) {
            const f32x4* xr = (const f32x4*)(x + (size_t)m * DM) + lane; f32x4 v[4]; float s = 0.f;
#pragma unroll
            for (int j = 0; j < 4; ++j) { v[j] = xr[64 * j]; s += (v[j].x * v[j].x + v[j].y * v[j].y) + (v[j].z * v[j].z + v[j].w * v[j].w); }
            s = wave_sum(s);
            v2u* o8 = (v2u*)(XB + (size_t)m * DM) + lane;
#pragma unroll
            for (int j = 0; j < 4; ++j) { v2u w; w.x = pk2(v[j].x, v[j].y); w.y = pk2(v[j].z, v[j].w); o8[64 * j] = w; }
            if (lane < 16) SS[(size_t)m * 16 + lane] = lane == 0 ? s : 0.f;
        }
        for (int it = gw; it < M * PLE / 512; it += NGW) { const size_t o = (size_t)it * 512 + lane * 8; const f32x4 u0 = *(const f32x4*)(p + o), u1 = *(const f32x4*)(p + o + 4);
            v4u w; w.x = pk2(u0.x, u0.y); w.y = pk2(u0.z, u0.w); w.z = pk2(u1.x, u1.y); w.w = pk2(u1.z, u1.w); *(v4u*)(PB + o) = w; }
        asm volatile("s_waitcnt vmcnt(0) lgkmcnt(0)" ::: "memory"); __syncthreads();
    }
    SEAM(0);

    for (int l = 0; l < DEPTH; ++l) {
        const int pb = 1 + 6 * l;
        const bf16* wl = Wb + (size_t)l * E_WLAYER;
        bf16* bufX = (l & 1) ? HB : XB; bf16* bufT = (l & 1) ? XB : HB;
        float* ss1 = SS; float* ss2 = SS + (size_t)M * 16; float* ss3 = SS + (size_t)2 * M * 16; float* ss1n = ss1;
        if (IN(pb)) for (int rep_ = 0; rep_ < PROBE_A; ++rep_) {
#ifndef NO_A
            { pg8::Gemm g{bufX, wl + E_WIN, M, NIN, DM}; pg8::StaticOrder S; S.init(M, NIN, G, bx);
              EpiInProj E{ss1, CONV, Qb, Kb, VTb, CUb, VNTb, a.in[5] + l * 64, a.in[6] + l * 64, a.in[7] + l * 256};
              pg8::gemm_phase<EpiInProj, pg8::StaticOrder, true, true>(lds, g, S, E); }
            { int kp = PLE; asm volatile("" : "+s"(kp)); pg8::Gemm g{PB, wl + E_WP, M, DM, kp}; TSched S{bx, (M / 256 * (NIN / 256)) % G, G};
              EpiT E{bufT};
              pg8::gemm_phase<EpiT, TSched, true, true>(lds, g, S, E); }
#endif
        }
        SEAM(pb);
        if (IN(pb + 1)) for (int rep_ = 0; rep_ < PROBE_B; ++rep_) {
            int lane_ = lane; asm volatile("" : "+v"(lane_));
#ifndef NO_ATT
            for (int pr = gw; pr < 2048; pr += NGW) { const int bh = pr >> 5, i = pr & 31;
                attn_task(Qb, Kb, VTb, Yb, bh >> 3, bh & 7, 63 - i, lane_);
                attn_task(Qb, Kb, VTb, Yb, bh >> 3, bh & 7, i, lane_); }
#endif
#ifndef NO_SGU
            for (int tk = gw; tk < 2048; tk += NGW) sgu_task(VNTb, WSBb + (size_t)l * 4 * 128 * 128, CUb, a.in[9] + l * 512, Yb, tk, lane_);
#endif
#ifndef NO_CONV
            for (int tk = gw; tk < 1024; tk += NGW) conv_task(CONV, a.in[4] + l * 768, Yb, tk, lane_);
#endif
            const float* pl = p + (size_t)(l + 1 < DEPTH ? l + 1 : l) * M * PLE;
#pragma unroll 4
            for (int it = gw; it < M * PLE / 512; it += NGW) { const size_t o = (size_t)it * 512 + lane_ * 8; const f32x4 u0 = *(const f32x4*)(pl + o), u1 = *(const f32x4*)(pl + o + 4);
                v4u w; w.x = pk2(u0.x, u0.y); w.y = pk2(u0.z, u0.w); w.z = pk2(u1.x, u1.y); w.w = pk2(u1.z, u1.w); *(v4u*)(PB + o) = w; }
            asm volatile("s_waitcnt vmcnt(0) lgkmcnt(0)" ::: "memory"); __syncthreads();
        }
        SEAM(pb + 1);
        if (IN(pb + 2)) {
#ifndef NO_C
#ifndef NO_O
            { pg8::Gemm g{Yb, wl + E_WOUT, M, DM, DM}; pg8::StaticOrder S; S.init(M, DM, G, bx);
              EpiRes E{l == 0 ? x : (const float*)H, H, bufX, ss2};
              pg8::gemm_phase<EpiRes, pg8::StaticOrder, true, true>(lds, g, S, E); }
#endif
#endif
        }
        SEAM(pb + 2);
        if (IN(pb + 3)) for (int rep_ = 0; rep_ < PROBE_D; ++rep_) {
#ifndef NO_D
            pg8::Gemm g{bufX, wl + E_W1, M, DFF, DM}; pg8::StaticOrder S; S.init(M, DFF, G, bx);
            EpiFF1 E{ss2, Fb};
            pg8::gemm_phase<EpiFF1, pg8::StaticOrder, true, true>(lds, g, S, E);
#endif
        }
        SEAM(pb + 3);
        if (IN(pb + 4)) {
#ifndef NO_E
            pg8::Gemm g{Fb, wl + E_W2, M, DM, DFF}; pg8::StaticOrder S; S.init(M, DM, G, bx);
            EpiRes E{H, H, bufX, ss3};
            pg8::gemm_phase<EpiRes, pg8::StaticOrder, true, true>(lds, g, S, E);
#endif
        }
        SEAM(pb + 4);
        if (IN(pb + 5)) {
#ifndef NO_F
            pg8::Gemm g{bufX, wl + E_WG, M, DM, DM}; pg8::StaticOrder S; S.init(M, DM, G, bx);
            EpiGate E{ss3, H, bufT, ss1n};
            pg8::gemm_phase<EpiGate, pg8::StaticOrder, true, true>(lds, g, S, E);
#endif
        }
        SEAM(pb + 5);
    }
#undef IN
#undef SEAM
}

extern "C" void kernel_launch(void* const* d_in, const int* in_sizes, int n_in, void* d_out, int out_size, void* d_ws, size_t ws_size, hipStream_t stream) {
    static int grid = 0;
    if (grid == 0) {
        if (n_in != 17 || in_sizes[0] != M * DM || out_size != M * DM || ws_size < WS_TOTAL) { fprintf(stderr, "kernel_launch: unexpected shapes (n_in %d, in0 %d, out %d, ws %zu, need %zu)\n", n_in, n_in > 0 ? in_sizes[0] : -1, out_size, ws_size, (size_t)WS_TOTAL); grid = -1; return; }
        int dev = 0, cus = 0, per_cu = 0;
        hipGetDevice(&dev); hipDeviceGetAttribute(&cus, hipDeviceAttributeMultiprocessorCount, dev);
        if (hipFuncSetAttribute((const void*)mk_fwd, hipFuncAttributeMaxDynamicSharedMemorySize, LDS_BYTES) != hipSuccess) { fprintf(stderr, "kernel_launch: hipFuncSetAttribute failed\n"); grid = -1; return; }
        if (hipOccupancyMaxActiveBlocksPerMultiprocessor(&per_cu, (const void*)mk_fwd, NWAVES * 64, LDS_BYTES) != hipSuccess || per_cu < 1) { fprintf(stderr, "kernel_launch: occupancy query says %d\n", per_cu); per_cu = 1; }
        (void)hipGetLastError();
        grid = cus * 1;
    }
    if (grid < 0) return;
#ifdef DBG_MEMSET
    (void)hipMemsetAsync(d_ws, 0xAA, WS_END, stream); (void)hipMemsetAsync(d_out, 0xAA, (size_t)M * DM * 4, stream);
#endif
    if (hipMemsetAsync((char*)d_ws + WS_CTL, 0, CTL_BYTES, stream) != hipSuccess) { fprintf(stderr, "kernel_launch: memset of the barrier words failed\n"); return; }
    Args a{};
    for (int i = 0; i < 17; ++i) a.in[i] = (const float*)d_in[i];
    a.out = (float*)d_out; a.ws = (unsigned char*)d_ws;
#if MK_N_LAUNCHES == 1
    a.ph_lo = 0; a.ph_hi = NPHASE;
    void* args[] = {&a};
    hipError_t e = hipLaunchCooperativeKernel((const void*)mk_fwd, dim3(grid), dim3(NWAVES * 64), args, LDS_BYTES, stream);
    if (e != hipSuccess) fprintf(stderr, "cooperative launch failed: %s (grid %d)\n", hipGetErrorString(e), grid);
#else
    for (int ph = 0; ph < NPHASE; ++ph) { a.ph_lo = ph; a.ph_hi = ph + 1; hipLaunchKernelGGL(mk_fwd, dim3(grid), dim3(NWAVES * 64), LDS_BYTES, stream, a); }
#endif
}
```

```cpp
#include <hip/hip_runtime.h>
#include <hip/hip_cooperative_groups.h>
#include <cstdio>
#include <cstdint>
namespace cg = cooperative_groups;
namespace pg8 {
#define PG8_LAS __attribute__((address_space(3)))
typedef unsigned short bf16_t;
typedef short bf16x8 __attribute__((ext_vector_type(8)));
typedef float f32x4 __attribute__((ext_vector_type(4)));
typedef unsigned u32x4 __attribute__((ext_vector_type(4)));
constexpr int BM = 256, BK = 64, HALF = 128, HTB = HALF * BK * 2  , STAGE_BYTES = 8 * HTB, NXCD = 8, WGM = 8;

__host__ __device__ __forceinline__ int lds_byte(int r, int c) { const int st = (r >> 4) * 2 + (c >> 5), rr = r & 15, cc = c & 31, ob = rr * 64 + cc * 2; return st * 1024 + (ob ^ (((ob >> 9) & 1) << 5)); }
__host__ __device__ __forceinline__ void stage_rc(int b, int& R, int& C) { const int st = b / 1024, sb = b % 1024, swz = sb ^ (((sb >> 9) & 1) << 5); R = (st >> 1) * 16 + swz / 64; C = (st & 1) * 32 + (swz % 64) / 2; }
__host__ __device__ __forceinline__ int perm32(int rho) { const int n = rho >> 4, i = rho & 15; return 8 * (i >> 2) + 4 * n + (i & 3); }

struct Unit { int pm, pn; };
struct Gemm { const bf16_t* A; const bf16_t* Bt; int M, N, K; };

struct StaticOrder {
    int nM, nN, nwg, G, c;
    __host__ __device__ void init(int M, int N, int G_, int c_) { nM = M / BM; nN = N / BM; nwg = nM * nN; G = G_; c = c_; }
    __host__ __device__ bool next(int i, Unit& u) const {
        const long L = (long)i * G + c; if (L >= nwg) return false;
        int wgid = (int)L; { const int q = nwg / NXCD, r = nwg % NXCD, xcd = wgid % NXCD, off = wgid / NXCD; wgid = (xcd < r ? xcd * (q + 1) : r * (q + 1) + (xcd - r) * q) + off; }
        const int nig = WGM * nN, gid = wgid / nig, fm = gid * WGM, gsz = (nM - fm) < WGM ? (nM - fm) : WGM;
        u.pm = fm + ((wgid % nig) % gsz); u.pn = (wgid % nig) / gsz; return true;
    }
    __device__ __forceinline__ void a_ready(const Unit&) const {}
    __device__ __forceinline__ void done(const Unit&) const {}
};

__device__ __forceinline__ unsigned cvt_pk_bf16(float lo, float hi) { unsigned r; asm volatile("v_cvt_pk_bf16_f32 %0, %1, %2" : "=v"(r) : "v"(lo), "v"(hi)); return r; }
typedef float f32x2 __attribute__((ext_vector_type(2)));
__device__ __forceinline__ f32x2 gelu_pk(f32x2 v) {
    const f32x2 av = __builtin_elementwise_abs(v), d = av * 0.2316418882f + 1.0f;
    f32x2 t; t.x = __builtin_amdgcn_rcpf(d.x); t.y = __builtin_amdgcn_rcpf(d.y);
    f32x2 q = t * 0.5307027145f + (-0.7265760135f); q = q * t + 0.7107068705f; q = q * t + (-0.142248368f); q = q * t + 0.127414796f; q = q * t;
    const f32x2 s = (v * v) * (-0.72134752044f);
    f32x2 e; e.x = __builtin_amdgcn_exp2f(s.x); e.y = __builtin_amdgcn_exp2f(s.y);
    const f32x2 m = v * (q * e), r = v - m;
    f32x2 o; o.x = v.x < 0.f ? m.x : r.x; o.y = v.y < 0.f ? m.y : r.y; return o;
}

template <int ACT  > struct EpiBf16 {
    static constexpr bool PERM = true, AFTER_DRAIN = false; static_assert(ACT == 0 || ACT == 1, "EpiBf16: ACT is 0 (none) or 1 (gelu_pk)");
    bf16_t* O; int ldc; const float* bias; int split_cols; size_t split_stride; float scale0;
    __device__ __forceinline__ void operator()(const f32x4 (&acc)[2][2][4][2], const Unit& u, int wr, int wc, int fr, int fq) const {
        const int row0 = u.pm * BM + wr * 64 + fr; int colt = u.pn * BM; bf16_t* base = O;
        float sc = 1.f; if (split_cols) { const int t = colt / split_cols; base += (size_t)t * split_stride; colt -= t * split_cols; if (t == 0) sc = scale0; }
        const int col0 = colt + wc * 32 + 8 * fq, bcol0 = u.pn * BM + wc * 32 + 8 * fq;
        f32x4 bv[2][2];
#pragma unroll
        for (int bj = 0; bj < 2; ++bj)
#pragma unroll
            for (int n = 0; n < 2; ++n) bv[bj][n] = bias ? *(const f32x4*)(bias + bcol0 + bj * HALF + 4 * n) : (f32x4){0.f, 0.f, 0.f, 0.f};
#pragma unroll
        for (int ai = 0; ai < 2; ++ai)
#pragma unroll
            for (int m = 0; m < 4; ++m) { bf16_t* rowp = base + (size_t)(row0 + ai * HALF + m * 16) * ldc + col0;
#pragma unroll
                for (int bj = 0; bj < 2; ++bj) { f32x4 v0 = acc[ai][bj][m][0] + bv[bj][0], v1 = acc[ai][bj][m][1] + bv[bj][1];
                    if (ACT == 1) { f32x2 a = gelu_pk((f32x2){v0[0], v0[1]}), b = gelu_pk((f32x2){v0[2], v0[3]}), c = gelu_pk((f32x2){v1[0], v1[1]}), d = gelu_pk((f32x2){v1[2], v1[3]});
                        v0 = (f32x4){a.x, a.y, b.x, b.y}; v1 = (f32x4){c.x, c.y, d.x, d.y}; }
                    v0 = v0 * sc; v1 = v1 * sc; u32x4 w; w.x = cvt_pk_bf16(v0[0], v0[1]); w.y = cvt_pk_bf16(v0[2], v0[3]); w.z = cvt_pk_bf16(v1[0], v1[1]); w.w = cvt_pk_bf16(v1[2], v1[3]);
                    *(u32x4*)(rowp + bj * HALF) = w; } }
    }
};
template <class Epi, class Sched, bool ALIGN_EPI = false, bool SP2 = false>
__device__ __forceinline__ void gemm_phase(PG8_LAS unsigned char* lds, const Gemm g, const Sched& S, const Epi& E) {
    int tid_ = threadIdx.x; asm volatile("" : "+v"(tid_));
    const int tid = tid_, wid = __builtin_amdgcn_readfirstlane(tid >> 6), lane = tid & 63, wr = wid >> 2, wc = wid & 3, fr = lane & 15, fq = lane >> 4;
    const int K = g.K, nt = K / BK;
    unsigned voffA[2], voffB[2];
#pragma unroll
    for (int i = 0; i < 2; ++i) { int R, C; stage_rc(tid * 16 + i * 8192, R, C); const int Rb = Epi::PERM ? ((R & ~31) + perm32(R & 31)) : R;
        voffA[i] = (unsigned)(R * K + C) * 2u; voffB[i] = (unsigned)(Rb * K + C) * 2u; }
    const size_t kstep = (size_t)(BK * 2);
    const size_t hstep = (size_t)HALF * K * 2;
    const size_t tstep = 2 * hstep;
    const unsigned ldsw = (unsigned)wid * 1024u;
    const int aoff = lds_byte(wr * 64 + fr, fq * 8), boff = lds_byte(wc * 32 + fr, fq * 8);
#define PG8_SA(b, h) (((b) * 2 + (h)) * HTB)
#define PG8_SB(b, h) ((4 + (b) * 2 + (h)) * HTB)
#define PG8_STAGE(bufoff, gbase, voff) do { _Pragma("unroll") for (int _i = 0; _i < 2; ++_i) \
        __builtin_amdgcn_global_load_lds((const unsigned*)((const char*)(gbase) + (voff)[_i]), (PG8_LAS unsigned*)(lds + (bufoff) + ldsw + _i * 8192), 16, 0, 0); } while (0)
#define PG8_LDA(dst, b, h) do { _Pragma("unroll") for (int m = 0; m < 4; ++m) _Pragma("unroll") for (int k = 0; k < 2; ++k) dst[m][k] = *(const PG8_LAS bf16x8*)(lds + PG8_SA(b, h) + aoff + m * 2048 + k * 1024); } while (0)
#define PG8_LDB(dst, b, h) do { _Pragma("unroll") for (int n = 0; n < 2; ++n) _Pragma("unroll") for (int k = 0; k < 2; ++k) dst[n][k] = *(const PG8_LAS bf16x8*)(lds + PG8_SB(b, h) + boff + n * 2048 + k * 1024); } while (0)
#define PG8_MMA(ai, bj, At, Bt) do { __builtin_amdgcn_s_setprio(1); _Pragma("unroll") for (int m = 0; m < 4; ++m) _Pragma("unroll") for (int n = 0; n < 2; ++n) _Pragma("unroll") for (int k = 0; k < 2; ++k) \
        acc[ai][bj][m][n] = __builtin_amdgcn_mfma_f32_16x16x32_bf16(Bt[n][k], At[m][k], acc[ai][bj][m][n], 0, 0, 0); __builtin_amdgcn_s_setprio(0); } while (0)
#define PG8_WAIT_V(n) asm volatile("s_waitcnt vmcnt(" #n ")" ::: "memory")
#define PG8_WAIT_L(n) asm volatile("s_waitcnt lgkmcnt(" #n ")" ::: "memory")
#define PG8_BAR __builtin_amdgcn_s_barrier()
#define PG8_SCHED __builtin_amdgcn_sched_barrier(0)
    Unit cur, nxt; int ui = 0;
    if (!S.next(0, cur)) return;
    f32x4 acc[2][2][4][2];
#pragma unroll
    for (int a = 0; a < 2; ++a)
#pragma unroll
        for (int b = 0; b < 2; ++b)
#pragma unroll
            for (int m = 0; m < 4; ++m)
#pragma unroll
                for (int n = 0; n < 2; ++n) acc[a][b][m][n] = (f32x4){0.f, 0.f, 0.f, 0.f};
    bf16x8 At[4][2], B0[2][2], B1[2][2];
    const char* cA = (const char*)g.A + (size_t)cur.pm * tstep; const char* cB = (const char*)g.Bt + (size_t)cur.pn * tstep;
    S.a_ready(cur);
    if constexpr (SP2) {
        PG8_STAGE(PG8_SB(0, 0), cB, voffB); PG8_STAGE(PG8_SB(0, 1), cB + hstep, voffB); PG8_STAGE(PG8_SA(0, 0), cA, voffA); PG8_STAGE(PG8_SA(0, 1), cA + hstep, voffA);
        if (wr == 1) PG8_BAR;
        PG8_WAIT_V(2); PG8_BAR;
        PG8_STAGE(PG8_SB(1, 0), cB + kstep, voffB); PG8_STAGE(PG8_SA(1, 0), cA + kstep, voffA); PG8_STAGE(PG8_SB(1, 1), cB + hstep + kstep, voffB);
        PG8_WAIT_V(6); PG8_BAR;
    } else {
        PG8_STAGE(PG8_SB(0, 0), cB, voffB); PG8_STAGE(PG8_SA(0, 0), cA, voffA); PG8_STAGE(PG8_SB(0, 1), cB + hstep, voffB); PG8_STAGE(PG8_SA(0, 1), cA + hstep, voffA);
        if (wr == 1) PG8_BAR;
        PG8_WAIT_V(4); PG8_BAR;
        PG8_STAGE(PG8_SB(1, 0), cB + kstep, voffB); PG8_STAGE(PG8_SA(1, 0), cA + kstep, voffA); PG8_STAGE(PG8_SB(1, 1), cB + hstep + kstep, voffB);
        PG8_WAIT_V(6); PG8_BAR;
    }
    for (;;) {
        const bool has_next = S.next(ui + 1, nxt);
        const char* nA = has_next ? (const char*)g.A + (size_t)nxt.pm * tstep : cA; const char* nB = has_next ? (const char*)g.Bt + (size_t)nxt.pn * tstep : cB;
        for (int t = 0; t < nt; t += 2) {
            const bool last = (t == nt - 2);
            const char* a1 = cA + (size_t)(t + 1) * kstep;
            const char* a2 = last ? nA : cA + (size_t)(t + 2) * kstep; const char* b2 = last ? nB : cB + (size_t)(t + 2) * kstep;
            const char* a3 = a2 + kstep; const char* b3 = b2 + kstep;
            if (last && has_next) S.a_ready(nxt);
            if constexpr (SP2) {
            PG8_LDB(B0, 0, 0); PG8_LDB(B1, 0, 1); PG8_SCHED; PG8_LDA(At, 0, 0); PG8_STAGE(PG8_SA(1, 1), a1 + hstep, voffA);
            PG8_WAIT_V(8); PG8_WAIT_L(0); PG8_BAR; PG8_MMA(0, 0, At, B0); PG8_MMA(0, 1, At, B1); PG8_BAR; PG8_SCHED;
            PG8_LDA(At, 0, 1); PG8_STAGE(PG8_SB(0, 0), b2, voffB); PG8_STAGE(PG8_SB(0, 1), b2 + hstep, voffB); PG8_STAGE(PG8_SA(0, 0), a2, voffA);
            PG8_WAIT_V(8); PG8_WAIT_L(0); PG8_BAR; PG8_MMA(1, 0, At, B0); PG8_MMA(1, 1, At, B1); PG8_BAR; PG8_SCHED;
            PG8_LDB(B0, 1, 0); PG8_LDB(B1, 1, 1); PG8_SCHED; PG8_LDA(At, 1, 0); PG8_STAGE(PG8_SA(0, 1), a2 + hstep, voffA);
            PG8_WAIT_V(8); PG8_WAIT_L(0); PG8_BAR; PG8_MMA(0, 0, At, B0); PG8_MMA(0, 1, At, B1); PG8_BAR; PG8_SCHED;
            PG8_LDA(At, 1, 1); PG8_STAGE(PG8_SB(1, 0), b3, voffB); PG8_STAGE(PG8_SB(1, 1), b3 + hstep, voffB); PG8_STAGE(PG8_SA(1, 0), a3, voffA);
            PG8_WAIT_V(8); PG8_WAIT_L(0); PG8_BAR; PG8_MMA(1, 0, At, B0); PG8_MMA(1, 1, At, B1); PG8_BAR; PG8_SCHED;
            } else {
            PG8_LDB(B0, 0, 0); PG8_SCHED; PG8_LDA(At, 0, 0); PG8_STAGE(PG8_SA(1, 1), a1 + hstep, voffA);
            PG8_WAIT_L(8); PG8_BAR; PG8_WAIT_L(0); PG8_MMA(0, 0, At, B0); PG8_BAR; PG8_SCHED;
            PG8_LDB(B1, 0, 1); PG8_STAGE(PG8_SB(0, 0), b2, voffB);
            PG8_BAR; PG8_WAIT_L(0); PG8_MMA(0, 1, At, B1); PG8_BAR;
            PG8_LDA(At, 0, 1); PG8_STAGE(PG8_SA(0, 0), a2, voffA);
            PG8_BAR; PG8_WAIT_L(0); PG8_MMA(1, 0, At, B0); PG8_BAR; PG8_SCHED;
            PG8_STAGE(PG8_SB(0, 1), b2 + hstep, voffB);
            PG8_WAIT_V(6); PG8_BAR; PG8_MMA(1, 1, At, B1); PG8_BAR;
            PG8_LDB(B0, 1, 0); PG8_SCHED; PG8_LDA(At, 1, 0); PG8_STAGE(PG8_SA(0, 1), a2 + hstep, voffA);
            PG8_WAIT_L(8); PG8_BAR; PG8_WAIT_L(0); PG8_MMA(0, 0, At, B0); PG8_BAR; PG8_SCHED;
            PG8_LDB(B1, 1, 1); PG8_STAGE(PG8_SB(1, 0), b3, voffB);
            PG8_BAR; PG8_WAIT_L(0); PG8_MMA(0, 1, At, B1); PG8_BAR;
            PG8_LDA(At, 1, 1); PG8_STAGE(PG8_SA(1, 0), a3, voffA);
            PG8_BAR; PG8_WAIT_L(0); PG8_MMA(1, 0, At, B0); PG8_BAR; PG8_SCHED;
            PG8_STAGE(PG8_SB(1, 1), b3 + hstep, voffB);
            PG8_WAIT_V(6); PG8_BAR; PG8_MMA(1, 1, At, B1); PG8_BAR;
            }
        }
        if constexpr (ALIGN_EPI) { if (wr == 0) PG8_BAR; }
        if constexpr (!Epi::AFTER_DRAIN) { E(acc, cur, wr, wc, fr, fq); S.done(cur); }
        if (!has_next) break;
#pragma unroll
        for (int a = 0; a < 2; ++a)
#pragma unroll
            for (int b = 0; b < 2; ++b)
#pragma unroll
                for (int m = 0; m < 4; ++m)
#pragma unroll
                    for (int n = 0; n < 2; ++n) acc[a][b][m][n] = (f32x4){0.f, 0.f, 0.f, 0.f};
        cur = nxt; cA = nA; cB = nB; ++ui;
        if constexpr (ALIGN_EPI) { if (wr == 1) PG8_BAR; }
    }
    PG8_WAIT_V(0);
    if constexpr (!ALIGN_EPI) { if (wr == 0) PG8_BAR; }
    PG8_BAR;
    if constexpr (Epi::AFTER_DRAIN) { E.fused(acc, cur, wr, wc, fr, fq, lds, wid, lane); S.done(cur); }
#undef PG8_SA
#undef PG8_SB
#undef PG8_STAGE
#undef PG8_LDA
#undef PG8_LDB
#undef PG8_MMA
#undef PG8_WAIT_V
#undef PG8_WAIT_L
#undef PG8_BAR
#undef PG8_SCHED
}
}

#ifndef MK_N_LAUNCHES
#define MK_N_LAUNCHES 1
#endif
#ifndef ATT_EARLY_EXIT
#define ATT_EARLY_EXIT 1
#endif
constexpr int NWAVES = 8;
constexpr int M = 16384, DM = 1024, SEQ = 2048, DEPTH = 4, NIN = 2816, DFF = 4096, PLE = 256;
constexpr float EPS = 1e-6f;
constexpr float C2 = 0.125f * 1.4426950408889634f;
constexpr int NPHASE = 1 + 6 * DEPTH;
#ifndef PROBE_B
#define PROBE_B 1
#endif
#ifndef PROBE_SYNC
#define PROBE_SYNC 1
#endif
#ifndef PROBE_P
#define PROBE_P 1
#endif
#ifndef PROBE_A
#define PROBE_A 1
#endif
#ifndef PROBE_D
#define PROBE_D 1
#endif

typedef unsigned short bf16;
#define LAS __attribute__((address_space(3)))
typedef unsigned v4u __attribute__((ext_vector_type(4)));
typedef unsigned v2u __attribute__((ext_vector_type(2)));
typedef float f32x4 __attribute__((ext_vector_type(4)));
typedef float f32x2 __attribute__((ext_vector_type(2)));
typedef float f32x16 __attribute__((ext_vector_type(16)));
typedef short bf16x8 __attribute__((ext_vector_type(8)));
typedef short s16x4 __attribute__((ext_vector_type(4)));
#define LDS_WAIT() asm volatile("s_waitcnt lgkmcnt(0)" ::: "memory")

constexpr size_t E_WIN = 0, E_WOUT = (size_t)NIN * DM, E_W1 = E_WOUT + (size_t)DM * DM, E_W2 = E_W1 + (size_t)DFF * DM, E_WG = E_W2 + (size_t)DFF * DM, E_WP = E_WG + (size_t)DM * DM,
                 E_WLAYER = E_WP + (size_t)PLE * DM;
constexpr size_t WS_W = 0, WS_WSB = WS_W + (size_t)DEPTH * E_WLAYER * 2, WS_SS = WS_WSB + (size_t)DEPTH * 4 * 128 * 128 * 2, WS_HB = WS_SS + (size_t)3 * M * 16 * 4,
                 WS_LO = WS_HB + (size_t)M * DM * 2, WS_XB = WS_LO + (size_t)M * DM * 2, WS_BIG = WS_XB + (size_t)M * DM * 2, WS_END = WS_BIG + (size_t)M * DFF * 2;
constexpr size_t B_CONV = 0, B_Q = B_CONV + (size_t)3 * M * 256 * 2, B_K = B_Q + (size_t)M * 512 * 2, B_VT = B_K + (size_t)M * 512 * 2, B_CU = B_VT + (size_t)M * 512 * 2,
                 B_VNT = B_CU + (size_t)M * 256 * 2, B_Y = B_VNT + (size_t)M * 256 * 2, B_ENDMIX = B_Y + (size_t)M * DM * 2;
static_assert(B_ENDMIX <= (size_t)M * DFF * 2, "mixer tensors fit under the F overlay");
constexpr size_t WS_CTL = WS_END, CTL_BYTES = 16384, WS_TOTAL = WS_CTL + CTL_BYTES;
constexpr int RING_BYTES = 131072, LDS_BYTES = 132096;

__device__ __forceinline__ unsigned f2bf(float f) { unsigned u = __builtin_bit_cast(unsigned, f); return (u + 0x7fffu + ((u >> 16) & 1u)) >> 16; }
typedef __bf16 bf16x2_t __attribute__((ext_vector_type(2)));
__device__ __forceinline__ unsigned pk2(float lo, float hi) { f32x2 v = {lo, hi}; bf16x2_t b = __builtin_convertvector(v, bf16x2_t); return __builtin_bit_cast(unsigned, b); }
__device__ __forceinline__ float bflo(unsigned u) { return __builtin_bit_cast(float, u << 16); }
__device__ __forceinline__ float bfhi(unsigned u) { return __builtin_bit_cast(float, u & 0xffff0000u); }
__device__ __forceinline__ float wave_sum(float v) {
#pragma unroll
    for (int o = 1; o < 64; o <<= 1) v += __shfl_xor(v, o);
    return v;
}

__device__ __forceinline__ float row_rs(const float* ssp, int r) {
    const f32x4* q = (const f32x4*)(ssp + (size_t)r * 16); const f32x4 a = q[0], b = q[1], c = q[2], d = q[3];
    const float s = ((a[0] + a[1]) + (a[2] + a[3])) + ((b[0] + b[1]) + (b[2] + b[3])) + ((c[0] + c[1]) + (c[2] + c[3])) + ((d[0] + d[1]) + (d[2] + d[3]));
    return rsqrtf(s * (1.f / 1024.f) + EPS);
}
struct EpiInProj {
    static constexpr bool PERM = true, AFTER_DRAIN = false;
    const float* ss; bf16* conv; bf16* q; bf16* k; bf16* vt; bf16* cu; bf16* vnt; const float* qg; const float* kg; const float* sg;
    __device__ __forceinline__ void operator()(const pg8::f32x4 (&acc)[2][2][4][2], const pg8::Unit& u, int wr, int wc, int fr, int fq) const {
        const int sec = u.pn;
        const int row0 = u.pm * 256 + wr * 64 + fr;
        const int cw = 64 * wc + 8 * fq;
        const bool normed = (sec >= 3 && sec < 7) || sec == 10;
        float rsv[8];
#pragma unroll
        for (int g = 0; g < 8; ++g) { rsv[g] = row_rs(ss, row0 + (g >> 2) * 128 + (g & 3) * 16); if (g & 1) asm volatile("" : "+v"(rsv[g - 1]), "+v"(rsv[g]) :: "memory"); }
        f32x4 gv[2][2];
#pragma unroll
        for (int bj = 0; bj < 2; ++bj)
#pragma unroll
            for (int n = 0; n < 2; ++n) {
                if (sec >= 3 && sec < 7) { const float* g = sec < 5 ? qg : kg; const float sc = sec < 5 ? C2 : 1.f; gv[bj][n] = *(const f32x4*)(g + 32 * bj + 8 * fq + 4 * n) * sc; }
                else if (sec == 10) gv[bj][n] = *(const f32x4*)(sg + cw + 32 * bj + 4 * n);
                else gv[bj][n] = (f32x4){1.f, 1.f, 1.f, 1.f};
            }
#pragma unroll
        for (int ai = 0; ai < 2; ++ai)
#pragma unroll
            for (int m = 0; m < 4; ++m) {
                const int r = row0 + ai * 128 + m * 16;
                const float rs = rsv[ai * 4 + m];
                f32x4 v[2][2];
#pragma unroll
                for (int bj = 0; bj < 2; ++bj)
#pragma unroll
                    for (int n = 0; n < 2; ++n) v[bj][n] = acc[ai][bj][m][n] * rs;
                if (sec >= 9) {
#pragma unroll
                    for (int bj = 0; bj < 2; ++bj)
#pragma unroll
                        for (int n = 0; n < 2; ++n) { const pg8::f32x2 a = pg8::gelu_pk((pg8::f32x2){v[bj][n][0], v[bj][n][1]}), b = pg8::gelu_pk((pg8::f32x2){v[bj][n][2], v[bj][n][3]}); v[bj][n] = (f32x4){a.x, a.y, b.x, b.y}; }
                }
                if (normed) {
                    float s2 = 0.f;
#pragma unroll
                    for (int bj = 0; bj < 2; ++bj)
#pragma unroll
                        for (int n = 0; n < 2; ++n) { const f32x4 x = v[bj][n]; s2 += (x[0] * x[0] + x[1] * x[1]) + (x[2] * x[2] + x[3] * x[3]); }
                    s2 += __shfl_xor(s2, 16); s2 += __shfl_xor(s2, 32);
                    const float rn = rsqrtf(s2 * (1.f / 64.f) + EPS);
#pragma unroll
                    for (int bj = 0; bj < 2; ++bj)
#pragma unroll
                        for (int n = 0; n < 2; ++n) v[bj][n] = v[bj][n] * rn * gv[bj][n];
                }
                const int b = r >> 11, s = r & 2047;
                if (sec == 10) {
                    bf16* base = vnt + ((size_t)(b * 4 + wc) * 64) * SEQ + s;
#pragma unroll
                    for (int bj = 0; bj < 2; ++bj)
#pragma unroll
                        for (int n = 0; n < 2; ++n)
#pragma unroll
                            for (int j = 0; j < 4; ++j) base[(size_t)(32 * bj + 8 * fq + 4 * n + j) * SEQ] = (bf16)f2bf(v[bj][n][j]);
                } else if (sec == 7 || sec == 8) {
                    const int kk_ = s & 31;
                    bf16* base = vt + (((size_t)((b * 8 + 4 * (sec - 7) + wc) * 64 + (s >> 5)) * 4 + (kk_ >> 4)) * 64 + ((kk_ >> 3) & 1) * 32 + 8 * fq) * 8 + (kk_ & 7);
#pragma unroll
                    for (int bj = 0; bj < 2; ++bj)
#pragma unroll
                        for (int n = 0; n < 2; ++n)
#pragma unroll
                            for (int j = 0; j < 4; ++j) base[(size_t)bj * 2 * 64 * 8 + (4 * n + j) * 8] = (bf16)f2bf(v[bj][n][j]);
                } else if (sec >= 3 && sec < 7) {
                    const bool isq = sec < 5;
                    const int sl = s & 31, pos = isq ? sl : ((sl & 0x13) | ((sl & 4) << 1) | ((sl & 8) >> 1));
                    bf16* base = (isq ? q : k) + (((size_t)((b * 8 + 4 * ((sec - 3) & 1) + wc) * 64 + (s >> 5)) * 4 + (fq >> 1)) * 64 + (fq & 1) * 32 + pos) * 8;
#pragma unroll
                    for (int bj = 0; bj < 2; ++bj) { v4u w; w.x = pk2(v[bj][0][0], v[bj][0][1]); w.y = pk2(v[bj][0][2], v[bj][0][3]); w.z = pk2(v[bj][1][0], v[bj][1][1]); w.w = pk2(v[bj][1][2], v[bj][1][3]);
                        *(v4u*)(base + (size_t)bj * 2 * 64 * 8) = w; }
                } else {
                    bf16* dst; int ld;
                    if (sec < 3) { dst = conv + (size_t)sec * M * 256 + cw; ld = 256; }
                    else { dst = cu + cw; ld = 256; }
                    dst += (size_t)r * ld;
#pragma unroll
                    for (int bj = 0; bj < 2; ++bj) { v4u w; w.x = pk2(v[bj][0][0], v[bj][0][1]); w.y = pk2(v[bj][0][2], v[bj][0][3]); w.z = pk2(v[bj][1][0], v[bj][1][1]); w.w = pk2(v[bj][1][2], v[bj][1][3]);
                        *(v4u*)(dst + 32 * bj) = w; }
                }
            }
    }
};

__device__ __forceinline__ void unpk(const v4u w, f32x4& a, f32x4& b) { a = (f32x4){bflo(w.x), bfhi(w.x), bflo(w.y), bfhi(w.y)}; b = (f32x4){bflo(w.z), bfhi(w.z), bflo(w.w), bfhi(w.w)}; }
__device__ __forceinline__ void split_store(const f32x4 h0, const f32x4 h1, bf16* hi, bf16* lo) {
    v4u w; w.x = pk2(h0[0], h0[1]); w.y = pk2(h0[2], h0[3]); w.z = pk2(h1[0], h1[1]); w.w = pk2(h1[2], h1[3]); *(v4u*)hi = w;
    f32x4 a, b; unpk(w, a, b); const f32x4 d0 = h0 - a, d1 = h1 - b;
    v4u l; l.x = pk2(d0[0], d0[1]); l.y = pk2(d0[2], d0[3]); l.z = pk2(d1[0], d1[1]); l.w = pk2(d1[2], d1[3]); *(v4u*)lo = l;
}
struct EpiRes {
    static constexpr bool PERM = true, AFTER_DRAIN = false;
    bf16* hi; bf16* lo; float* ssout;
    __device__ __forceinline__ void operator()(const pg8::f32x4 (&acc)[2][2][4][2], const pg8::Unit& u, int wr, int wc, int fr, int fq) const {
        const int row0 = u.pm * 256 + wr * 64 + fr, col0 = u.pn * 256 + wc * 32 + 8 * fq;
        constexpr int LA = 2;
        v4u bq[8][4];
#pragma unroll
        for (int g = 0; g < LA; ++g) { const size_t off = (size_t)(row0 + (g >> 2) * 128 + (g & 3) * 16) * DM + col0;
#pragma unroll
            for (int bj = 0; bj < 2; ++bj) { bq[g][2 * bj] = *(const v4u*)(hi + off + bj * 128); bq[g][2 * bj + 1] = *(const v4u*)(lo + off + bj * 128); } }
#pragma unroll
        for (int g = 0; g < 8; ++g) {
            if (g + LA < 8) { const int gn = g + LA; const size_t off = (size_t)(row0 + (gn >> 2) * 128 + (gn & 3) * 16) * DM + col0;
#pragma unroll
                for (int bj = 0; bj < 2; ++bj) { bq[gn][2 * bj] = *(const v4u*)(hi + off + bj * 128); bq[gn][2 * bj + 1] = *(const v4u*)(lo + off + bj * 128); } }
            const int ai = g >> 2, m = g & 3;
            const int r = row0 + ai * 128 + m * 16; const size_t off = (size_t)r * DM + col0; float s2 = 0.f;
#pragma unroll
            for (int bj = 0; bj < 2; ++bj) {
                f32x4 a0, a1, l0, l1; unpk(bq[g][2 * bj], a0, a1); unpk(bq[g][2 * bj + 1], l0, l1);
                const f32x4 h0 = (a0 + l0) + acc[ai][bj][m][0], h1 = (a1 + l1) + acc[ai][bj][m][1];
                split_store(h0, h1, hi + off + bj * 128, lo + off + bj * 128);
                s2 += (h0[0] * h0[0] + h0[1] * h0[1]) + (h0[2] * h0[2] + h0[3] * h0[3]) + (h1[0] * h1[0] + h1[1] * h1[1]) + (h1[2] * h1[2] + h1[3] * h1[3]);
            }
            s2 += __shfl_xor(s2, 16); s2 += __shfl_xor(s2, 32);
            if (fq == 0) ssout[(size_t)r * 16 + u.pn * 4 + wc] = s2;
            asm volatile("" ::: "memory");
        }
    }
};
struct EpiFF1 {
    static constexpr bool PERM = true, AFTER_DRAIN = false;
    const float* ss; bf16* f;
    __device__ __forceinline__ void operator()(const pg8::f32x4 (&acc)[2][2][4][2], const pg8::Unit& u, int wr, int wc, int fr, int fq) const {
        const int row0 = u.pm * 256 + wr * 64 + fr, col0 = u.pn * 256 + wc * 32 + 8 * fq;
        float rsv[8];
#pragma unroll
        for (int g = 0; g < 8; ++g) { rsv[g] = row_rs(ss, row0 + (g >> 2) * 128 + (g & 3) * 16); if (g & 1) asm volatile("" : "+v"(rsv[g - 1]), "+v"(rsv[g]) :: "memory"); }
#pragma unroll
        for (int ai = 0; ai < 2; ++ai)
#pragma unroll
            for (int m = 0; m < 4; ++m) {
                const int r = row0 + ai * 128 + m * 16; const float rs = rsv[ai * 4 + m]; bf16* dst = f + (size_t)r * DFF + col0;
#pragma unroll
                for (int bj = 0; bj < 2; ++bj) {
                    f32x4 a = acc[ai][bj][m][0] * rs, b = acc[ai][bj][m][1] * rs;
#pragma unroll
                    for (int j = 0; j < 4; ++j) { a[j] = fmaxf(a[j], 0.f); a[j] *= a[j]; b[j] = fmaxf(b[j], 0.f); b[j] *= b[j]; }
                    v4u w; w.x = pk2(a[0], a[1]); w.y = pk2(a[2], a[3]); w.z = pk2(b[0], b[1]); w.w = pk2(b[2], b[3]); *(v4u*)(dst + bj * 128) = w;
                }
            }
    }
};
struct EpiT {
    static constexpr bool PERM = true, AFTER_DRAIN = false;
    bf16* t;
    __device__ __forceinline__ void operator()(const pg8::f32x4 (&acc)[2][2][4][2], const pg8::Unit& u, int wr, int wc, int fr, int fq) const {
        const int row0 = u.pm * 256 + wr * 64 + fr, col0 = u.pn * 256 + wc * 32 + 8 * fq;
#pragma unroll
        for (int ai = 0; ai < 2; ++ai)
#pragma unroll
            for (int m = 0; m < 4; ++m) {
                bf16* dst = t + (size_t)(row0 + ai * 128 + m * 16) * DM + col0;
#pragma unroll
                for (int bj = 0; bj < 2; ++bj) { const f32x4 a = acc[ai][bj][m][0], b = acc[ai][bj][m][1];
                    v4u w; w.x = pk2(a[0], a[1]); w.y = pk2(a[2], a[3]); w.z = pk2(b[0], b[1]); w.w = pk2(b[2], b[3]); *(v4u*)(dst + bj * 128) = w; }
            }
    }
};
struct EpiGate {
    static constexpr bool PERM = true, AFTER_DRAIN = false;
    const float* ss; const bf16* hi; bf16* lo; bf16* tx; float* ssout; float* fout;
    __device__ __forceinline__ void operator()(const pg8::f32x4 (&acc)[2][2][4][2], const pg8::Unit& u, int wr, int wc, int fr, int fq) const {
        const int row0 = u.pm * 256 + wr * 64 + fr, col0 = u.pn * 256 + wc * 32 + 8 * fq;
        float rsv[8];
#pragma unroll
        for (int g = 0; g < 8; ++g) { rsv[g] = row_rs(ss, row0 + (g >> 2) * 128 + (g & 3) * 16) * (-1.4426950408889634f); if (g & 1) asm volatile("" : "+v"(rsv[g - 1]), "+v"(rsv[g]) :: "memory"); }
        constexpr int LA = 0;
        v4u hq[8][4]; v4u tq[8][2];
#pragma unroll
        for (int g = 0; g < LA; ++g) { const size_t off = (size_t)(row0 + (g >> 2) * 128 + (g & 3) * 16) * DM + col0;
#pragma unroll
            for (int bj = 0; bj < 2; ++bj) { tq[g][bj] = *(const v4u*)(tx + off + bj * 128); hq[g][2 * bj] = *(const v4u*)(hi + off + bj * 128); hq[g][2 * bj + 1] = *(const v4u*)(lo + off + bj * 128); } }
#pragma unroll
        for (int g = 0; g < 8; ++g) {
            if (g + LA < 8) { const int gn = g + LA; const size_t off = (size_t)(row0 + (gn >> 2) * 128 + (gn & 3) * 16) * DM + col0;
#pragma unroll
                for (int bj = 0; bj < 2; ++bj) { tq[gn][bj] = *(const v4u*)(tx + off + bj * 128); hq[gn][2 * bj] = *(const v4u*)(hi + off + bj * 128); hq[gn][2 * bj + 1] = *(const v4u*)(lo + off + bj * 128); } }
            const int ai = g >> 2, m = g & 3;
            const int r = row0 + ai * 128 + m * 16; const float rs = rsv[g]; const size_t off = (size_t)r * DM + col0; float s2 = 0.f;
#pragma unroll
            for (int bj = 0; bj < 2; ++bj) {
                f32x4 t0, t1, a0, a1, l0, l1; unpk(tq[g][bj], t0, t1); unpk(hq[g][2 * bj], a0, a1); unpk(hq[g][2 * bj + 1], l0, l1);
                f32x4 g0 = acc[ai][bj][m][0] * rs, g1 = acc[ai][bj][m][1] * rs;
#pragma unroll
                for (int j = 0; j < 4; ++j) { g0[j] = __builtin_amdgcn_rcpf(1.f + __builtin_amdgcn_exp2f(g0[j])); g1[j] = __builtin_amdgcn_rcpf(1.f + __builtin_amdgcn_exp2f(g1[j])); }
                const f32x4 h0 = (a0 + l0) + g0 * t0, h1 = (a1 + l1) + g1 * t1;
                split_store(h0, h1, tx + off + bj * 128, lo + off + bj * 128);
                if (fout) { *(f32x4*)(fout + off + bj * 128) = h0; *(f32x4*)(fout + off + bj * 128 + 4) = h1; }
                s2 += (h0[0] * h0[0] + h0[1] * h0[1]) + (h0[2] * h0[2] + h0[3] * h0[3]) + (h1[0] * h1[0] + h1[1] * h1[1]) + (h1[2] * h1[2] + h1[3] * h1[3]);
            }
            s2 += __shfl_xor(s2, 16); s2 += __shfl_xor(s2, 32);
            if (fq == 0) ssout[(size_t)r * 16 + u.pn * 4 + wc] = s2;
            asm volatile("" ::: "memory");
        }
    }
};

struct TSched {
    int c, c0, G;
    __device__ __forceinline__ bool next(int i, pg8::Unit& u) const { if (c < c0) return false; const int un = (c - c0) + i * (G - c0); if (un >= 256) return false; u.pm = un >> 2; u.pn = un & 3; return true; }
    __device__ __forceinline__ void a_ready(const pg8::Unit&) const {}
    __device__ __forceinline__ void done(const pg8::Unit&) const {}
};
__device__ __forceinline__ void tr_item(const float* W, int K, int N, bf16* WT, LAS float* scr, int item, int lane, const float* g, bool hperm) {
    const int nblk = N / 32, kb = item / nblk, nb = item % nblk, k0 = 64 * kb, n0 = 32 * nb;
    const int kr = lane >> 3, nq = (lane & 7) * 4;
    f32x4 v[8];
#pragma unroll
    for (int i = 0; i < 8; ++i) v[i] = *(const f32x4*)(W + (size_t)(k0 + 8 * i + kr) * N + n0 + nq);
    if (g) {
#pragma unroll
        for (int i = 0; i < 8; ++i) v[i] = v[i] * g[k0 + 8 * i + kr];
    }
#pragma unroll
    for (int i = 0; i < 8; ++i) { LAS float* d = scr + (8 * i + kr) * 33 + nq; d[0] = v[i][0]; d[1] = v[i][1]; d[2] = v[i][2]; d[3] = v[i][3]; }
    LDS_WAIT(); asm volatile("" ::: "memory");
    int d0 = n0; if (hperm) { const int gi = (n0 >> 5) & 7; d0 = (n0 & ~255) + 32 * (4 * (gi & 1) + (gi >> 1)); }
    const int c = lane & 7;
#pragma unroll
    for (int j = 0; j < 4; ++j) { const int n = (lane >> 3) + 8 * j; const LAS float* sp = scr + (8 * c) * 33 + n;
        v4u o; o.x = pk2(sp[0 * 33], sp[1 * 33]); o.y = pk2(sp[2 * 33], sp[3 * 33]); o.z = pk2(sp[4 * 33], sp[5 * 33]); o.w = pk2(sp[6 * 33], sp[7 * 33]);
        *(v4u*)(WT + (size_t)(d0 + n) * K + k0 + 8 * c) = o; }
    LDS_WAIT(); asm volatile("" ::: "memory");
}

__device__ __forceinline__ int crow(int r, int hf) { return (r & 3) + 8 * (r >> 2) + 4 * hf; }
__device__ __forceinline__ void attn_task(const bf16* Q, const bf16* K, const bf16* VT, bf16* Y, int b, int h, int qb, int lane) {
    const int t = lane & 31, hf = lane >> 5, q0 = qb * 32;
    const size_t hb = (size_t)(b * 8 + h) * 64;
    const bf16* qp = Q + ((hb + qb) * 4 * 64 + lane) * 8;
    bf16x8 qr[4];
#pragma unroll
    for (int kk = 0; kk < 4; ++kk) qr[kk] = *(const bf16x8*)(qp + kk * 512);
    const bf16* kbase = K + (hb * 4 * 64 + lane) * 8;
    const bf16* vbase = VT + (hb * 4 * 64 + lane) * 8;
    f32x16 o0, o1;
#pragma unroll
    for (int r = 0; r < 16; ++r) { o0[r] = 0.f; o1[r] = 0.f; }
    float carry = 1.f;
    bf16x8 kn[4], vn[4];
#pragma unroll
    for (int i = 0; i < 4; ++i) { kn[i] = *(const bf16x8*)(kbase + (size_t)qb * 2048 + i * 512); vn[i] = *(const bf16x8*)(vbase + (size_t)qb * 2048 + i * 512); }
    for (int j = qb; j >= 0; --j) {
        bf16x8 kf[4], vf[4];
#pragma unroll
        for (int i = 0; i < 4; ++i) { kf[i] = kn[i]; vf[i] = vn[i]; }
        { const int jn = j > 0 ? j - 1 : 0;
#pragma unroll
          for (int i = 0; i < 4; ++i) { kn[i] = *(const bf16x8*)(kbase + (size_t)jn * 2048 + i * 512); vn[i] = *(const bf16x8*)(vbase + (size_t)jn * 2048 + i * 512); } }
        f32x16 z;
#pragma unroll
        for (int r = 0; r < 16; ++r) z[r] = 0.f;
#pragma unroll
        for (int kk = 0; kk < 4; ++kk) z = __builtin_amdgcn_mfma_f32_32x32x16_bf16(kf[kk], qr[kk], z, 0, 0, 0);
        float om[16], w[16];
        const bool diag = (j == qb);
#pragma unroll
        for (int r = 0; r < 16; ++r) {
            const float e = __builtin_amdgcn_exp2f(fminf(z[r], 100.f));
            float o = __builtin_amdgcn_rcpf(1.f + e), bt = e * o;
            if (diag) { const bool valid = (16 * (r >> 3) + 8 * hf + (r & 7)) < t; o = valid ? o : 1.f; bt = valid ? bt : 0.f; }
            om[r] = o; w[r] = bt;
        }
        float R[2];
#pragma unroll
        for (int ks = 0; ks < 2; ++ks) {
            float x = om[8 * ks + 7];
#pragma unroll
            for (int jj = 6; jj >= 0; --jj) { w[8 * ks + jj] *= x; x *= om[8 * ks + jj]; }
            R[ks] = x;
        }
        const float Rp0 = __shfl_xor(R[0], 32), Rp1 = __shfl_xor(R[1], 32);
        const float T1 = R[1] * Rp1, T0 = R[0] * Rp0;
        const float L1 = hf ? carry : carry * Rp1;
        const float c0 = carry * T1, L0 = hf ? c0 : c0 * Rp0;
        carry = c0 * T0;
#pragma unroll
        for (int jj = 0; jj < 8; ++jj) { w[jj] *= L0; w[8 + jj] *= L1; }
#pragma unroll
        for (int ks = 0; ks < 2; ++ks) {
            v4u pw; pw.x = pk2(w[8 * ks], w[8 * ks + 1]); pw.y = pk2(w[8 * ks + 2], w[8 * ks + 3]); pw.z = pk2(w[8 * ks + 4], w[8 * ks + 5]); pw.w = pk2(w[8 * ks + 6], w[8 * ks + 7]);
            const bf16x8 pf = __builtin_bit_cast(bf16x8, pw);
            o0 = __builtin_amdgcn_mfma_f32_32x32x16_bf16(vf[ks], pf, o0, 0, 0, 0);
            o1 = __builtin_amdgcn_mfma_f32_32x32x16_bf16(vf[2 + ks], pf, o1, 0, 0, 0);
        }
#if ATT_EARLY_EXIT
        if (__all(carry == 0.f)) break;
#endif
    }
    bf16* yp = Y + (size_t)(b * SEQ + q0 + t) * DM + 256 + h * 64 + 4 * hf;
#pragma unroll
    for (int g = 0; g < 4; ++g) {
        v2u a; a.x = pk2(o0[4 * g], o0[4 * g + 1]); a.y = pk2(o0[4 * g + 2], o0[4 * g + 3]); *(v2u*)(yp + 8 * g) = a;
        v2u c; c.x = pk2(o1[4 * g], o1[4 * g + 1]); c.y = pk2(o1[4 * g + 2], o1[4 * g + 3]); *(v2u*)(yp + 32 + 8 * g) = c;
    }
}
__device__ __forceinline__ void sgu_task(const bf16* VNT, const bf16* WSB, const bf16* CU, const float* bias, bf16* Y, int task, int lane) {
    const int tb = task & 3, g = (task >> 2) & 3, c = (task >> 4) & 15, b = task >> 8;
    const int t = lane & 31, hf = lane >> 5;
    const bf16* ap = VNT + (size_t)((b * 4 + g) * 64 + t) * SEQ + 128 * c + 8 * hf;
    const bf16* bp = WSB + (size_t)(g * 128 + 32 * tb + t) * 128 + 8 * hf;
    f32x16 a0, a1;
#pragma unroll
    for (int r = 0; r < 16; ++r) { a0[r] = 0.f; a1[r] = 0.f; }
    bf16x8 bfr[8], af0[8], af1[8];
#pragma unroll
    for (int ks = 0; ks < 8; ++ks) { bfr[ks] = *(const bf16x8*)(bp + 16 * ks); af0[ks] = *(const bf16x8*)(ap + 16 * ks); af1[ks] = *(const bf16x8*)(ap + (size_t)32 * SEQ + 16 * ks); }
#pragma unroll
    for (int ks = 0; ks < 8; ++ks) {
        a0 = __builtin_amdgcn_mfma_f32_32x32x16_bf16(af0[ks], bfr[ks], a0, 0, 0, 0);
        a1 = __builtin_amdgcn_mfma_f32_32x32x16_bf16(af1[ks], bfr[ks], a1, 0, 0, 0);
    }
    const int tok = b * SEQ + 128 * c + 32 * tb + t;
    const float bs = bias[g * 128 + 32 * tb + t];
    const bf16* up = CU + (size_t)tok * 256 + 64 * g + 4 * hf;
    bf16* yp = Y + (size_t)tok * DM + 768 + 64 * g + 4 * hf;
#pragma unroll
    for (int gg = 0; gg < 4; ++gg) {
        const v2u u0 = *(const v2u*)(up + 8 * gg), u1 = *(const v2u*)(up + 32 + 8 * gg);
        v2u a; a.x = pk2(bflo(u0.x) * (a0[4 * gg] + bs), bfhi(u0.x) * (a0[4 * gg + 1] + bs)); a.y = pk2(bflo(u0.y) * (a0[4 * gg + 2] + bs), bfhi(u0.y) * (a0[4 * gg + 3] + bs)); *(v2u*)(yp + 8 * gg) = a;
        v2u d; d.x = pk2(bflo(u1.x) * (a1[4 * gg] + bs), bfhi(u1.x) * (a1[4 * gg + 1] + bs)); d.y = pk2(bflo(u1.y) * (a1[4 * gg + 2] + bs), bfhi(u1.y) * (a1[4 * gg + 3] + bs)); *(v2u*)(yp + 32 + 8 * gg) = d;
    }
}
__device__ __forceinline__ void unpack8(const v4u w, float (&f)[8]) { f[0] = bflo(w.x); f[1] = bfhi(w.x); f[2] = bflo(w.y); f[3] = bfhi(w.y); f[4] = bflo(w.z); f[5] = bfhi(w.z); f[6] = bflo(w.w); f[7] = bfhi(w.w); }
__device__ __forceinline__ void conv_task(const bf16* CONV, const float* cwt, bf16* Y, int task, int lane) {
    const int ch = (lane & 31) * 8;
    float w0[8], w1[8], w2[8];
#pragma unroll
    for (int e = 0; e < 8; ++e) { w0[e] = cwt[ch + e]; w1[e] = cwt[256 + ch + e]; w2[e] = cwt[512 + ch + e]; }
    const bf16* ab = CONV; const bf16* ac = CONV + (size_t)M * 256; const bf16* ah = CONV + (size_t)2 * M * 256;
#pragma unroll 2
    for (int it = 0; it < 8; ++it) {
        const int tok = task * 16 + it * 2 + (lane >> 5), s = tok & (SEQ - 1);
        const size_t o = (size_t)tok * 256 + ch;
        float fb[8], c0[8], h0[8], c1[8], h1[8], c2[8], h2[8];
        unpack8(*(const v4u*)(ab + o), fb); unpack8(*(const v4u*)(ac + o), c0); unpack8(*(const v4u*)(ah + o), h0);
        const v4u zz = (v4u){0u, 0u, 0u, 0u};
        unpack8(s >= 1 ? *(const v4u*)(ac + o - 256) : zz, c1); unpack8(s >= 1 ? *(const v4u*)(ah + o - 256) : zz, h1);
        unpack8(s >= 2 ? *(const v4u*)(ac + o - 512) : zz, c2); unpack8(s >= 2 ? *(const v4u*)(ah + o - 512) : zz, h2);
        float y[8];
#pragma unroll
        for (int e = 0; e < 8; ++e) y[e] = fb[e] * (w2[e] * (c0[e] * h0[e]) + w1[e] * (c1[e] * h1[e]) + w0[e] * (c2[e] * h2[e]));
        v4u w; w.x = pk2(y[0], y[1]); w.y = pk2(y[2], y[3]); w.z = pk2(y[4], y[5]); w.w = pk2(y[6], y[7]);
        *(v4u*)(Y + (size_t)tok * DM + ch) = w;
    }
}

#define RLX_AGENT __ATOMIC_RELAXED, __HIP_MEMORY_SCOPE_AGENT
#define XB_TMO      128
#define XB_XCNT(j)  (256  + 64 * (j))
#define XB_XSUB(j)  (1280 + 64 * (j))
#define XB_XGEN(j)  (2304 + 64 * (j))
#define XB_TOP      3328
#define XB_TOPGEN   3392
#define XCD_BAR_WORDS 3456
#define XB_SPIN_CAP (1u << 18)

__device__ __forceinline__ unsigned xb_ld(unsigned* p)              { return __hip_atomic_load(p, __ATOMIC_RELAXED, __HIP_MEMORY_SCOPE_AGENT); }
__device__ __forceinline__ unsigned xb_add(unsigned* p, unsigned v) { return __hip_atomic_fetch_add(p, v, __ATOMIC_RELAXED, __HIP_MEMORY_SCOPE_AGENT); }
__device__ __forceinline__ unsigned xb_xcc_id() { return (unsigned)__builtin_amdgcn_s_getreg((3 << 11) | 20) & 0xFu; }
#define XB_SPIN(cond, bar) do { unsigned _sp = 0; while (cond) { __builtin_amdgcn_s_sleep(1); \
    if ((++_sp & 255u) == 0u) { if (xb_ld(&(bar)[XB_TMO])) break; if (_sp > XB_SPIN_CAP) { atomicAdd(&(bar)[XB_TMO], 1u); break; } } } } while (0)

struct XcdBarrier {
    unsigned* bar; unsigned x;
    volatile LAS unsigned* st;
};

__device__ __forceinline__ XcdBarrier xcd_barrier_post(unsigned* bar, volatile LAS unsigned* st) {
    XcdBarrier b; b.bar = bar; b.x = xb_xcc_id(); b.st = st;
    if (threadIdx.x == 0) (void)xb_add(&bar[XB_XCNT(b.x)], 1u);
    return b;
}
__device__ __forceinline__ void xcd_barrier_complete(unsigned* bar, unsigned x, unsigned& nloc, unsigned& nx) {
    const unsigned G = gridDim.x * gridDim.y * gridDim.z;
    unsigned sum, cnt, mine, sp = 0u;
    for (;;) {
        sum = 0u; cnt = 0u; mine = 0u;
#pragma unroll
        for (unsigned j = 0; j < 16; ++j) { const unsigned c = xb_ld(&bar[XB_XCNT(j)]); sum += c; cnt += (c > 0u) ? 1u : 0u; mine = (j == x) ? c : mine; }
        if (sum == G) break;
        __builtin_amdgcn_s_sleep(1);
        if ((++sp & 255u) == 0u) { if (xb_ld(&bar[XB_TMO])) break; if (sp > XB_SPIN_CAP) { atomicAdd(&bar[XB_TMO], 1u); break; } }
    }
    nloc = mine > 0u ? mine : 1u; nx = cnt > 0u ? cnt : 1u;
}

__device__ __forceinline__ void xcd_barrier(const XcdBarrier& b) {
    asm volatile("s_waitcnt vmcnt(0)" ::: "memory");
    __syncthreads();
    if (threadIdx.x == 0) {
        unsigned* bar = b.bar;
        __builtin_amdgcn_s_waitcnt(0);
        unsigned nloc = b.st[0], nx = b.st[1];
        if (nloc == 0u) { xcd_barrier_complete(bar, b.x, nloc, nx); b.st[0] = nloc; b.st[1] = nx; }
        const unsigned old = xb_add(&bar[XB_XSUB(b.x)], 1u);
        const unsigned gen = old / nloc;
        if (old + 1u == (gen + 1u) * nloc) {
            __builtin_amdgcn_fence(__ATOMIC_RELEASE, "agent");
            asm volatile("s_waitcnt vmcnt(0)" ::: "memory");
            const unsigned og = xb_add(&bar[XB_TOP], 1u);
            const unsigned tg = og / nx;
            if (og + 1u == (tg + 1u) * nx) xb_add(&bar[XB_TOPGEN], 1u);
            else XB_SPIN(xb_ld(&bar[XB_TOPGEN]) == tg, bar);
            __builtin_amdgcn_fence(__ATOMIC_ACQUIRE, "agent");
            xb_add(&bar[XB_XGEN(b.x)], 1u);
            asm volatile("s_waitcnt vmcnt(0)" ::: "memory");
        } else {
            XB_SPIN(xb_ld(&bar[XB_XGEN(b.x)]) == gen, bar);
            __builtin_amdgcn_fence(__ATOMIC_ACQUIRE, "agent");
            asm volatile("s_waitcnt vmcnt(0)" ::: "memory");
        }
    }
    __syncthreads();
}

struct Args { const float* in[17]; float* out; unsigned char* ws; int ph_lo, ph_hi; };
__global__ void __launch_bounds__(NWAVES * 64, 2) mk_fwd(Args a) {
    extern __shared__ __attribute__((aligned(16))) unsigned char lds_raw[];
    LAS unsigned char* lds = (LAS unsigned char*)lds_raw;
    const int tid = threadIdx.x, lane = tid & 63, wave = __builtin_amdgcn_readfirstlane(tid >> 6);
    const int G = gridDim.x; const int bx = blockIdx.x; const int vcu = (G % 8 == 0) ? (bx % 8) * (G / 8) + bx / 8 : bx;
    const int gw = vcu * NWAVES + wave, NGW = G * NWAVES;
    const int lo = a.ph_lo, hi = a.ph_hi;
    volatile LAS unsigned* bst = (volatile LAS unsigned*)(lds + RING_BYTES);
    if (tid < 4) bst[tid] = 0u;
    __syncthreads();
    XcdBarrier bar = xcd_barrier_post((unsigned*)(a.ws + WS_CTL), bst);
    unsigned char* ws = a.ws;
    const float* x = a.in[0]; const float* p = a.in[1];
    bf16* Wb = (bf16*)(ws + WS_W); bf16* WSBb = (bf16*)(ws + WS_WSB); float* SS = (float*)(ws + WS_SS);
    bf16* HB = (bf16*)(ws + WS_HB); bf16* LO = (bf16*)(ws + WS_LO); bf16* XB = (bf16*)(ws + WS_XB);
    bf16* PB = (bf16*)a.out;
    unsigned char* big = ws + WS_BIG;
    bf16* CONV = (bf16*)(big + B_CONV); bf16* Qb = (bf16*)(big + B_Q); bf16* Kb = (bf16*)(big + B_K); bf16* VTb = (bf16*)(big + B_VT); bf16* CUb = (bf16*)(big + B_CU);
    bf16* VNTb = (bf16*)(big + B_VNT); bf16* Yb = (bf16*)(big + B_Y); bf16* Fb = (bf16*)big;
    float* H = a.out;
#define IN(k) (lo <= (k) && (k) < hi)
#define SEAM(k) do { if (IN(k) && IN((k) + 1)) { if ((k) == 0) cg::this_grid().sync(); else xcd_barrier(bar); } } while (0)

    if (IN(0)) for (int rep_ = 0; rep_ < PROBE_P; ++rep_) {
        LAS float* scr = (LAS float*)(lds + wave * 16384);
        constexpr int I_IN = (DM / 64) * (NIN / 32), I_OUT = (DM / 64) * (DM / 32), I_1 = (DM / 64) * (DFF / 32), I_2 = (DFF / 64) * (DM / 32), I_G = I_OUT, I_P = (PLE / 64) * (DM / 32);
        constexpr int I_LAYER = I_IN + I_OUT + I_1 + I_2 + I_G + I_P;
        for (int it = gw; it < DEPTH * I_LAYER; it += NGW) {
            const int l = it / I_LAYER; int r = it % I_LAYER; bf16* wl = Wb + (size_t)l * E_WLAYER;
            if (r < I_IN) { tr_item(a.in[3] + (size_t)l * DM * NIN, DM, NIN, wl + E_WIN, scr, r, lane, a.in[2] + l * DM, true); continue; } r -= I_IN;
            if (r < I_OUT) { tr_item(a.in[10] + (size_t)l * DM * DM, DM, DM, wl + E_WOUT, scr, r, lane, nullptr, false); continue; } r -= I_OUT;
            if (r < I_1) { tr_item(a.in[12] + (size_t)l * DM * DFF, DM, DFF, wl + E_W1, scr, r, lane, a.in[11] + l * DM, false); continue; } r -= I_1;
            if (r < I_2) { tr_item(a.in[13] + (size_t)l * DFF * DM, DFF, DM, wl + E_W2, scr, r, lane, nullptr, false); continue; } r -= I_2;
            if (r < I_G) { tr_item(a.in[15] + (size_t)l * DM * DM, DM, DM, wl + E_WG, scr, r, lane, a.in[14] + l * DM, false); continue; } r -= I_G;
            tr_item(a.in[16] + (size_t)l * PLE * DM, PLE, DM, wl + E_WP, scr, r, lane, nullptr, false);
        }
        for (int i = gw * 64 + lane; i < DEPTH * 4 * 128 * 128; i += NGW * 64) { const int s = i & 127, t = (i >> 7) & 127; WSBb[i] = (bf16)f2bf(s <= t ? a.in[8][i] : 0.f); }
        for (int m = gw; m < M; m += NGW) {
            const f32x4* xr = (const f32x4*)(x + (size_t)m * DM) + lane; f32x4 v[4]; float s = 0.f;
#pragma unroll
            for (int j = 0; j < 4; ++j) { v[j] = xr[64 * j]; s += (v[j].x * v[j].x + v[j].y * v[j].y) + (v[j].z * v[j].z + v[j].w * v[j].w); }
            s = wave_sum(s);
            v2u* o8 = (v2u*)(XB + (size_t)m * DM) + lane;
            v2u* l8 = (v2u*)(LO + (size_t)m * DM) + lane;
#pragma unroll
            for (int j = 0; j < 4; ++j) { v2u w; w.x = pk2(v[j].x, v[j].y); w.y = pk2(v[j].z, v[j].w); o8[64 * j] = w;
                v2u d; d.x = pk2(v[j].x - bflo(w.x), v[j].y - bfhi(w.x)); d.y = pk2(v[j].z - bflo(w.y), v[j].w - bfhi(w.y)); l8[64 * j] = d; }
            if (lane < 16) SS[(size_t)m * 16 + lane] = lane == 0 ? s : 0.f;
        }
        for (int it = gw; it < M * PLE / 512; it += NGW) { const size_t o = (size_t)it * 512 + lane * 8; const f32x4 u0 = *(const f32x4*)(p + o), u1 = *(const f32x4*)(p + o + 4);
            v4u w; w.x = pk2(u0.x, u0.y); w.y = pk2(u0.z, u0.w); w.z = pk2(u1.x, u1.y); w.w = pk2(u1.z, u1.w); *(v4u*)(PB + o) = w; }
        asm volatile("s_waitcnt vmcnt(0) lgkmcnt(0)" ::: "memory"); __syncthreads();
    }
    SEAM(0);

    for (int l = 0; l < DEPTH; ++l) {
        const int pb = 1 + 6 * l;
        const bf16* wl = Wb + (size_t)l * E_WLAYER;
        bf16* bufX = (l & 1) ? HB : XB; bf16* bufT = (l & 1) ? XB : HB;
        float* ss1 = SS; float* ss2 = SS + (size_t)M * 16; float* ss3 = SS + (size_t)2 * M * 16; float* ss1n = ss1;
        if (IN(pb)) for (int rep_ = 0; rep_ < PROBE_A; ++rep_) {
#ifndef NO_A
            { pg8::Gemm g{bufX, wl + E_WIN, M, NIN, DM}; pg8::StaticOrder S; S.init(M, NIN, G, bx);
              EpiInProj E{ss1, CONV, Qb, Kb, VTb, CUb, VNTb, a.in[5] + l * 64, a.in[6] + l * 64, a.in[7] + l * 256};
              pg8::gemm_phase<EpiInProj, pg8::StaticOrder, true, true>(lds, g, S, E); }
            { int kp = PLE; asm volatile("" : "+s"(kp)); pg8::Gemm g{PB, wl + E_WP, M, DM, kp}; TSched S{bx, (M / 256 * (NIN / 256)) % G, G};
              EpiT E{bufT};
              pg8::gemm_phase<EpiT, TSched, true, true>(lds, g, S, E); }
#endif
        }
        SEAM(pb);
        if (IN(pb + 1)) for (int rep_ = 0; rep_ < PROBE_B; ++rep_) {
            int lane_ = lane; asm volatile("" : "+v"(lane_));
#ifndef NO_ATT
            for (int pr = gw; pr < 2048; pr += NGW) { const int bh = pr >> 5, i = pr & 31;
                attn_task(Qb, Kb, VTb, Yb, bh >> 3, bh & 7, 63 - i, lane_);
                attn_task(Qb, Kb, VTb, Yb, bh >> 3, bh & 7, i, lane_); }
#endif
#ifndef NO_SGU
            for (int tk = gw; tk < 2048; tk += NGW) sgu_task(VNTb, WSBb + (size_t)l * 4 * 128 * 128, CUb, a.in[9] + l * 512, Yb, tk, lane_);
#endif
#ifndef NO_CONV
            for (int tk = gw; tk < 1024; tk += NGW) conv_task(CONV, a.in[4] + l * 768, Yb, tk, lane_);
#endif
            const float* pl = p + (size_t)(l + 1 < DEPTH ? l + 1 : l) * M * PLE;
#pragma unroll 4
            for (int it = gw; it < M * PLE / 512; it += NGW) { const size_t o = (size_t)it * 512 + lane_ * 8; const f32x4 u0 = *(const f32x4*)(pl + o), u1 = *(const f32x4*)(pl + o + 4);
                v4u w; w.x = pk2(u0.x, u0.y); w.y = pk2(u0.z, u0.w); w.z = pk2(u1.x, u1.y); w.w = pk2(u1.z, u1.w); *(v4u*)(PB + o) = w; }
            asm volatile("s_waitcnt vmcnt(0) lgkmcnt(0)" ::: "memory"); __syncthreads();
        }
        SEAM(pb + 1);
        if (IN(pb + 2)) {
#ifndef NO_C
#ifndef NO_O
            { pg8::Gemm g{Yb, wl + E_WOUT, M, DM, DM}; pg8::StaticOrder S; S.init(M, DM, G, bx);
              EpiRes E{bufX, LO, ss2};
              pg8::gemm_phase<EpiRes, pg8::StaticOrder, true, true>(lds, g, S, E); }
#endif
#endif
        }
        SEAM(pb + 2);
        if (IN(pb + 3)) for (int rep_ = 0; rep_ < PROBE_D; ++rep_) {
#ifndef NO_D
            pg8::Gemm g{bufX, wl + E_W1, M, DFF, DM}; pg8::StaticOrder S; S.init(M, DFF, G, bx);
            EpiFF1 E{ss2, Fb};
            pg8::gemm_phase<EpiFF1, pg8::StaticOrder, true, true>(lds, g, S, E);
#endif
        }
        SEAM(pb + 3);
        if (IN(pb + 4)) {
#ifndef NO_E
            pg8::Gemm g{Fb, wl + E_W2, M, DM, DFF}; pg8::StaticOrder S; S.init(M, DM, G, bx);
            EpiRes E{bufX, LO, ss3};
            pg8::gemm_phase<EpiRes, pg8::StaticOrder, true, true>(lds, g, S, E);
#endif
        }
        SEAM(pb + 4);
        if (IN(pb + 5)) {
#ifndef NO_F
            pg8::Gemm g{bufX, wl + E_WG, M, DM, DM}; pg8::StaticOrder S; S.init(M, DM, G, bx);
            EpiGate E{ss3, bufX, LO, bufT, ss1n, l == DEPTH - 1 ? H : (float*)nullptr};
            pg8::gemm_phase<EpiGate, pg8::StaticOrder, true, true>(lds, g, S, E);
#endif
        }
        SEAM(pb + 5);
    }
#undef IN
#undef SEAM
}

extern "C" void kernel_launch(void* const* d_in, const int* in_sizes, int n_in, void* d_out, int out_size, void* d_ws, size_t ws_size, hipStream_t stream) {
    static int grid = 0;
    if (grid == 0) {
        if (n_in != 17 || in_sizes[0] != M * DM || out_size != M * DM || ws_size < WS_TOTAL) { fprintf(stderr, "kernel_launch: unexpected shapes (n_in %d, in0 %d, out %d, ws %zu, need %zu)\n", n_in, n_in > 0 ? in_sizes[0] : -1, out_size, ws_size, (size_t)WS_TOTAL); grid = -1; return; }
        int dev = 0, cus = 0, per_cu = 0;
        hipGetDevice(&dev); hipDeviceGetAttribute(&cus, hipDeviceAttributeMultiprocessorCount, dev);
        if (hipFuncSetAttribute((const void*)mk_fwd, hipFuncAttributeMaxDynamicSharedMemorySize, LDS_BYTES) != hipSuccess) { fprintf(stderr, "kernel_launch: hipFuncSetAttribute failed\n"); grid = -1; return; }
        if (hipOccupancyMaxActiveBlocksPerMultiprocessor(&per_cu, (const void*)mk_fwd, NWAVES * 64, LDS_BYTES) != hipSuccess || per_cu < 1) { fprintf(stderr, "kernel_launch: occupancy query says %d\n", per_cu); per_cu = 1; }
        (void)hipGetLastError();
        grid = cus * 1;
    }
    if (grid < 0) return;
#ifdef DBG_MEMSET
    (void)hipMemsetAsync(d_ws, 0xAA, WS_END, stream); (void)hipMemsetAsync(d_out, 0xAA, (size_t)M * DM * 4, stream);
#endif
    if (hipMemsetAsync((char*)d_ws + WS_CTL, 0, CTL_BYTES, stream) != hipSuccess) { fprintf(stderr, "kernel_launch: memset of the barrier words failed\n"); return; }
    Args a{};
    for (int i = 0; i < 17; ++i) a.in[i] = (const float*)d_in[i];
    a.out = (float*)d_out; a.ws = (unsigned char*)d_ws;
#if MK_N_LAUNCHES == 1
    a.ph_lo = 0; a.ph_hi = NPHASE;
    void* args[] = {&a};
    hipError_t e = hipLaunchCooperativeKernel((const void*)mk_fwd, dim3(grid), dim3(NWAVES * 64), args, LDS_BYTES, stream);
    if (e != hipSuccess) fprintf(stderr, "cooperative launch failed: %s (grid %d)\n", hipGetErrorString(e), grid);
#else
    for (int ph = 0; ph < NPHASE; ++ph) { a.ph_lo = ph; a.ph_hi = ph + 1; hipLaunchKernelGGL(mk_fwd, dim3(grid), dim3(NWAVES * 64), LDS_BYTES, stream, a); }
#endif
}
```

```cpp
#include <hip/hip_runtime.h>
#include <hip/hip_cooperative_groups.h>
#include <cstdio>
#include <cstdint>
namespace cg = cooperative_groups;
namespace pg8 {
#define PG8_LAS __attribute__((address_space(3)))
typedef unsigned short bf16_t;
typedef short bf16x8 __attribute__((ext_vector_type(8)));
typedef float f32x4 __attribute__((ext_vector_type(4)));
typedef unsigned u32x4 __attribute__((ext_vector_type(4)));
constexpr int BM = 256, BK = 64, HALF = 128, HTB = HALF * BK * 2  , STAGE_BYTES = 8 * HTB, NXCD = 8, WGM = 8;

__host__ __device__ __forceinline__ int lds_byte(int r, int c) { const int st = (r >> 4) * 2 + (c >> 5), rr = r & 15, cc = c & 31, ob = rr * 64 + cc * 2; return st * 1024 + (ob ^ (((ob >> 9) & 1) << 5)); }
__host__ __device__ __forceinline__ void stage_rc(int b, int& R, int& C) { const int st = b / 1024, sb = b % 1024, swz = sb ^ (((sb >> 9) & 1) << 5); R = (st >> 1) * 16 + swz / 64; C = (st & 1) * 32 + (swz % 64) / 2; }
__host__ __device__ __forceinline__ int perm32(int rho) { const int n = rho >> 4, i = rho & 15; return 8 * (i >> 2) + 4 * n + (i & 3); }

struct Unit { int pm, pn; };
struct Gemm { const bf16_t* A; const bf16_t* Bt; int M, N, K; };

struct StaticOrder {
    int nM, nN, nwg, G, c;
    __host__ __device__ void init(int M, int N, int G_, int c_) { nM = M / BM; nN = N / BM; nwg = nM * nN; G = G_; c = c_; }
    __host__ __device__ bool next(int i, Unit& u) const {
        const long L = (long)i * G + c; if (L >= nwg) return false;
        int wgid = (int)L; { const int q = nwg / NXCD, r = nwg % NXCD, xcd = wgid % NXCD, off = wgid / NXCD; wgid = (xcd < r ? xcd * (q + 1) : r * (q + 1) + (xcd - r) * q) + off; }
        const int nig = WGM * nN, gid = wgid / nig, fm = gid * WGM, gsz = (nM - fm) < WGM ? (nM - fm) : WGM;
        u.pm = fm + ((wgid % nig) % gsz); u.pn = (wgid % nig) / gsz; return true;
    }
    __device__ __forceinline__ void a_ready(const Unit&) const {}
    __device__ __forceinline__ void done(const Unit&) const {}
};

__device__ __forceinline__ unsigned cvt_pk_bf16(float lo, float hi) { unsigned r; asm volatile("v_cvt_pk_bf16_f32 %0, %1, %2" : "=v"(r) : "v"(lo), "v"(hi)); return r; }
typedef float f32x2 __attribute__((ext_vector_type(2)));
__device__ __forceinline__ f32x2 gelu_pk(f32x2 v) {
    const f32x2 av = __builtin_elementwise_abs(v), d = av * 0.2316418882f + 1.0f;
    f32x2 t; t.x = __builtin_amdgcn_rcpf(d.x); t.y = __builtin_amdgcn_rcpf(d.y);
    f32x2 q = t * 0.5307027145f + (-0.7265760135f); q = q * t + 0.7107068705f; q = q * t + (-0.142248368f); q = q * t + 0.127414796f; q = q * t;
    const f32x2 s = (v * v) * (-0.72134752044f);
    f32x2 e; e.x = __builtin_amdgcn_exp2f(s.x); e.y = __builtin_amdgcn_exp2f(s.y);
    const f32x2 m = v * (q * e), r = v - m;
    f32x2 o; o.x = v.x < 0.f ? m.x : r.x; o.y = v.y < 0.f ? m.y : r.y; return o;
}

template <int ACT  > struct EpiBf16 {
    static constexpr bool PERM = true, AFTER_DRAIN = false; static_assert(ACT == 0 || ACT == 1, "EpiBf16: ACT is 0 (none) or 1 (gelu_pk)");
    bf16_t* O; int ldc; const float* bias; int split_cols; size_t split_stride; float scale0;
    __device__ __forceinline__ void operator()(const f32x4 (&acc)[2][2][4][2], const Unit& u, int wr, int wc, int fr, int fq) const {
        const int row0 = u.pm * BM + wr * 64 + fr; int colt = u.pn * BM; bf16_t* base = O;
        float sc = 1.f; if (split_cols) { const int t = colt / split_cols; base += (size_t)t * split_stride; colt -= t * split_cols; if (t == 0) sc = scale0; }
        const int col0 = colt + wc * 32 + 8 * fq, bcol0 = u.pn * BM + wc * 32 + 8 * fq;
        f32x4 bv[2][2];
#pragma unroll
        for (int bj = 0; bj < 2; ++bj)
#pragma unroll
            for (int n = 0; n < 2; ++n) bv[bj][n] = bias ? *(const f32x4*)(bias + bcol0 + bj * HALF + 4 * n) : (f32x4){0.f, 0.f, 0.f, 0.f};
#pragma unroll
        for (int ai = 0; ai < 2; ++ai)
#pragma unroll
            for (int m = 0; m < 4; ++m) { bf16_t* rowp = base + (size_t)(row0 + ai * HALF + m * 16) * ldc + col0;
#pragma unroll
                for (int bj = 0; bj < 2; ++bj) { f32x4 v0 = acc[ai][bj][m][0] + bv[bj][0], v1 = acc[ai][bj][m][1] + bv[bj][1];
                    if (ACT == 1) { f32x2 a = gelu_pk((f32x2){v0[0], v0[1]}), b = gelu_pk((f32x2){v0[2], v0[3]}), c = gelu_pk((f32x2){v1[0], v1[1]}), d = gelu_pk((f32x2){v1[2], v1[3]});
                        v0 = (f32x4){a.x, a.y, b.x, b.y}; v1 = (f32x4){c.x, c.y, d.x, d.y}; }
                    v0 = v0 * sc; v1 = v1 * sc; u32x4 w; w.x = cvt_pk_bf16(v0[0], v0[1]); w.y = cvt_pk_bf16(v0[2], v0[3]); w.z = cvt_pk_bf16(v1[0], v1[1]); w.w = cvt_pk_bf16(v1[2], v1[3]);
                    *(u32x4*)(rowp + bj * HALF) = w; } }
    }
};
template <class Epi, class Sched, bool ALIGN_EPI = false, bool SP2 = false>
__device__ __forceinline__ void gemm_phase(PG8_LAS unsigned char* lds, const Gemm g, const Sched& S, const Epi& E) {
    int tid_ = threadIdx.x; asm volatile("" : "+v"(tid_));
    const int tid = tid_, wid = __builtin_amdgcn_readfirstlane(tid >> 6), lane = tid & 63, wr = wid >> 2, wc = wid & 3, fr = lane & 15, fq = lane >> 4;
    const int K = g.K, nt = K / BK;
    unsigned voffA[2], voffB[2];
#pragma unroll
    for (int i = 0; i < 2; ++i) { int R, C; stage_rc(tid * 16 + i * 8192, R, C); const int Rb = Epi::PERM ? ((R & ~31) + perm32(R & 31)) : R;
        voffA[i] = (unsigned)(R * K + C) * 2u; voffB[i] = (unsigned)(Rb * K + C) * 2u; }
    const size_t kstep = (size_t)(BK * 2);
    const size_t hstep = (size_t)HALF * K * 2;
    const size_t tstep = 2 * hstep;
    const unsigned ldsw = (unsigned)wid * 1024u;
    const int aoff = lds_byte(wr * 64 + fr, fq * 8), boff = lds_byte(wc * 32 + fr, fq * 8);
#define PG8_SA(b, h) (((b) * 2 + (h)) * HTB)
#define PG8_SB(b, h) ((4 + (b) * 2 + (h)) * HTB)
#define PG8_STAGE(bufoff, gbase, voff) do { _Pragma("unroll") for (int _i = 0; _i < 2; ++_i) \
        __builtin_amdgcn_global_load_lds((const unsigned*)((const char*)(gbase) + (voff)[_i]), (PG8_LAS unsigned*)(lds + (bufoff) + ldsw + _i * 8192), 16, 0, 0); } while (0)
#define PG8_LDA(dst, b, h) do { _Pragma("unroll") for (int m = 0; m < 4; ++m) _Pragma("unroll") for (int k = 0; k < 2; ++k) dst[m][k] = *(const PG8_LAS bf16x8*)(lds + PG8_SA(b, h) + aoff + m * 2048 + k * 1024); } while (0)
#define PG8_LDB(dst, b, h) do { _Pragma("unroll") for (int n = 0; n < 2; ++n) _Pragma("unroll") for (int k = 0; k < 2; ++k) dst[n][k] = *(const PG8_LAS bf16x8*)(lds + PG8_SB(b, h) + boff + n * 2048 + k * 1024); } while (0)
#define PG8_MMA(ai, bj, At, Bt) do { __builtin_amdgcn_s_setprio(1); _Pragma("unroll") for (int m = 0; m < 4; ++m) _Pragma("unroll") for (int n = 0; n < 2; ++n) _Pragma("unroll") for (int k = 0; k < 2; ++k) \
        acc[ai][bj][m][n] = __builtin_amdgcn_mfma_f32_16x16x32_bf16(Bt[n][k], At[m][k], acc[ai][bj][m][n], 0, 0, 0); __builtin_amdgcn_s_setprio(0); } while (0)
#define PG8_WAIT_V(n) asm volatile("s_waitcnt vmcnt(" #n ")" ::: "memory")
#define PG8_WAIT_L(n) asm volatile("s_waitcnt lgkmcnt(" #n ")" ::: "memory")
#define PG8_BAR __builtin_amdgcn_s_barrier()
#define PG8_SCHED __builtin_amdgcn_sched_barrier(0)
    Unit cur, nxt; int ui = 0;
    if (!S.next(0, cur)) return;
    f32x4 acc[2][2][4][2];
#pragma unroll
    for (int a = 0; a < 2; ++a)
#pragma unroll
        for (int b = 0; b < 2; ++b)
#pragma unroll
            for (int m = 0; m < 4; ++m)
#pragma unroll
                for (int n = 0; n < 2; ++n) acc[a][b][m][n] = (f32x4){0.f, 0.f, 0.f, 0.f};
    bf16x8 At[4][2], B0[2][2], B1[2][2];
    const char* cA = (const char*)g.A + (size_t)cur.pm * tstep; const char* cB = (const char*)g.Bt + (size_t)cur.pn * tstep;
    S.a_ready(cur);
    if constexpr (SP2) {
        PG8_STAGE(PG8_SB(0, 0), cB, voffB); PG8_STAGE(PG8_SB(0, 1), cB + hstep, voffB); PG8_STAGE(PG8_SA(0, 0), cA, voffA); PG8_STAGE(PG8_SA(0, 1), cA + hstep, voffA);
        if (wr == 1) PG8_BAR;
        PG8_WAIT_V(2); PG8_BAR;
        PG8_STAGE(PG8_SB(1, 0), cB + kstep, voffB); PG8_STAGE(PG8_SA(1, 0), cA + kstep, voffA); PG8_STAGE(PG8_SB(1, 1), cB + hstep + kstep, voffB);
        PG8_WAIT_V(6); PG8_BAR;
    } else {
        PG8_STAGE(PG8_SB(0, 0), cB, voffB); PG8_STAGE(PG8_SA(0, 0), cA, voffA); PG8_STAGE(PG8_SB(0, 1), cB + hstep, voffB); PG8_STAGE(PG8_SA(0, 1), cA + hstep, voffA);
        if (wr == 1) PG8_BAR;
        PG8_WAIT_V(4); PG8_BAR;
        PG8_STAGE(PG8_SB(1, 0), cB + kstep, voffB); PG8_STAGE(PG8_SA(1, 0), cA + kstep, voffA); PG8_STAGE(PG8_SB(1, 1), cB + hstep + kstep, voffB);
        PG8_WAIT_V(6); PG8_BAR;
    }
    for (;;) {
        const bool has_next = S.next(ui + 1, nxt);
        const char* nA = has_next ? (const char*)g.A + (size_t)nxt.pm * tstep : cA; const char* nB = has_next ? (const char*)g.Bt + (size_t)nxt.pn * tstep : cB;
        for (int t = 0; t < nt; t += 2) {
            const bool last = (t == nt - 2);
            const char* a1 = cA + (size_t)(t + 1) * kstep;
            const char* a2 = last ? nA : cA + (size_t)(t + 2) * kstep; const char* b2 = last ? nB : cB + (size_t)(t + 2) * kstep;
            const char* a3 = a2 + kstep; const char* b3 = b2 + kstep;
            if (last && has_next) S.a_ready(nxt);
            if constexpr (SP2) {
            PG8_LDB(B0, 0, 0); PG8_LDB(B1, 0, 1); PG8_SCHED; PG8_LDA(At, 0, 0); PG8_STAGE(PG8_SA(1, 1), a1 + hstep, voffA);
            PG8_WAIT_V(8); PG8_WAIT_L(0); PG8_BAR; PG8_MMA(0, 0, At, B0); PG8_MMA(0, 1, At, B1); PG8_BAR; PG8_SCHED;
            PG8_LDA(At, 0, 1); PG8_STAGE(PG8_SB(0, 0), b2, voffB); PG8_STAGE(PG8_SB(0, 1), b2 + hstep, voffB); PG8_STAGE(PG8_SA(0, 0), a2, voffA);
            PG8_WAIT_V(8); PG8_WAIT_L(0); PG8_BAR; PG8_MMA(1, 0, At, B0); PG8_MMA(1, 1, At, B1); PG8_BAR; PG8_SCHED;
            PG8_LDB(B0, 1, 0); PG8_LDB(B1, 1, 1); PG8_SCHED; PG8_LDA(At, 1, 0); PG8_STAGE(PG8_SA(0, 1), a2 + hstep, voffA);
            PG8_WAIT_V(8); PG8_WAIT_L(0); PG8_BAR; PG8_MMA(0, 0, At, B0); PG8_MMA(0, 1, At, B1); PG8_BAR; PG8_SCHED;
            PG8_LDA(At, 1, 1); PG8_STAGE(PG8_SB(1, 0), b3, voffB); PG8_STAGE(PG8_SB(1, 1), b3 + hstep, voffB); PG8_STAGE(PG8_SA(1, 0), a3, voffA);
            PG8_WAIT_V(8); PG8_WAIT_L(0); PG8_BAR; PG8_MMA(1, 0, At, B0); PG8_MMA(1, 1, At, B1); PG8_BAR; PG8_SCHED;
            } else {
            PG8_LDB(B0, 0, 0); PG8_SCHED; PG8_LDA(At, 0, 0); PG8_STAGE(PG8_SA(1, 1), a1 + hstep, voffA);
            PG8_WAIT_L(8); PG8_BAR; PG8_WAIT_L(0); PG8_MMA(0, 0, At, B0); PG8_BAR; PG8_SCHED;
            PG8_LDB(B1, 0, 1); PG8_STAGE(PG8_SB(0, 0), b2, voffB);
            PG8_BAR; PG8_WAIT_L(0); PG8_MMA(0, 1, At, B1); PG8_BAR;
            PG8_LDA(At, 0, 1); PG8_STAGE(PG8_SA(0, 0), a2, voffA);
            PG8_BAR; PG8_WAIT_L(0); PG8_MMA(1, 0, At, B0); PG8_BAR; PG8_SCHED;
            PG8_STAGE(PG8_SB(0, 1), b2 + hstep, voffB);
            PG8_WAIT_V(6); PG8_BAR; PG8_MMA(1, 1, At, B1); PG8_BAR;
            PG8_LDB(B0, 1, 0); PG8_SCHED; PG8_LDA(At, 1, 0); PG8_STAGE(PG8_SA(0, 1), a2 + hstep, voffA);
            PG8_WAIT_L(8); PG8_BAR; PG8_WAIT_L(0); PG8_MMA(0, 0, At, B0); PG8_BAR; PG8_SCHED;
            PG8_LDB(B1, 1, 1); PG8_STAGE(PG8_SB(1, 0), b3, voffB);
            PG8_BAR; PG8_WAIT_L(0); PG8_MMA(0, 1, At, B1); PG8_BAR;
            PG8_LDA(At, 1, 1); PG8_STAGE(PG8_SA(1, 0), a3, voffA);
            PG8_BAR; PG8_WAIT_L(0); PG8_MMA(1, 0, At, B0); PG8_BAR; PG8_SCHED;
            PG8_STAGE(PG8_SB(1, 1), b3 + hstep, voffB);
            PG8_WAIT_V(6); PG8_BAR; PG8_MMA(1, 1, At, B1); PG8_BAR;
            }
        }
        if constexpr (ALIGN_EPI) { if (wr == 0) PG8_BAR; }
        if constexpr (!Epi::AFTER_DRAIN) { E(acc, cur, wr, wc, fr, fq); S.done(cur); }
        if (!has_next) break;
#pragma unroll
        for (int a = 0; a < 2; ++a)
#pragma unroll
            for (int b = 0; b < 2; ++b)
#pragma unroll
                for (int m = 0; m < 4; ++m)
#pragma unroll
                    for (int n = 0; n < 2; ++n) acc[a][b][m][n] = (f32x4){0.f, 0.f, 0.f, 0.f};
        cur = nxt; cA = nA; cB = nB; ++ui;
        if constexpr (ALIGN_EPI) { if (wr == 1) PG8_BAR; }
    }
    PG8_WAIT_V(0);
    if constexpr (!ALIGN_EPI) { if (wr == 0) PG8_BAR; }
    PG8_BAR;
    if constexpr (Epi::AFTER_DRAIN) { E.fused(acc, cur, wr, wc, fr, fq, lds, wid, lane); S.done(cur); }
#undef PG8_SA
#undef PG8_SB
#undef PG8_STAGE
#undef PG8_LDA
#undef PG8_LDB
#undef PG8_MMA
#undef PG8_WAIT_V
#undef PG8_WAIT_L
#undef PG8_BAR
#undef PG8_SCHED
}
}

#ifndef MK_N_LAUNCHES
#define MK_N_LAUNCHES 1
#endif
#ifndef ATT_EARLY_EXIT
#define ATT_EARLY_EXIT 1
#endif
constexpr int NWAVES = 8;
constexpr int M = 16384, DM = 1024, SEQ = 2048, DEPTH = 4, NIN = 2816, DFF = 4096, PLE = 256;
constexpr float EPS = 1e-6f;
constexpr float C2 = 0.125f * 1.4426950408889634f;
constexpr int NPHASE = 1 + 6 * DEPTH;
#ifndef PROBE_B
#define PROBE_B 1
#endif
#ifndef PROBE_SYNC
#define PROBE_SYNC 1
#endif
#ifndef PROBE_P
#define PROBE_P 1
#endif
#ifndef PROBE_A
#define PROBE_A 1
#endif
#ifndef PROBE_D
#define PROBE_D 1
#endif

typedef unsigned short bf16;
#define LAS __attribute__((address_space(3)))
typedef unsigned v4u __attribute__((ext_vector_type(4)));
typedef unsigned v2u __attribute__((ext_vector_type(2)));
typedef float f32x4 __attribute__((ext_vector_type(4)));
typedef float f32x2 __attribute__((ext_vector_type(2)));
typedef float f32x16 __attribute__((ext_vector_type(16)));
typedef short bf16x8 __attribute__((ext_vector_type(8)));
typedef short s16x4 __attribute__((ext_vector_type(4)));
#define LDS_WAIT() asm volatile("s_waitcnt lgkmcnt(0)" ::: "memory")

constexpr size_t E_WIN = 0, E_WOUT = (size_t)NIN * DM, E_W1 = E_WOUT + (size_t)DM * DM, E_W2 = E_W1 + (size_t)DFF * DM, E_WG = E_W2 + (size_t)DFF * DM, E_WP = E_WG + (size_t)DM * DM,
                 E_WLAYER = E_WP + (size_t)PLE * DM;
constexpr size_t WS_W = 0, WS_WSB = WS_W + (size_t)DEPTH * E_WLAYER * 2, WS_SS = WS_WSB + (size_t)DEPTH * 4 * 128 * 128 * 2, WS_HB = WS_SS + (size_t)3 * M * 16 * 4,
                 WS_LO = WS_HB + (size_t)M * DM * 2, WS_XB = WS_LO + (size_t)M * DM * 2, WS_BIG = WS_XB + (size_t)M * DM * 2, WS_END = WS_BIG + (size_t)M * DFF * 2;
constexpr size_t B_CONV = 0, B_Q = B_CONV + (size_t)3 * M * 256 * 2, B_K = B_Q + (size_t)M * 512 * 2, B_VT = B_K + (size_t)M * 512 * 2, B_CU = B_VT + (size_t)M * 512 * 2,
                 B_VNT = B_CU + (size_t)M * 256 * 2, B_Y = B_VNT + (size_t)M * 256 * 2, B_ENDMIX = B_Y + (size_t)M * DM * 2;
static_assert(B_ENDMIX <= (size_t)M * DFF * 2, "mixer tensors fit under the F overlay");
constexpr size_t WS_CTL = WS_END, CTL_BYTES = 16384, WS_TOTAL = WS_CTL + CTL_BYTES;
constexpr int RING_BYTES = 131072, LDS_BYTES = 132096;

__device__ __forceinline__ unsigned f2bf(float f) { unsigned u = __builtin_bit_cast(unsigned, f); return (u + 0x7fffu + ((u >> 16) & 1u)) >> 16; }
typedef __bf16 bf16x2_t __attribute__((ext_vector_type(2)));
__device__ __forceinline__ unsigned pk2(float lo, float hi) { f32x2 v = {lo, hi}; bf16x2_t b = __builtin_convertvector(v, bf16x2_t); return __builtin_bit_cast(unsigned, b); }
__device__ __forceinline__ float bflo(unsigned u) { return __builtin_bit_cast(float, u << 16); }
__device__ __forceinline__ float bfhi(unsigned u) { return __builtin_bit_cast(float, u & 0xffff0000u); }
__device__ __forceinline__ float wave_sum(float v) {
#pragma unroll
    for (int o = 1; o < 64; o <<= 1) v += __shfl_xor(v, o);
    return v;
}

__device__ __forceinline__ float row_rs(const float* ssp, int r) {
    const f32x4* q = (const f32x4*)(ssp + (size_t)r * 16); const f32x4 a = q[0], b = q[1], c = q[2], d = q[3];
    const float s = ((a[0] + a[1]) + (a[2] + a[3])) + ((b[0] + b[1]) + (b[2] + b[3])) + ((c[0] + c[1]) + (c[2] + c[3])) + ((d[0] + d[1]) + (d[2] + d[3]));
    return rsqrtf(s * (1.f / 1024.f) + EPS);
}
struct EpiInProj {
    static constexpr bool PERM = true, AFTER_DRAIN = false;
    const float* ss; bf16* conv; bf16* q; bf16* k; bf16* vt; bf16* cu; bf16* vnt; const float* qg; const float* kg; const float* sg;
    __device__ __forceinline__ void operator()(const pg8::f32x4 (&acc)[2][2][4][2], const pg8::Unit& u, int wr, int wc, int fr, int fq) const {
        const int sec = u.pn;
        const int row0 = u.pm * 256 + wr * 64 + fr;
        const int cw = 64 * wc + 8 * fq;
        const bool normed = (sec >= 3 && sec < 7) || sec == 10;
        float rsv[8];
#pragma unroll
        for (int g = 0; g < 8; ++g) { rsv[g] = row_rs(ss, row0 + (g >> 2) * 128 + (g & 3) * 16); if (g & 1) asm volatile("" : "+v"(rsv[g - 1]), "+v"(rsv[g]) :: "memory"); }
        f32x4 gv[2][2];
#pragma unroll
        for (int bj = 0; bj < 2; ++bj)
#pragma unroll
            for (int n = 0; n < 2; ++n) {
                if (sec >= 3 && sec < 7) { const float* g = sec < 5 ? qg : kg; const float sc = sec < 5 ? C2 : 1.f; gv[bj][n] = *(const f32x4*)(g + 32 * bj + 8 * fq + 4 * n) * sc; }
                else if (sec == 10) gv[bj][n] = *(const f32x4*)(sg + cw + 32 * bj + 4 * n);
                else gv[bj][n] = (f32x4){1.f, 1.f, 1.f, 1.f};
            }
#pragma unroll
        for (int ai = 0; ai < 2; ++ai)
#pragma unroll
            for (int m = 0; m < 4; ++m) {
                const int r = row0 + ai * 128 + m * 16;
                const float rs = rsv[ai * 4 + m];
                f32x4 v[2][2];
#pragma unroll
                for (int bj = 0; bj < 2; ++bj)
#pragma unroll
                    for (int n = 0; n < 2; ++n) v[bj][n] = acc[ai][bj][m][n] * rs;
                if (sec >= 9) {
#pragma unroll
                    for (int bj = 0; bj < 2; ++bj)
#pragma unroll
                        for (int n = 0; n < 2; ++n) { const pg8::f32x2 a = pg8::gelu_pk((pg8::f32x2){v[bj][n][0], v[bj][n][1]}), b = pg8::gelu_pk((pg8::f32x2){v[bj][n][2], v[bj][n][3]}); v[bj][n] = (f32x4){a.x, a.y, b.x, b.y}; }
                }
                if (normed) {
                    float s2 = 0.f;
#pragma unroll
                    for (int bj = 0; bj < 2; ++bj)
#pragma unroll
                        for (int n = 0; n < 2; ++n) { const f32x4 x = v[bj][n]; s2 += (x[0] * x[0] + x[1] * x[1]) + (x[2] * x[2] + x[3] * x[3]); }
                    s2 += __shfl_xor(s2, 16); s2 += __shfl_xor(s2, 32);
                    const float rn = rsqrtf(s2 * (1.f / 64.f) + EPS);
#pragma unroll
                    for (int bj = 0; bj < 2; ++bj)
#pragma unroll
                        for (int n = 0; n < 2; ++n) v[bj][n] = v[bj][n] * rn * gv[bj][n];
                }
                const int b = r >> 11, s = r & 2047;
                if (sec == 10) {
                    const int sl = s & 127;
                    bf16* base = vnt + ((((size_t)((b * 4 + wc) * 16 + (s >> 7)) * 2) * 8 + (sl >> 4)) * 64 + ((sl >> 3) & 1) * 32 + 8 * fq) * 8 + (sl & 7);
#pragma unroll
                    for (int bj = 0; bj < 2; ++bj)
#pragma unroll
                        for (int n = 0; n < 2; ++n)
#pragma unroll
                            for (int j = 0; j < 4; ++j) base[(size_t)bj * 8 * 64 * 8 + (4 * n + j) * 8] = (bf16)f2bf(v[bj][n][j]);
                } else if (sec == 7 || sec == 8) {
                    const int kk_ = s & 31;
                    bf16* base = vt + (((size_t)((b * 8 + 4 * (sec - 7) + wc) * 64 + (s >> 5)) * 4 + (kk_ >> 4)) * 64 + ((kk_ >> 3) & 1) * 32 + 8 * fq) * 8 + (kk_ & 7);
#pragma unroll
                    for (int bj = 0; bj < 2; ++bj)
#pragma unroll
                        for (int n = 0; n < 2; ++n)
#pragma unroll
                            for (int j = 0; j < 4; ++j) base[(size_t)bj * 2 * 64 * 8 + (4 * n + j) * 8] = (bf16)f2bf(v[bj][n][j]);
                } else if (sec >= 3 && sec < 7) {
                    const bool isq = sec < 5;
                    const int sl = s & 31, pos = isq ? sl : ((sl & 0x13) | ((sl & 4) << 1) | ((sl & 8) >> 1));
                    bf16* base = (isq ? q : k) + (((size_t)((b * 8 + 4 * ((sec - 3) & 1) + wc) * 64 + (s >> 5)) * 4 + (fq >> 1)) * 64 + (fq & 1) * 32 + pos) * 8;
#pragma unroll
                    for (int bj = 0; bj < 2; ++bj) { v4u w; w.x = pk2(v[bj][0][0], v[bj][0][1]); w.y = pk2(v[bj][0][2], v[bj][0][3]); w.z = pk2(v[bj][1][0], v[bj][1][1]); w.w = pk2(v[bj][1][2], v[bj][1][3]);
                        *(v4u*)(base + (size_t)bj * 2 * 64 * 8) = w; }
                } else {
                    bf16* dst; int ld;
                    if (sec < 3) { dst = conv + (size_t)sec * M * 256 + cw; ld = 256; }
                    else { dst = cu + cw; ld = 256; }
                    dst += (size_t)r * ld;
#pragma unroll
                    for (int bj = 0; bj < 2; ++bj) { v4u w; w.x = pk2(v[bj][0][0], v[bj][0][1]); w.y = pk2(v[bj][0][2], v[bj][0][3]); w.z = pk2(v[bj][1][0], v[bj][1][1]); w.w = pk2(v[bj][1][2], v[bj][1][3]);
                        *(v4u*)(dst + 32 * bj) = w; }
                }
            }
    }
};

__device__ __forceinline__ void unpk(const v4u w, f32x4& a, f32x4& b) { a = (f32x4){bflo(w.x), bfhi(w.x), bflo(w.y), bfhi(w.y)}; b = (f32x4){bflo(w.z), bfhi(w.z), bflo(w.w), bfhi(w.w)}; }
__device__ __forceinline__ void split_store(const f32x4 h0, const f32x4 h1, bf16* hi, bf16* lo) {
    v4u w; w.x = pk2(h0[0], h0[1]); w.y = pk2(h0[2], h0[3]); w.z = pk2(h1[0], h1[1]); w.w = pk2(h1[2], h1[3]); *(v4u*)hi = w;
    f32x4 a, b; unpk(w, a, b); const f32x4 d0 = h0 - a, d1 = h1 - b;
    v4u l; l.x = pk2(d0[0], d0[1]); l.y = pk2(d0[2], d0[3]); l.z = pk2(d1[0], d1[1]); l.w = pk2(d1[2], d1[3]); *(v4u*)lo = l;
}
struct EpiRes {
    static constexpr bool PERM = true, AFTER_DRAIN = false;
    bf16* hi; bf16* lo; float* ssout; int use_lo;
    __device__ __forceinline__ void operator()(const pg8::f32x4 (&acc)[2][2][4][2], const pg8::Unit& u, int wr, int wc, int fr, int fq) const {
        const int row0 = u.pm * 256 + wr * 64 + fr, col0 = u.pn * 256 + wc * 32 + 8 * fq;
        constexpr int LA = 2;
        v4u bq[8][4];
#pragma unroll
        for (int g = 0; g < LA; ++g) { const size_t off = (size_t)(row0 + (g >> 2) * 128 + (g & 3) * 16) * DM + col0;
#pragma unroll
            for (int bj = 0; bj < 2; ++bj) { bq[g][2 * bj] = *(const v4u*)(hi + off + bj * 128); bq[g][2 * bj + 1] = use_lo ? *(const v4u*)(lo + off + bj * 128) : (v4u){0u, 0u, 0u, 0u}; } }
#pragma unroll
        for (int g = 0; g < 8; ++g) {
            if (g + LA < 8) { const int gn = g + LA; const size_t off = (size_t)(row0 + (gn >> 2) * 128 + (gn & 3) * 16) * DM + col0;
#pragma unroll
                for (int bj = 0; bj < 2; ++bj) { bq[gn][2 * bj] = *(const v4u*)(hi + off + bj * 128); bq[gn][2 * bj + 1] = use_lo ? *(const v4u*)(lo + off + bj * 128) : (v4u){0u, 0u, 0u, 0u}; } }
            const int ai = g >> 2, m = g & 3;
            const int r = row0 + ai * 128 + m * 16; const size_t off = (size_t)r * DM + col0; float s2 = 0.f;
#pragma unroll
            for (int bj = 0; bj < 2; ++bj) {
                f32x4 a0, a1, l0, l1; unpk(bq[g][2 * bj], a0, a1); unpk(bq[g][2 * bj + 1], l0, l1);
                const f32x4 h0 = (a0 + l0) + acc[ai][bj][m][0], h1 = (a1 + l1) + acc[ai][bj][m][1];
                split_store(h0, h1, hi + off + bj * 128, lo + off + bj * 128);
                s2 += (h0[0] * h0[0] + h0[1] * h0[1]) + (h0[2] * h0[2] + h0[3] * h0[3]) + (h1[0] * h1[0] + h1[1] * h1[1]) + (h1[2] * h1[2] + h1[3] * h1[3]);
            }
            s2 += __shfl_xor(s2, 16); s2 += __shfl_xor(s2, 32);
            if (fq == 0) ssout[(size_t)r * 16 + u.pn * 4 + wc] = s2;
            asm volatile("" ::: "memory");
        }
    }
};
struct EpiFF1 {
    static constexpr bool PERM = true, AFTER_DRAIN = false;
    const float* ss; bf16* f;
    __device__ __forceinline__ void operator()(const pg8::f32x4 (&acc)[2][2][4][2], const pg8::Unit& u, int wr, int wc, int fr, int fq) const {
        const int row0 = u.pm * 256 + wr * 64 + fr, col0 = u.pn * 256 + wc * 32 + 8 * fq;
        float rsv[8];
#pragma unroll
        for (int g = 0; g < 8; ++g) { rsv[g] = row_rs(ss, row0 + (g >> 2) * 128 + (g & 3) * 16); if (g & 1) asm volatile("" : "+v"(rsv[g - 1]), "+v"(rsv[g]) :: "memory"); }
#pragma unroll
        for (int ai = 0; ai < 2; ++ai)
#pragma unroll
            for (int m = 0; m < 4; ++m) {
                const int r = row0 + ai * 128 + m * 16; const float rs = rsv[ai * 4 + m]; bf16* dst = f + (size_t)r * DFF + col0;
#pragma unroll
                for (int bj = 0; bj < 2; ++bj) {
                    f32x4 a = acc[ai][bj][m][0] * rs, b = acc[ai][bj][m][1] * rs;
#pragma unroll
                    for (int j = 0; j < 4; ++j) { a[j] = fmaxf(a[j], 0.f); a[j] *= a[j]; b[j] = fmaxf(b[j], 0.f); b[j] *= b[j]; }
                    v4u w; w.x = pk2(a[0], a[1]); w.y = pk2(a[2], a[3]); w.z = pk2(b[0], b[1]); w.w = pk2(b[2], b[3]); *(v4u*)(dst + bj * 128) = w;
                }
            }
    }
};
struct EpiT {
    static constexpr bool PERM = true, AFTER_DRAIN = false;
    bf16* t;
    __device__ __forceinline__ void operator()(const pg8::f32x4 (&acc)[2][2][4][2], const pg8::Unit& u, int wr, int wc, int fr, int fq) const {
        const int row0 = u.pm * 256 + wr * 64 + fr, col0 = u.pn * 256 + wc * 32 + 8 * fq;
#pragma unroll
        for (int ai = 0; ai < 2; ++ai)
#pragma unroll
            for (int m = 0; m < 4; ++m) {
                bf16* dst = t + (size_t)(row0 + ai * 128 + m * 16) * DM + col0;
#pragma unroll
                for (int bj = 0; bj < 2; ++bj) { const f32x4 a = acc[ai][bj][m][0], b = acc[ai][bj][m][1];
                    v4u w; w.x = pk2(a[0], a[1]); w.y = pk2(a[2], a[3]); w.z = pk2(b[0], b[1]); w.w = pk2(b[2], b[3]); *(v4u*)(dst + bj * 128) = w; }
            }
    }
};
struct EpiGate {
    static constexpr bool PERM = true, AFTER_DRAIN = false;
    const float* ss; const bf16* hi; bf16* lo; bf16* tx; float* ssout; float* fout;
    __device__ __forceinline__ void operator()(const pg8::f32x4 (&acc)[2][2][4][2], const pg8::Unit& u, int wr, int wc, int fr, int fq) const {
        const int row0 = u.pm * 256 + wr * 64 + fr, col0 = u.pn * 256 + wc * 32 + 8 * fq;
        float rsv[8];
#pragma unroll
        for (int g = 0; g < 8; ++g) { rsv[g] = row_rs(ss, row0 + (g >> 2) * 128 + (g & 3) * 16) * (-1.4426950408889634f); if (g & 1) asm volatile("" : "+v"(rsv[g - 1]), "+v"(rsv[g]) :: "memory"); }
        v4u hq[16], lq[16], tq[16];
        { const size_t off = (size_t)row0 * DM + col0; tq[0] = *(const v4u*)(tx + off); hq[0] = *(const v4u*)(hi + off); lq[0] = *(const v4u*)(lo + off); }
        float s2 = 0.f;
#pragma unroll
        for (int q = 0; q < 16; ++q) {
            if (q + 1 < 16) { const int gn = (q + 1) >> 1, bn = (q + 1) & 1; const size_t off = (size_t)(row0 + (gn >> 2) * 128 + (gn & 3) * 16) * DM + col0 + bn * 128;
                tq[q + 1] = *(const v4u*)(tx + off); hq[q + 1] = *(const v4u*)(hi + off); lq[q + 1] = *(const v4u*)(lo + off); }
            const int g = q >> 1, bj = q & 1, ai = g >> 2, m = g & 3;
            const int r = row0 + ai * 128 + m * 16; const float rs = rsv[g]; const size_t off = (size_t)r * DM + col0 + bj * 128;
            f32x4 t0, t1, a0, a1, l0, l1; unpk(tq[q], t0, t1); unpk(hq[q], a0, a1); unpk(lq[q], l0, l1);
            f32x4 g0 = acc[ai][bj][m][0] * rs, g1 = acc[ai][bj][m][1] * rs;
#pragma unroll
            for (int j = 0; j < 4; ++j) { g0[j] = __builtin_amdgcn_rcpf(1.f + __builtin_amdgcn_exp2f(g0[j])); g1[j] = __builtin_amdgcn_rcpf(1.f + __builtin_amdgcn_exp2f(g1[j])); }
            const f32x4 h0 = (a0 + l0) + g0 * t0, h1 = (a1 + l1) + g1 * t1;
            { v4u w; w.x = pk2(h0[0], h0[1]); w.y = pk2(h0[2], h0[3]); w.z = pk2(h1[0], h1[1]); w.w = pk2(h1[2], h1[3]); *(v4u*)(tx + off) = w; }
            if (fout) { *(f32x4*)(fout + off) = h0; *(f32x4*)(fout + off + 4) = h1; }
            s2 += (h0[0] * h0[0] + h0[1] * h0[1]) + (h0[2] * h0[2] + h0[3] * h0[3]) + (h1[0] * h1[0] + h1[1] * h1[1]) + (h1[2] * h1[2] + h1[3] * h1[3]);
            if (bj == 1) {
                s2 += __shfl_xor(s2, 16); s2 += __shfl_xor(s2, 32);
                if (fq == 0) ssout[(size_t)r * 16 + u.pn * 4 + wc] = s2;
                s2 = 0.f;
            }
            asm volatile("" ::: "memory");
        }
    }
};

struct TSched {
    int c, c0, G;
    __device__ __forceinline__ bool next(int i, pg8::Unit& u) const { if (c < c0) return false; const int un = (c - c0) + i * (G - c0); if (un >= 256) return false; u.pm = un >> 2; u.pn = un & 3; return true; }
    __device__ __forceinline__ void a_ready(const pg8::Unit&) const {}
    __device__ __forceinline__ void done(const pg8::Unit&) const {}
};
__device__ __forceinline__ void tr_item(const float* W, int K, int N, bf16* WT, LAS float* scr, int item, int lane, const float* g, bool hperm) {
    const int nblk = N / 32, kb = item / nblk, nb = item % nblk, k0 = 64 * kb, n0 = 32 * nb;
    const int kr = lane >> 3, nq = (lane & 7) * 4;
    f32x4 v[8];
#pragma unroll
    for (int i = 0; i < 8; ++i) v[i] = *(const f32x4*)(W + (size_t)(k0 + 8 * i + kr) * N + n0 + nq);
    if (g) {
#pragma unroll
        for (int i = 0; i < 8; ++i) v[i] = v[i] * g[k0 + 8 * i + kr];
    }
#pragma unroll
    for (int i = 0; i < 8; ++i) { LAS float* d = scr + (8 * i + kr) * 33 + nq; d[0] = v[i][0]; d[1] = v[i][1]; d[2] = v[i][2]; d[3] = v[i][3]; }
    LDS_WAIT(); asm volatile("" ::: "memory");
    int d0 = n0; if (hperm) { const int gi = (n0 >> 5) & 7; d0 = (n0 & ~255) + 32 * (4 * (gi & 1) + (gi >> 1)); }
    const int c = lane & 7;
#pragma unroll
    for (int j = 0; j < 4; ++j) { const int n = (lane >> 3) + 8 * j; const LAS float* sp = scr + (8 * c) * 33 + n;
        v4u o; o.x = pk2(sp[0 * 33], sp[1 * 33]); o.y = pk2(sp[2 * 33], sp[3 * 33]); o.z = pk2(sp[4 * 33], sp[5 * 33]); o.w = pk2(sp[6 * 33], sp[7 * 33]);
        *(v4u*)(WT + (size_t)(d0 + n) * K + k0 + 8 * c) = o; }
    LDS_WAIT(); asm volatile("" ::: "memory");
}

__device__ __forceinline__ int crow(int r, int hf) { return (r & 3) + 8 * (r >> 2) + 4 * hf; }
__device__ __forceinline__ void attn_task(const bf16* Q, const bf16* K, const bf16* VT, bf16* Y, int b, int h, int qb, int lane) {
    const int t = lane & 31, hf = lane >> 5, q0 = qb * 32;
    const size_t hb = (size_t)(b * 8 + h) * 64;
    const bf16* qp = Q + ((hb + qb) * 4 * 64 + lane) * 8;
    bf16x8 qr[4];
#pragma unroll
    for (int kk = 0; kk < 4; ++kk) qr[kk] = *(const bf16x8*)(qp + kk * 512);
    const bf16* kbase = K + (hb * 4 * 64 + lane) * 8;
    const bf16* vbase = VT + (hb * 4 * 64 + lane) * 8;
    f32x16 o0, o1;
#pragma unroll
    for (int r = 0; r < 16; ++r) { o0[r] = 0.f; o1[r] = 0.f; }
    float carry = 1.f;
    bf16x8 kn[4], vn[4];
#pragma unroll
    for (int i = 0; i < 4; ++i) { kn[i] = *(const bf16x8*)(kbase + (size_t)qb * 2048 + i * 512); vn[i] = *(const bf16x8*)(vbase + (size_t)qb * 2048 + i * 512); }
    for (int j = qb; j >= 0; --j) {
        bf16x8 kf[4], vf[4];
#pragma unroll
        for (int i = 0; i < 4; ++i) { kf[i] = kn[i]; vf[i] = vn[i]; }
        { const int jn = j > 0 ? j - 1 : 0;
#pragma unroll
          for (int i = 0; i < 4; ++i) { kn[i] = *(const bf16x8*)(kbase + (size_t)jn * 2048 + i * 512); vn[i] = *(const bf16x8*)(vbase + (size_t)jn * 2048 + i * 512); } }
        f32x16 z;
#pragma unroll
        for (int r = 0; r < 16; ++r) z[r] = 0.f;
#pragma unroll
        for (int kk = 0; kk < 4; ++kk) z = __builtin_amdgcn_mfma_f32_32x32x16_bf16(kf[kk], qr[kk], z, 0, 0, 0);
        float om[16], w[16];
        const bool diag = (j == qb);
#pragma unroll
        for (int r = 0; r < 16; ++r) {
            const float e = __builtin_amdgcn_exp2f(fminf(z[r], 100.f));
            float o = __builtin_amdgcn_rcpf(1.f + e), bt = e * o;
            if (diag) { const bool valid = (16 * (r >> 3) + 8 * hf + (r & 7)) < t; o = valid ? o : 1.f; bt = valid ? bt : 0.f; }
            om[r] = o; w[r] = bt;
        }
        float R[2];
#pragma unroll
        for (int ks = 0; ks < 2; ++ks) {
            float x = om[8 * ks + 7];
#pragma unroll
            for (int jj = 6; jj >= 0; --jj) { w[8 * ks + jj] *= x; x *= om[8 * ks + jj]; }
            R[ks] = x;
        }
        const float Rp0 = __shfl_xor(R[0], 32), Rp1 = __shfl_xor(R[1], 32);
        const float T1 = R[1] * Rp1, T0 = R[0] * Rp0;
        const float L1 = hf ? carry : carry * Rp1;
        const float c0 = carry * T1, L0 = hf ? c0 : c0 * Rp0;
        carry = c0 * T0;
#pragma unroll
        for (int jj = 0; jj < 8; ++jj) { w[jj] *= L0; w[8 + jj] *= L1; }
#pragma unroll
        for (int ks = 0; ks < 2; ++ks) {
            v4u pw; pw.x = pk2(w[8 * ks], w[8 * ks + 1]); pw.y = pk2(w[8 * ks + 2], w[8 * ks + 3]); pw.z = pk2(w[8 * ks + 4], w[8 * ks + 5]); pw.w = pk2(w[8 * ks + 6], w[8 * ks + 7]);
            const bf16x8 pf = __builtin_bit_cast(bf16x8, pw);
            o0 = __builtin_amdgcn_mfma_f32_32x32x16_bf16(vf[ks], pf, o0, 0, 0, 0);
            o1 = __builtin_amdgcn_mfma_f32_32x32x16_bf16(vf[2 + ks], pf, o1, 0, 0, 0);
        }
#if ATT_EARLY_EXIT
        if (__all(carry == 0.f)) break;
#endif
    }
    bf16* yp = Y + (size_t)(b * SEQ + q0 + t) * DM + 256 + h * 64 + 4 * hf;
#pragma unroll
    for (int g = 0; g < 4; ++g) {
        v2u a; a.x = pk2(o0[4 * g], o0[4 * g + 1]); a.y = pk2(o0[4 * g + 2], o0[4 * g + 3]); *(v2u*)(yp + 8 * g) = a;
        v2u c; c.x = pk2(o1[4 * g], o1[4 * g + 1]); c.y = pk2(o1[4 * g + 2], o1[4 * g + 3]); *(v2u*)(yp + 32 + 8 * g) = c;
    }
}
__device__ __forceinline__ void sgu_task(const bf16* VNT, const bf16* WSB, const bf16* CU, const float* bias, bf16* Y, int task, int lane) {
    const int tb = task & 3, g = (task >> 2) & 3, c = (task >> 4) & 15, b = task >> 8;
    const int t = lane & 31, hf = lane >> 5;
    const bf16* ap = VNT + ((size_t)((b * 4 + g) * 16 + c) * 2 * 8 * 64 + lane) * 8;
    const bf16* bp = WSB + ((size_t)(g * 4 + tb) * 8 * 64 + lane) * 8;
    f32x16 a0, a1;
#pragma unroll
    for (int r = 0; r < 16; ++r) { a0[r] = 0.f; a1[r] = 0.f; }
    bf16x8 bfr[8], af0[8], af1[8];
#pragma unroll
    for (int ks = 0; ks < 8; ++ks) { bfr[ks] = *(const bf16x8*)(bp + 512 * ks); af0[ks] = *(const bf16x8*)(ap + 512 * ks); af1[ks] = *(const bf16x8*)(ap + 4096 + 512 * ks); }
#pragma unroll
    for (int ks = 0; ks < 8; ++ks) {
        a0 = __builtin_amdgcn_mfma_f32_32x32x16_bf16(af0[ks], bfr[ks], a0, 0, 0, 0);
        a1 = __builtin_amdgcn_mfma_f32_32x32x16_bf16(af1[ks], bfr[ks], a1, 0, 0, 0);
    }
    const int tok = b * SEQ + 128 * c + 32 * tb + t;
    const float bs = bias[g * 128 + 32 * tb + t];
    const bf16* up = CU + (size_t)tok * 256 + 64 * g + 4 * hf;
    bf16* yp = Y + (size_t)tok * DM + 768 + 64 * g + 4 * hf;
#pragma unroll
    for (int gg = 0; gg < 4; ++gg) {
        const v2u u0 = *(const v2u*)(up + 8 * gg), u1 = *(const v2u*)(up + 32 + 8 * gg);
        v2u a; a.x = pk2(bflo(u0.x) * (a0[4 * gg] + bs), bfhi(u0.x) * (a0[4 * gg + 1] + bs)); a.y = pk2(bflo(u0.y) * (a0[4 * gg + 2] + bs), bfhi(u0.y) * (a0[4 * gg + 3] + bs)); *(v2u*)(yp + 8 * gg) = a;
        v2u d; d.x = pk2(bflo(u1.x) * (a1[4 * gg] + bs), bfhi(u1.x) * (a1[4 * gg + 1] + bs)); d.y = pk2(bflo(u1.y) * (a1[4 * gg + 2] + bs), bfhi(u1.y) * (a1[4 * gg + 3] + bs)); *(v2u*)(yp + 32 + 8 * gg) = d;
    }
}
__device__ __forceinline__ void unpack8(const v4u w, float (&f)[8]) { f[0] = bflo(w.x); f[1] = bfhi(w.x); f[2] = bflo(w.y); f[3] = bfhi(w.y); f[4] = bflo(w.z); f[5] = bfhi(w.z); f[6] = bflo(w.w); f[7] = bfhi(w.w); }
__device__ __forceinline__ void conv_task(const bf16* CONV, const float* cwt, bf16* Y, int task, int lane) {
    const int ch = (lane & 31) * 8;
    float w0[8], w1[8], w2[8];
#pragma unroll
    for (int e = 0; e < 8; ++e) { w0[e] = cwt[ch + e]; w1[e] = cwt[256 + ch + e]; w2[e] = cwt[512 + ch + e]; }
    const bf16* ab = CONV; const bf16* ac = CONV + (size_t)M * 256; const bf16* ah = CONV + (size_t)2 * M * 256;
#pragma unroll 2
    for (int it = 0; it < 8; ++it) {
        const int tok = task * 16 + it * 2 + (lane >> 5), s = tok & (SEQ - 1);
        const size_t o = (size_t)tok * 256 + ch;
        float fb[8], c0[8], h0[8], c1[8], h1[8], c2[8], h2[8];
        unpack8(*(const v4u*)(ab + o), fb); unpack8(*(const v4u*)(ac + o), c0); unpack8(*(const v4u*)(ah + o), h0);
        const v4u zz = (v4u){0u, 0u, 0u, 0u};
        unpack8(s >= 1 ? *(const v4u*)(ac + o - 256) : zz, c1); unpack8(s >= 1 ? *(const v4u*)(ah + o - 256) : zz, h1);
        unpack8(s >= 2 ? *(const v4u*)(ac + o - 512) : zz, c2); unpack8(s >= 2 ? *(const v4u*)(ah + o - 512) : zz, h2);
        float y[8];
#pragma unroll
        for (int e = 0; e < 8; ++e) y[e] = fb[e] * (w2[e] * (c0[e] * h0[e]) + w1[e] * (c1[e] * h1[e]) + w0[e] * (c2[e] * h2[e]));
        v4u w; w.x = pk2(y[0], y[1]); w.y = pk2(y[2], y[3]); w.z = pk2(y[4], y[5]); w.w = pk2(y[6], y[7]);
        *(v4u*)(Y + (size_t)tok * DM + ch) = w;
    }
}

#define RLX_AGENT __ATOMIC_RELAXED, __HIP_MEMORY_SCOPE_AGENT
#define XB_TMO      128
#define XB_XCNT(j)  (256  + 64 * (j))
#define XB_XSUB(j)  (1280 + 64 * (j))
#define XB_XGEN(j)  (2304 + 64 * (j))
#define XB_TOP      3328
#define XB_TOPGEN   3392
#define XCD_BAR_WORDS 3456
#define XB_SPIN_CAP (1u << 18)

__device__ __forceinline__ unsigned xb_ld(unsigned* p)              { return __hip_atomic_load(p, __ATOMIC_RELAXED, __HIP_MEMORY_SCOPE_AGENT); }
__device__ __forceinline__ unsigned xb_add(unsigned* p, unsigned v) { return __hip_atomic_fetch_add(p, v, __ATOMIC_RELAXED, __HIP_MEMORY_SCOPE_AGENT); }
__device__ __forceinline__ unsigned xb_xcc_id() { return (unsigned)__builtin_amdgcn_s_getreg((3 << 11) | 20) & 0xFu; }
#define XB_SPIN(cond, bar) do { unsigned _sp = 0; while (cond) { __builtin_amdgcn_s_sleep(1); \
    if ((++_sp & 255u) == 0u) { if (xb_ld(&(bar)[XB_TMO])) break; if (_sp > XB_SPIN_CAP) { atomicAdd(&(bar)[XB_TMO], 1u); break; } } } } while (0)

struct XcdBarrier {
    unsigned* bar; unsigned x;
    volatile LAS unsigned* st;
};

__device__ __forceinline__ XcdBarrier xcd_barrier_post(unsigned* bar, volatile LAS unsigned* st) {
    XcdBarrier b; b.bar = bar; b.x = xb_xcc_id(); b.st = st;
    if (threadIdx.x == 0) (void)xb_add(&bar[XB_XCNT(b.x)], 1u);
    return b;
}
__device__ __forceinline__ void xcd_barrier_complete(unsigned* bar, unsigned x, unsigned& nloc, unsigned& nx) {
    const unsigned G = gridDim.x * gridDim.y * gridDim.z;
    unsigned sum, cnt, mine, sp = 0u;
    for (;;) {
        sum = 0u; cnt = 0u; mine = 0u;
#pragma unroll
        for (unsigned j = 0; j < 16; ++j) { const unsigned c = xb_ld(&bar[XB_XCNT(j)]); sum += c; cnt += (c > 0u) ? 1u : 0u; mine = (j == x) ? c : mine; }
        if (sum == G) break;
        __builtin_amdgcn_s_sleep(1);
        if ((++sp & 255u) == 0u) { if (xb_ld(&bar[XB_TMO])) break; if (sp > XB_SPIN_CAP) { atomicAdd(&bar[XB_TMO], 1u); break; } }
    }
    nloc = mine > 0u ? mine : 1u; nx = cnt > 0u ? cnt : 1u;
}

__device__ __forceinline__ void xcd_barrier(const XcdBarrier& b) {
    asm volatile("s_waitcnt vmcnt(0)" ::: "memory");
    __syncthreads();
    if (threadIdx.x == 0) {
        unsigned* bar = b.bar;
        __builtin_amdgcn_s_waitcnt(0);
        unsigned nloc = b.st[0], nx = b.st[1];
        if (nloc == 0u) { xcd_barrier_complete(bar, b.x, nloc, nx); b.st[0] = nloc; b.st[1] = nx; }
        const unsigned old = xb_add(&bar[XB_XSUB(b.x)], 1u);
        const unsigned gen = old / nloc;
        if (old + 1u == (gen + 1u) * nloc) {
            __builtin_amdgcn_fence(__ATOMIC_RELEASE, "agent");
            asm volatile("s_waitcnt vmcnt(0)" ::: "memory");
            const unsigned og = xb_add(&bar[XB_TOP], 1u);
            const unsigned tg = og / nx;
            if (og + 1u == (tg + 1u) * nx) xb_add(&bar[XB_TOPGEN], 1u);
            else XB_SPIN(xb_ld(&bar[XB_TOPGEN]) == tg, bar);
            __builtin_amdgcn_fence(__ATOMIC_ACQUIRE, "agent");
            xb_add(&bar[XB_XGEN(b.x)], 1u);
            asm volatile("s_waitcnt vmcnt(0)" ::: "memory");
        } else {
            XB_SPIN(xb_ld(&bar[XB_XGEN(b.x)]) == gen, bar);
            __builtin_amdgcn_fence(__ATOMIC_ACQUIRE, "agent");
            asm volatile("s_waitcnt vmcnt(0)" ::: "memory");
        }
    }
    __syncthreads();
}

struct Args { const float* in[17]; float* out; unsigned char* ws; int ph_lo, ph_hi; };
__global__ void __launch_bounds__(NWAVES * 64, 2) mk_fwd(Args a) {
    extern __shared__ __attribute__((aligned(16))) unsigned char lds_raw[];
    LAS unsigned char* lds = (LAS unsigned char*)lds_raw;
    const int tid = threadIdx.x, lane = tid & 63, wave = __builtin_amdgcn_readfirstlane(tid >> 6);
    const int G = gridDim.x; const int bx = blockIdx.x; const int vcu = (G % 8 == 0) ? (bx % 8) * (G / 8) + bx / 8 : bx;
    const int gw = vcu * NWAVES + wave, NGW = G * NWAVES;
    const int lo = a.ph_lo, hi = a.ph_hi;
    volatile LAS unsigned* bst = (volatile LAS unsigned*)(lds + RING_BYTES);
    if (tid < 4) bst[tid] = 0u;
    __syncthreads();
    XcdBarrier bar = xcd_barrier_post((unsigned*)(a.ws + WS_CTL), bst);
    unsigned char* ws = a.ws;
    const float* x = a.in[0]; const float* p = a.in[1];
    bf16* Wb = (bf16*)(ws + WS_W); bf16* WSBb = (bf16*)(ws + WS_WSB); float* SS = (float*)(ws + WS_SS);
    bf16* HB = (bf16*)(ws + WS_HB); bf16* LO = (bf16*)(ws + WS_LO); bf16* XB = (bf16*)(ws + WS_XB);
    bf16* PB = (bf16*)a.out;
    unsigned char* big = ws + WS_BIG;
    bf16* CONV = (bf16*)(big + B_CONV); bf16* Qb = (bf16*)(big + B_Q); bf16* Kb = (bf16*)(big + B_K); bf16* VTb = (bf16*)(big + B_VT); bf16* CUb = (bf16*)(big + B_CU);
    bf16* VNTb = (bf16*)(big + B_VNT); bf16* Yb = (bf16*)(big + B_Y); bf16* Fb = (bf16*)big;
    float* H = a.out;
#define IN(k) (lo <= (k) && (k) < hi)
#define SEAM(k) do { if (IN(k) && IN((k) + 1)) { if ((k) == 0) cg::this_grid().sync(); else { for (int sr_ = 0; sr_ < PROBE_SYNC; ++sr_) xcd_barrier(bar); } } } while (0)

    if (IN(0)) for (int rep_ = 0; rep_ < PROBE_P; ++rep_) {
        LAS float* scr = (LAS float*)(lds + wave * 16384);
        constexpr int I_IN = (DM / 64) * (NIN / 32), I_OUT = (DM / 64) * (DM / 32), I_1 = (DM / 64) * (DFF / 32), I_2 = (DFF / 64) * (DM / 32), I_G = I_OUT, I_P = (PLE / 64) * (DM / 32);
        constexpr int I_LAYER = I_IN + I_OUT + I_1 + I_2 + I_G + I_P;
        for (int it = gw; it < DEPTH * I_LAYER; it += NGW) {
            const int l = it / I_LAYER; int r = it % I_LAYER; bf16* wl = Wb + (size_t)l * E_WLAYER;
            if (r < I_IN) { tr_item(a.in[3] + (size_t)l * DM * NIN, DM, NIN, wl + E_WIN, scr, r, lane, a.in[2] + l * DM, true); continue; } r -= I_IN;
            if (r < I_OUT) { tr_item(a.in[10] + (size_t)l * DM * DM, DM, DM, wl + E_WOUT, scr, r, lane, nullptr, false); continue; } r -= I_OUT;
            if (r < I_1) { tr_item(a.in[12] + (size_t)l * DM * DFF, DM, DFF, wl + E_W1, scr, r, lane, a.in[11] + l * DM, false); continue; } r -= I_1;
            if (r < I_2) { tr_item(a.in[13] + (size_t)l * DFF * DM, DFF, DM, wl + E_W2, scr, r, lane, nullptr, false); continue; } r -= I_2;
            if (r < I_G) { tr_item(a.in[15] + (size_t)l * DM * DM, DM, DM, wl + E_WG, scr, r, lane, a.in[14] + l * DM, false); continue; } r -= I_G;
            tr_item(a.in[16] + (size_t)l * PLE * DM, PLE, DM, wl + E_WP, scr, r, lane, nullptr, false);
        }
        for (int i = gw * 64 + lane; i < DEPTH * 4 * 128 * 128; i += NGW * 64) {
            const int e8 = i & 7, ln = (i >> 3) & 63, ks = (i >> 9) & 7, tb = (i >> 12) & 3, lg = i >> 14; const int t = 32 * tb + (ln & 31), sk = 16 * ks + 8 * (ln >> 5) + e8;
            WSBb[i] = (bf16)f2bf(sk <= t ? a.in[8][((size_t)lg * 128 + t) * 128 + sk] : 0.f); }
        for (int m = gw; m < M; m += NGW) {
            const f32x4* xr = (const f32x4*)(x + (size_t)m * DM) + lane; f32x4 v[4]; float s = 0.f;
#pragma unroll
            for (int j = 0; j < 4; ++j) { v[j] = xr[64 * j]; s += (v[j].x * v[j].x + v[j].y * v[j].y) + (v[j].z * v[j].z + v[j].w * v[j].w); }
            s = wave_sum(s);
            v2u* o8 = (v2u*)(XB + (size_t)m * DM) + lane;
            v2u* l8 = (v2u*)(LO + (size_t)m * DM) + lane;
#pragma unroll
            for (int j = 0; j < 4; ++j) { v2u w; w.x = pk2(v[j].x, v[j].y); w.y = pk2(v[j].z, v[j].w); o8[64 * j] = w;
                v2u d; d.x = pk2(v[j].x - bflo(w.x), v[j].y - bfhi(w.x)); d.y = pk2(v[j].z - bflo(w.y), v[j].w - bfhi(w.y)); l8[64 * j] = d; }
            if (lane < 16) SS[(size_t)m * 16 + lane] = lane == 0 ? s : 0.f;
        }
        for (int it = gw; it < M * PLE / 512; it += NGW) { const size_t o = (size_t)it * 512 + lane * 8; const f32x4 u0 = *(const f32x4*)(p + o), u1 = *(const f32x4*)(p + o + 4);
            v4u w; w.x = pk2(u0.x, u0.y); w.y = pk2(u0.z, u0.w); w.z = pk2(u1.x, u1.y); w.w = pk2(u1.z, u1.w); *(v4u*)(PB + o) = w; }
        asm volatile("s_waitcnt vmcnt(0) lgkmcnt(0)" ::: "memory"); __syncthreads();
    }
    SEAM(0);

    for (int l = 0; l < DEPTH; ++l) {
        const int pb = 1 + 6 * l;
        const bf16* wl = Wb + (size_t)l * E_WLAYER;
        bf16* bufX = (l & 1) ? HB : XB; bf16* bufT = (l & 1) ? XB : HB;
        float* ss1 = SS; float* ss2 = SS + (size_t)M * 16; float* ss3 = SS + (size_t)2 * M * 16; float* ss1n = ss1;
        if (IN(pb)) for (int rep_ = 0; rep_ < PROBE_A; ++rep_) {
#ifndef NO_A
            { pg8::Gemm g{bufX, wl + E_WIN, M, NIN, DM}; pg8::StaticOrder S; S.init(M, NIN, G, bx);
              EpiInProj E{ss1, CONV, Qb, Kb, VTb, CUb, VNTb, a.in[5] + l * 64, a.in[6] + l * 64, a.in[7] + l * 256};
              pg8::gemm_phase<EpiInProj, pg8::StaticOrder, true, true>(lds, g, S, E); }
            { int kp = PLE; asm volatile("" : "+s"(kp)); pg8::Gemm g{PB, wl + E_WP, M, DM, kp}; TSched S{bx, (M / 256 * (NIN / 256)) % G, G};
              EpiT E{bufT};
              pg8::gemm_phase<EpiT, TSched, true, true>(lds, g, S, E); }
#endif
        }
        SEAM(pb);
        if (IN(pb + 1)) for (int rep_ = 0; rep_ < PROBE_B; ++rep_) {
            int lane_ = lane; asm volatile("" : "+v"(lane_));
#ifndef NO_ATT
            for (int pr = gw; pr < 2048; pr += NGW) { const int bh = pr >> 5, i = pr & 31;
                attn_task(Qb, Kb, VTb, Yb, bh >> 3, bh & 7, 63 - i, lane_);
                attn_task(Qb, Kb, VTb, Yb, bh >> 3, bh & 7, i, lane_); }
#endif
#ifndef NO_SGU
            for (int tk = gw; tk < 2048; tk += NGW) sgu_task(VNTb, WSBb + (size_t)l * 4 * 128 * 128, CUb, a.in[9] + l * 512, Yb, tk, lane_);
#endif
#ifndef NO_CONV
            for (int tk = gw; tk < 1024; tk += NGW) conv_task(CONV, a.in[4] + l * 768, Yb, tk, lane_);
#endif
            const float* pl = p + (size_t)(l + 1 < DEPTH ? l + 1 : l) * M * PLE;
#pragma unroll 4
            for (int it = gw; it < M * PLE / 512; it += NGW) { const size_t o = (size_t)it * 512 + lane_ * 8; const f32x4 u0 = *(const f32x4*)(pl + o), u1 = *(const f32x4*)(pl + o + 4);
                v4u w; w.x = pk2(u0.x, u0.y); w.y = pk2(u0.z, u0.w); w.z = pk2(u1.x, u1.y); w.w = pk2(u1.z, u1.w); *(v4u*)(PB + o) = w; }
            asm volatile("s_waitcnt vmcnt(0) lgkmcnt(0)" ::: "memory"); __syncthreads();
        }
        SEAM(pb + 1);
        if (IN(pb + 2)) {
#ifndef NO_C
#ifndef NO_O
            { pg8::Gemm g{Yb, wl + E_WOUT, M, DM, DM}; pg8::StaticOrder S; S.init(M, DM, G, bx);
              EpiRes E{bufX, LO, ss2, l == 0 ? 1 : 0};
              pg8::gemm_phase<EpiRes, pg8::StaticOrder, true, true>(lds, g, S, E); }
#endif
#endif
        }
        SEAM(pb + 2);
        if (IN(pb + 3)) for (int rep_ = 0; rep_ < PROBE_D; ++rep_) {
#ifndef NO_D
            pg8::Gemm g{bufX, wl + E_W1, M, DFF, DM}; pg8::StaticOrder S; S.init(M, DFF, G, bx);
            EpiFF1 E{ss2, Fb};
            pg8::gemm_phase<EpiFF1, pg8::StaticOrder, true, true>(lds, g, S, E);
#endif
        }
        SEAM(pb + 3);
        if (IN(pb + 4)) {
#ifndef NO_E
            pg8::Gemm g{Fb, wl + E_W2, M, DM, DFF}; pg8::StaticOrder S; S.init(M, DM, G, bx);
            EpiRes E{bufX, LO, ss3, 1};
            pg8::gemm_phase<EpiRes, pg8::StaticOrder, true, true>(lds, g, S, E);
#endif
        }
        SEAM(pb + 4);
        if (IN(pb + 5)) {
#ifndef NO_F
            pg8::Gemm g{bufX, wl + E_WG, M, DM, DM}; pg8::StaticOrder S; S.init(M, DM, G, bx);
            EpiGate E{ss3, bufX, LO, bufT, ss1n, l == DEPTH - 1 ? H : (float*)nullptr};
            pg8::gemm_phase<EpiGate, pg8::StaticOrder, true, true>(lds, g, S, E);
#endif
        }
        SEAM(pb + 5);
    }
#undef IN
#undef SEAM
}

extern "C" void kernel_launch(void* const* d_in, const int* in_sizes, int n_in, void* d_out, int out_size, void* d_ws, size_t ws_size, hipStream_t stream) {
    static int grid = 0;
    if (grid == 0) {
        if (n_in != 17 || in_sizes[0] != M * DM || out_size != M * DM || ws_size < WS_TOTAL) { fprintf(stderr, "kernel_launch: unexpected shapes (n_in %d, in0 %d, out %d, ws %zu, need %zu)\n", n_in, n_in > 0 ? in_sizes[0] : -1, out_size, ws_size, (size_t)WS_TOTAL); grid = -1; return; }
        int dev = 0, cus = 0, per_cu = 0;
        hipGetDevice(&dev); hipDeviceGetAttribute(&cus, hipDeviceAttributeMultiprocessorCount, dev);
        if (hipFuncSetAttribute((const void*)mk_fwd, hipFuncAttributeMaxDynamicSharedMemorySize, LDS_BYTES) != hipSuccess) { fprintf(stderr, "kernel_launch: hipFuncSetAttribute failed\n"); grid = -1; return; }
        if (hipOccupancyMaxActiveBlocksPerMultiprocessor(&per_cu, (const void*)mk_fwd, NWAVES * 64, LDS_BYTES) != hipSuccess || per_cu < 1) { fprintf(stderr, "kernel_launch: occupancy query says %d\n", per_cu); per_cu = 1; }
        (void)hipGetLastError();
        grid = cus * 1;
    }
    if (grid < 0) return;
#ifdef DBG_MEMSET
    (void)hipMemsetAsync(d_ws, 0xAA, WS_END, stream); (void)hipMemsetAsync(d_out, 0xAA, (size_t)M * DM * 4, stream);
#endif
    if (hipMemsetAsync((char*)d_ws + WS_CTL, 0, CTL_BYTES, stream) != hipSuccess) { fprintf(stderr, "kernel_launch: memset of the barrier words failed\n"); return; }
    Args a{};
    for (int i = 0; i < 17; ++i) a.in[i] = (const float*)d_in[i];
    a.out = (float*)d_out; a.ws = (unsigned char*)d_ws;
#if MK_N_LAUNCHES == 1
    a.ph_lo = 0; a.ph_hi = NPHASE;
    void* args[] = {&a};
    hipError_t e = hipLaunchCooperativeKernel((const void*)mk_fwd, dim3(grid), dim3(NWAVES * 64), args, LDS_BYTES, stream);
    if (e != hipSuccess) fprintf(stderr, "cooperative launch failed: %s (grid %d)\n", hipGetErrorString(e), grid);
#else
    for (int ph = 0; ph < NPHASE; ++ph) { a.ph_lo = ph; a.ph_hi = ph + 1; hipLaunchKernelGGL(mk_fwd, dim3(grid), dim3(NWAVES * 64), LDS_BYTES, stream, a); }
#endif
}
```

```cpp
#include <hip/hip_runtime.h>
#include <hip/hip_cooperative_groups.h>
#include <cstdio>
#include <cstdint>
namespace cg = cooperative_groups;
namespace pg8 {
#define PG8_LAS __attribute__((address_space(3)))
typedef unsigned short bf16_t;
typedef short bf16x8 __attribute__((ext_vector_type(8)));
typedef float f32x4 __attribute__((ext_vector_type(4)));
typedef unsigned u32x4 __attribute__((ext_vector_type(4)));
constexpr int BM = 256, BK = 64, HALF = 128, HTB = HALF * BK * 2  , STAGE_BYTES = 8 * HTB, NXCD = 8, WGM = 8;

__host__ __device__ __forceinline__ int lds_byte(int r, int c) { const int st = (r >> 4) * 2 + (c >> 5), rr = r & 15, cc = c & 31, ob = rr * 64 + cc * 2; return st * 1024 + (ob ^ (((ob >> 9) & 1) << 5)); }
__host__ __device__ __forceinline__ void stage_rc(int b, int& R, int& C) { const int st = b / 1024, sb = b % 1024, swz = sb ^ (((sb >> 9) & 1) << 5); R = (st >> 1) * 16 + swz / 64; C = (st & 1) * 32 + (swz % 64) / 2; }
__host__ __device__ __forceinline__ int perm32(int rho) { const int n = rho >> 4, i = rho & 15; return 8 * (i >> 2) + 4 * n + (i & 3); }

struct Unit { int pm, pn; };
struct Gemm { const bf16_t* A; const bf16_t* Bt; int M, N, K; };

struct StaticOrder {
    int nM, nN, nwg, G, c;
    __host__ __device__ void init(int M, int N, int G_, int c_) { nM = M / BM; nN = N / BM; nwg = nM * nN; G = G_; c = c_; }
    __host__ __device__ bool next(int i, Unit& u) const {
        const long L = (long)i * G + c; if (L >= nwg) return false;
        int wgid = (int)L; { const int q = nwg / NXCD, r = nwg % NXCD, xcd = wgid % NXCD, off = wgid / NXCD; wgid = (xcd < r ? xcd * (q + 1) : r * (q + 1) + (xcd - r) * q) + off; }
        const int nig = WGM * nN, gid = wgid / nig, fm = gid * WGM, gsz = (nM - fm) < WGM ? (nM - fm) : WGM;
        u.pm = fm + ((wgid % nig) % gsz); u.pn = (wgid % nig) / gsz; return true;
    }
    __device__ __forceinline__ void a_ready(const Unit&) const {}
    __device__ __forceinline__ void done(const Unit&) const {}
};

__device__ __forceinline__ unsigned cvt_pk_bf16(float lo, float hi) { unsigned r; asm volatile("v_cvt_pk_bf16_f32 %0, %1, %2" : "=v"(r) : "v"(lo), "v"(hi)); return r; }
typedef float f32x2 __attribute__((ext_vector_type(2)));
__device__ __forceinline__ f32x2 gelu_pk(f32x2 v) {
    const f32x2 av = __builtin_elementwise_abs(v), d = av * 0.2316418882f + 1.0f;
    f32x2 t; t.x = __builtin_amdgcn_rcpf(d.x); t.y = __builtin_amdgcn_rcpf(d.y);
    f32x2 q = t * 0.5307027145f + (-0.7265760135f); q = q * t + 0.7107068705f; q = q * t + (-0.142248368f); q = q * t + 0.127414796f; q = q * t;
    const f32x2 s = (v * v) * (-0.72134752044f);
    f32x2 e; e.x = __builtin_amdgcn_exp2f(s.x); e.y = __builtin_amdgcn_exp2f(s.y);
    const f32x2 m = v * (q * e), r = v - m;
    f32x2 o; o.x = v.x < 0.f ? m.x : r.x; o.y = v.y < 0.f ? m.y : r.y; return o;
}

template <int ACT  > struct EpiBf16 {
    static constexpr bool PERM = true, AFTER_DRAIN = false; static_assert(ACT == 0 || ACT == 1, "EpiBf16: ACT is 0 (none) or 1 (gelu_pk)");
    bf16_t* O; int ldc; const float* bias; int split_cols; size_t split_stride; float scale0;
    __device__ __forceinline__ void operator()(const f32x4 (&acc)[2][2][4][2], const Unit& u, int wr, int wc, int fr, int fq) const {
        const int row0 = u.pm * BM + wr * 64 + fr; int colt = u.pn * BM; bf16_t* base = O;
        float sc = 1.f; if (split_cols) { const int t = colt / split_cols; base += (size_t)t * split_stride; colt -= t * split_cols; if (t == 0) sc = scale0; }
        const int col0 = colt + wc * 32 + 8 * fq, bcol0 = u.pn * BM + wc * 32 + 8 * fq;
        f32x4 bv[2][2];
#pragma unroll
        for (int bj = 0; bj < 2; ++bj)
#pragma unroll
            for (int n = 0; n < 2; ++n) bv[bj][n] = bias ? *(const f32x4*)(bias + bcol0 + bj * HALF + 4 * n) : (f32x4){0.f, 0.f, 0.f, 0.f};
#pragma unroll
        for (int ai = 0; ai < 2; ++ai)
#pragma unroll
            for (int m = 0; m < 4; ++m) { bf16_t* rowp = base + (size_t)(row0 + ai * HALF + m * 16) * ldc + col0;
#pragma unroll
                for (int bj = 0; bj < 2; ++bj) { f32x4 v0 = acc[ai][bj][m][0] + bv[bj][0], v1 = acc[ai][bj][m][1] + bv[bj][1];
                    if (ACT == 1) { f32x2 a = gelu_pk((f32x2){v0[0], v0[1]}), b = gelu_pk((f32x2){v0[2], v0[3]}), c = gelu_pk((f32x2){v1[0], v1[1]}), d = gelu_pk((f32x2){v1[2], v1[3]});
                        v0 = (f32x4){a.x, a.y, b.x, b.y}; v1 = (f32x4){c.x, c.y, d.x, d.y}; }
                    v0 = v0 * sc; v1 = v1 * sc; u32x4 w; w.x = cvt_pk_bf16(v0[0], v0[1]); w.y = cvt_pk_bf16(v0[2], v0[3]); w.z = cvt_pk_bf16(v1[0], v1[1]); w.w = cvt_pk_bf16(v1[2], v1[3]);
                    *(u32x4*)(rowp + bj * HALF) = w; } }
    }
};
template <class Epi, class Sched, bool ALIGN_EPI = false, bool SP2 = false>
__device__ __forceinline__ void gemm_phase(PG8_LAS unsigned char* lds, const Gemm g, const Sched& S, const Epi& E) {
    int tid_ = threadIdx.x; asm volatile("" : "+v"(tid_));
    const int tid = tid_, wid = __builtin_amdgcn_readfirstlane(tid >> 6), lane = tid & 63, wr = wid >> 2, wc = wid & 3, fr = lane & 15, fq = lane >> 4;
    const int K = g.K, nt = K / BK;
    unsigned voffA[2], voffB[2];
#pragma unroll
    for (int i = 0; i < 2; ++i) { int R, C; stage_rc(tid * 16 + i * 8192, R, C); const int Rb = Epi::PERM ? ((R & ~31) + perm32(R & 31)) : R;
        voffA[i] = (unsigned)(R * K + C) * 2u; voffB[i] = (unsigned)(Rb * K + C) * 2u; }
    const size_t kstep = (size_t)(BK * 2);
    const size_t hstep = (size_t)HALF * K * 2;
    const size_t tstep = 2 * hstep;
    const unsigned ldsw = (unsigned)wid * 1024u;
    const int aoff = lds_byte(wr * 64 + fr, fq * 8), boff = lds_byte(wc * 32 + fr, fq * 8);
#define PG8_SA(b, h) (((b) * 2 + (h)) * HTB)
#define PG8_SB(b, h) ((4 + (b) * 2 + (h)) * HTB)
#define PG8_STAGE(bufoff, gbase, voff) do { _Pragma("unroll") for (int _i = 0; _i < 2; ++_i) \
        __builtin_amdgcn_global_load_lds((const unsigned*)((const char*)(gbase) + (voff)[_i]), (PG8_LAS unsigned*)(lds + (bufoff) + ldsw + _i * 8192), 16, 0, 0); } while (0)
#define PG8_LDA(dst, b, h) do { _Pragma("unroll") for (int m = 0; m < 4; ++m) _Pragma("unroll") for (int k = 0; k < 2; ++k) dst[m][k] = *(const PG8_LAS bf16x8*)(lds + PG8_SA(b, h) + aoff + m * 2048 + k * 1024); } while (0)
#define PG8_LDB(dst, b, h) do { _Pragma("unroll") for (int n = 0; n < 2; ++n) _Pragma("unroll") for (int k = 0; k < 2; ++k) dst[n][k] = *(const PG8_LAS bf16x8*)(lds + PG8_SB(b, h) + boff + n * 2048 + k * 1024); } while (0)
#define PG8_MMA(ai, bj, At, Bt) do { __builtin_amdgcn_s_setprio(1); _Pragma("unroll") for (int m = 0; m < 4; ++m) _Pragma("unroll") for (int n = 0; n < 2; ++n) _Pragma("unroll") for (int k = 0; k < 2; ++k) \
        acc[ai][bj][m][n] = __builtin_amdgcn_mfma_f32_16x16x32_bf16(Bt[n][k], At[m][k], acc[ai][bj][m][n], 0, 0, 0); __builtin_amdgcn_s_setprio(0); } while (0)
#define PG8_WAIT_V(n) asm volatile("s_waitcnt vmcnt(" #n ")" ::: "memory")
#define PG8_WAIT_L(n) asm volatile("s_waitcnt lgkmcnt(" #n ")" ::: "memory")
#define PG8_BAR __builtin_amdgcn_s_barrier()
#define PG8_SCHED __builtin_amdgcn_sched_barrier(0)
    Unit cur, nxt; int ui = 0;
    if (!S.next(0, cur)) return;
    f32x4 acc[2][2][4][2];
#pragma unroll
    for (int a = 0; a < 2; ++a)
#pragma unroll
        for (int b = 0; b < 2; ++b)
#pragma unroll
            for (int m = 0; m < 4; ++m)
#pragma unroll
                for (int n = 0; n < 2; ++n) acc[a][b][m][n] = (f32x4){0.f, 0.f, 0.f, 0.f};
    bf16x8 At[4][2], B0[2][2], B1[2][2];
    const char* cA = (const char*)g.A + (size_t)cur.pm * tstep; const char* cB = (const char*)g.Bt + (size_t)cur.pn * tstep;
    S.a_ready(cur);
    if constexpr (SP2) {
        PG8_STAGE(PG8_SB(0, 0), cB, voffB); PG8_STAGE(PG8_SB(0, 1), cB + hstep, voffB); PG8_STAGE(PG8_SA(0, 0), cA, voffA); PG8_STAGE(PG8_SA(0, 1), cA + hstep, voffA);
        if (wr == 1) PG8_BAR;
        PG8_WAIT_V(2); PG8_BAR;
        PG8_STAGE(PG8_SB(1, 0), cB + kstep, voffB); PG8_STAGE(PG8_SA(1, 0), cA + kstep, voffA); PG8_STAGE(PG8_SB(1, 1), cB + hstep + kstep, voffB);
        PG8_WAIT_V(6); PG8_BAR;
    } else {
        PG8_STAGE(PG8_SB(0, 0), cB, voffB); PG8_STAGE(PG8_SA(0, 0), cA, voffA); PG8_STAGE(PG8_SB(0, 1), cB + hstep, voffB); PG8_STAGE(PG8_SA(0, 1), cA + hstep, voffA);
        if (wr == 1) PG8_BAR;
        PG8_WAIT_V(4); PG8_BAR;
        PG8_STAGE(PG8_SB(1, 0), cB + kstep, voffB); PG8_STAGE(PG8_SA(1, 0), cA + kstep, voffA); PG8_STAGE(PG8_SB(1, 1), cB + hstep + kstep, voffB);
        PG8_WAIT_V(6); PG8_BAR;
    }
    for (;;) {
        const bool has_next = S.next(ui + 1, nxt);
        const char* nA = has_next ? (const char*)g.A + (size_t)nxt.pm * tstep : cA; const char* nB = has_next ? (const char*)g.Bt + (size_t)nxt.pn * tstep : cB;
        for (int t = 0; t < nt; t += 2) {
            const bool last = (t == nt - 2);
            const char* a1 = cA + (size_t)(t + 1) * kstep;
            const char* a2 = last ? nA : cA + (size_t)(t + 2) * kstep; const char* b2 = last ? nB : cB + (size_t)(t + 2) * kstep;
            const char* a3 = a2 + kstep; const char* b3 = b2 + kstep;
            if (last && has_next) S.a_ready(nxt);
            if constexpr (SP2) {
            PG8_LDB(B0, 0, 0); PG8_LDB(B1, 0, 1); PG8_SCHED; PG8_LDA(At, 0, 0); PG8_STAGE(PG8_SA(1, 1), a1 + hstep, voffA);
            PG8_WAIT_V(8); PG8_WAIT_L(0); PG8_BAR; PG8_MMA(0, 0, At, B0); PG8_MMA(0, 1, At, B1); PG8_BAR; PG8_SCHED;
            PG8_LDA(At, 0, 1); PG8_STAGE(PG8_SB(0, 0), b2, voffB); PG8_STAGE(PG8_SB(0, 1), b2 + hstep, voffB); PG8_STAGE(PG8_SA(0, 0), a2, voffA);
            PG8_WAIT_V(8); PG8_WAIT_L(0); PG8_BAR; PG8_MMA(1, 0, At, B0); PG8_MMA(1, 1, At, B1); PG8_BAR; PG8_SCHED;
            PG8_LDB(B0, 1, 0); PG8_LDB(B1, 1, 1); PG8_SCHED; PG8_LDA(At, 1, 0); PG8_STAGE(PG8_SA(0, 1), a2 + hstep, voffA);
            PG8_WAIT_V(8); PG8_WAIT_L(0); PG8_BAR; PG8_MMA(0, 0, At, B0); PG8_MMA(0, 1, At, B1); PG8_BAR; PG8_SCHED;
            PG8_LDA(At, 1, 1); PG8_STAGE(PG8_SB(1, 0), b3, voffB); PG8_STAGE(PG8_SB(1, 1), b3 + hstep, voffB); PG8_STAGE(PG8_SA(1, 0), a3, voffA);
            PG8_WAIT_V(8); PG8_WAIT_L(0); PG8_BAR; PG8_MMA(1, 0, At, B0); PG8_MMA(1, 1, At, B1); PG8_BAR; PG8_SCHED;
            } else {
            PG8_LDB(B0, 0, 0); PG8_SCHED; PG8_LDA(At, 0, 0); PG8_STAGE(PG8_SA(1, 1), a1 + hstep, voffA);
            PG8_WAIT_L(8); PG8_BAR; PG8_WAIT_L(0); PG8_MMA(0, 0, At, B0); PG8_BAR; PG8_SCHED;
            PG8_LDB(B1, 0, 1); PG8_STAGE(PG8_SB(0, 0), b2, voffB);
            PG8_BAR; PG8_WAIT_L(0); PG8_MMA(0, 1, At, B1); PG8_BAR;
            PG8_LDA(At, 0, 1); PG8_STAGE(PG8_SA(0, 0), a2, voffA);
            PG8_BAR; PG8_WAIT_L(0); PG8_MMA(1, 0, At, B0); PG8_BAR; PG8_SCHED;
            PG8_STAGE(PG8_SB(0, 1), b2 + hstep, voffB);
            PG8_WAIT_V(6); PG8_BAR; PG8_MMA(1, 1, At, B1); PG8_BAR;
            PG8_LDB(B0, 1, 0); PG8_SCHED; PG8_LDA(At, 1, 0); PG8_STAGE(PG8_SA(0, 1), a2 + hstep, voffA);
            PG8_WAIT_L(8); PG8_BAR; PG8_WAIT_L(0); PG8_MMA(0, 0, At, B0); PG8_BAR; PG8_SCHED;
            PG8_LDB(B1, 1, 1); PG8_STAGE(PG8_SB(1, 0), b3, voffB);
            PG8_BAR; PG8_WAIT_L(0); PG8_MMA(0, 1, At, B1); PG8_BAR;
            PG8_LDA(At, 1, 1); PG8_STAGE(PG8_SA(1, 0), a3, voffA);
            PG8_BAR; PG8_WAIT_L(0); PG8_MMA(1, 0, At, B0); PG8_BAR; PG8_SCHED;
            PG8_STAGE(PG8_SB(1, 1), b3 + hstep, voffB);
            PG8_WAIT_V(6); PG8_BAR; PG8_MMA(1, 1, At, B1); PG8_BAR;
            }
        }
        if constexpr (ALIGN_EPI) { if (wr == 0) PG8_BAR; }
        if constexpr (!Epi::AFTER_DRAIN) { E(acc, cur, wr, wc, fr, fq); S.done(cur); }
        if (!has_next) break;
#pragma unroll
        for (int a = 0; a < 2; ++a)
#pragma unroll
            for (int b = 0; b < 2; ++b)
#pragma unroll
                for (int m = 0; m < 4; ++m)
#pragma unroll
                    for (int n = 0; n < 2; ++n) acc[a][b][m][n] = (f32x4){0.f, 0.f, 0.f, 0.f};
        cur = nxt; cA = nA; cB = nB; ++ui;
        if constexpr (ALIGN_EPI) { if (wr == 1) PG8_BAR; }
    }
    PG8_WAIT_V(0);
    if constexpr (!ALIGN_EPI) { if (wr == 0) PG8_BAR; }
    PG8_BAR;
    if constexpr (Epi::AFTER_DRAIN) { E.fused(acc, cur, wr, wc, fr, fq, lds, wid, lane); S.done(cur); }
#undef PG8_SA
#undef PG8_SB
#undef PG8_STAGE
#undef PG8_LDA
#undef PG8_LDB
#undef PG8_MMA
#undef PG8_WAIT_V
#undef PG8_WAIT_L
#undef PG8_BAR
#undef PG8_SCHED
}
}

#ifndef MK_N_LAUNCHES
#define MK_N_LAUNCHES 1
#endif
#ifndef ATT_EARLY_EXIT
#define ATT_EARLY_EXIT 1
#endif
constexpr int NWAVES = 8;
constexpr int M = 16384, DM = 1024, SEQ = 2048, DEPTH = 4, NIN = 2816, DFF = 4096, PLE = 256;
constexpr float EPS = 1e-6f;
constexpr float C2 = 0.125f * 1.4426950408889634f;
constexpr int NPHASE = 1 + 6 * DEPTH;
#ifndef PROBE_B
#define PROBE_B 1
#endif
#ifndef PROBE_SYNC
#define PROBE_SYNC 1
#endif
#ifndef PROBE_P
#define PROBE_P 1
#endif
#ifndef PROBE_A
#define PROBE_A 1
#endif
#ifndef PROBE_D
#define PROBE_D 1
#endif

typedef unsigned short bf16;
#define LAS __attribute__((address_space(3)))
typedef unsigned v4u __attribute__((ext_vector_type(4)));
typedef unsigned v2u __attribute__((ext_vector_type(2)));
typedef float f32x4 __attribute__((ext_vector_type(4)));
typedef float f32x2 __attribute__((ext_vector_type(2)));
typedef float f32x16 __attribute__((ext_vector_type(16)));
typedef short bf16x8 __attribute__((ext_vector_type(8)));
typedef short s16x4 __attribute__((ext_vector_type(4)));
#define LDS_WAIT() asm volatile("s_waitcnt lgkmcnt(0)" ::: "memory")

constexpr size_t E_WIN = 0, E_WOUT = (size_t)NIN * DM, E_W1 = E_WOUT + (size_t)DM * DM, E_W2 = E_W1 + (size_t)DFF * DM, E_WG = E_W2 + (size_t)DFF * DM, E_WP = E_WG + (size_t)DM * DM,
                 E_WLAYER = E_WP + (size_t)PLE * DM;
constexpr size_t WS_W = 0, WS_WSB = WS_W + (size_t)DEPTH * E_WLAYER * 2, WS_SS = WS_WSB + (size_t)DEPTH * 4 * 128 * 128 * 2, WS_HB = WS_SS + (size_t)3 * M * 16 * 4,
                 WS_LO = WS_HB + (size_t)M * DM * 2, WS_XB = WS_LO + (size_t)M * DM * 2, WS_BIG = WS_XB + (size_t)M * DM * 2, WS_END = WS_BIG + (size_t)M * DFF * 2;
constexpr size_t B_CONV = 0, B_Q = B_CONV + (size_t)3 * M * 256 * 2, B_K = B_Q + (size_t)M * 512 * 2, B_VT = B_K + (size_t)M * 512 * 2, B_CU = B_VT + (size_t)M * 512 * 2,
                 B_VNT = B_CU + (size_t)M * 256 * 2, B_Y = B_VNT + (size_t)M * 256 * 2, B_ENDMIX = B_Y + (size_t)M * DM * 2;
static_assert(B_ENDMIX <= (size_t)M * DFF * 2, "mixer tensors fit under the F overlay");
constexpr size_t WS_CTL = WS_END, CTL_BYTES = 16384, WS_TOTAL = WS_CTL + CTL_BYTES;
constexpr int RING_BYTES = 131072, LDS_BYTES = 132096;

__device__ __forceinline__ unsigned f2bf(float f) { unsigned u = __builtin_bit_cast(unsigned, f); return (u + 0x7fffu + ((u >> 16) & 1u)) >> 16; }
typedef __bf16 bf16x2_t __attribute__((ext_vector_type(2)));
__device__ __forceinline__ unsigned pk2(float lo, float hi) { f32x2 v = {lo, hi}; bf16x2_t b = __builtin_convertvector(v, bf16x2_t); return __builtin_bit_cast(unsigned, b); }
__device__ __forceinline__ float bflo(unsigned u) { return __builtin_bit_cast(float, u << 16); }
__device__ __forceinline__ float bfhi(unsigned u) { return __builtin_bit_cast(float, u & 0xffff0000u); }
__device__ __forceinline__ float wave_sum(float v) {
#pragma unroll
    for (int o = 1; o < 64; o <<= 1) v += __shfl_xor(v, o);
    return v;
}

__device__ __forceinline__ float row_rs(const float* ssp, int r) {
    const f32x4* q = (const f32x4*)(ssp + (size_t)r * 16); const f32x4 a = q[0], b = q[1], c = q[2], d = q[3];
    const float s = ((a[0] + a[1]) + (a[2] + a[3])) + ((b[0] + b[1]) + (b[2] + b[3])) + ((c[0] + c[1]) + (c[2] + c[3])) + ((d[0] + d[1]) + (d[2] + d[3]));
    return rsqrtf(s * (1.f / 1024.f) + EPS);
}
struct EpiInProj {
    static constexpr bool PERM = true, AFTER_DRAIN = false;
    const float* ss; bf16* conv; bf16* q; bf16* k; bf16* vt; bf16* cu; bf16* vnt; const float* qg; const float* kg; const float* sg;
    __device__ __forceinline__ void operator()(const pg8::f32x4 (&acc)[2][2][4][2], const pg8::Unit& u, int wr, int wc, int fr, int fq) const {
        const int sec = u.pn;
        const int row0 = u.pm * 256 + wr * 64 + fr;
        const int cw = 64 * wc + 8 * fq;
        const bool normed = (sec >= 3 && sec < 7) || sec == 10;
        float rsv[8];
#pragma unroll
        for (int g = 0; g < 8; ++g) { rsv[g] = row_rs(ss, row0 + (g >> 2) * 128 + (g & 3) * 16); if (g & 1) asm volatile("" : "+v"(rsv[g - 1]), "+v"(rsv[g]) :: "memory"); }
        f32x4 gv[2][2];
#pragma unroll
        for (int bj = 0; bj < 2; ++bj)
#pragma unroll
            for (int n = 0; n < 2; ++n) {
                if (sec >= 3 && sec < 7) { const float* g = sec < 5 ? qg : kg; const float sc = sec < 5 ? C2 : 1.f; gv[bj][n] = *(const f32x4*)(g + 32 * bj + 8 * fq + 4 * n) * sc; }
                else if (sec == 10) gv[bj][n] = *(const f32x4*)(sg + cw + 32 * bj + 4 * n);
                else gv[bj][n] = (f32x4){1.f, 1.f, 1.f, 1.f};
            }
#pragma unroll
        for (int ai = 0; ai < 2; ++ai)
#pragma unroll
            for (int m = 0; m < 4; ++m) {
                const int r = row0 + ai * 128 + m * 16;
                const float rs = rsv[ai * 4 + m];
                f32x4 v[2][2];
#pragma unroll
                for (int bj = 0; bj < 2; ++bj)
#pragma unroll
                    for (int n = 0; n < 2; ++n) v[bj][n] = acc[ai][bj][m][n] * rs;
                if (sec >= 9) {
#pragma unroll
                    for (int bj = 0; bj < 2; ++bj)
#pragma unroll
                        for (int n = 0; n < 2; ++n) { const pg8::f32x2 a = pg8::gelu_pk((pg8::f32x2){v[bj][n][0], v[bj][n][1]}), b = pg8::gelu_pk((pg8::f32x2){v[bj][n][2], v[bj][n][3]}); v[bj][n] = (f32x4){a.x, a.y, b.x, b.y}; }
                }
                if (normed) {
                    float s2 = 0.f;
#pragma unroll
                    for (int bj = 0; bj < 2; ++bj)
#pragma unroll
                        for (int n = 0; n < 2; ++n) { const f32x4 x = v[bj][n]; s2 += (x[0] * x[0] + x[1] * x[1]) + (x[2] * x[2] + x[3] * x[3]); }
                    s2 += __shfl_xor(s2, 16); s2 += __shfl_xor(s2, 32);
                    const float rn = rsqrtf(s2 * (1.f / 64.f) + EPS);
#pragma unroll
                    for (int bj = 0; bj < 2; ++bj)
#pragma unroll
                        for (int n = 0; n < 2; ++n) v[bj][n] = v[bj][n] * rn * gv[bj][n];
                }
                const int b = r >> 11, s = r & 2047;
                if (sec == 10) {
                    const int sl = s & 127;
                    bf16* base = vnt + ((((size_t)((b * 4 + wc) * 16 + (s >> 7)) * 2) * 8 + (sl >> 4)) * 64 + ((sl >> 3) & 1) * 32 + 8 * fq) * 8 + (sl & 7);
#pragma unroll
                    for (int bj = 0; bj < 2; ++bj)
#pragma unroll
                        for (int n = 0; n < 2; ++n)
#pragma unroll
                            for (int j = 0; j < 4; ++j) base[(size_t)bj * 8 * 64 * 8 + (4 * n + j) * 8] = (bf16)f2bf(v[bj][n][j]);
                } else if (sec == 7 || sec == 8) {
                    const int kk_ = s & 31;
                    bf16* base = vt + (((size_t)((b * 8 + 4 * (sec - 7) + wc) * 64 + (s >> 5)) * 4 + (kk_ >> 4)) * 64 + ((kk_ >> 3) & 1) * 32 + 8 * fq) * 8 + (kk_ & 7);
#pragma unroll
                    for (int bj = 0; bj < 2; ++bj)
#pragma unroll
                        for (int n = 0; n < 2; ++n)
#pragma unroll
                            for (int j = 0; j < 4; ++j) base[(size_t)bj * 2 * 64 * 8 + (4 * n + j) * 8] = (bf16)f2bf(v[bj][n][j]);
                } else if (sec >= 3 && sec < 7) {
                    const bool isq = sec < 5;
                    const int sl = s & 31, pos = isq ? sl : ((sl & 0x13) | ((sl & 4) << 1) | ((sl & 8) >> 1));
                    bf16* base = (isq ? q : k) + (((size_t)((b * 8 + 4 * ((sec - 3) & 1) + wc) * 64 + (s >> 5)) * 4 + (fq >> 1)) * 64 + (fq & 1) * 32 + pos) * 8;
#pragma unroll
                    for (int bj = 0; bj < 2; ++bj) { v4u w; w.x = pk2(v[bj][0][0], v[bj][0][1]); w.y = pk2(v[bj][0][2], v[bj][0][3]); w.z = pk2(v[bj][1][0], v[bj][1][1]); w.w = pk2(v[bj][1][2], v[bj][1][3]);
                        *(v4u*)(base + (size_t)bj * 2 * 64 * 8) = w; }
                } else {
                    bf16* dst; int ld;
                    if (sec < 3) { dst = conv + (size_t)sec * M * 256 + cw; ld = 256; }
                    else { dst = cu + cw; ld = 256; }
                    dst += (size_t)r * ld;
#pragma unroll
                    for (int bj = 0; bj < 2; ++bj) { v4u w; w.x = pk2(v[bj][0][0], v[bj][0][1]); w.y = pk2(v[bj][0][2], v[bj][0][3]); w.z = pk2(v[bj][1][0], v[bj][1][1]); w.w = pk2(v[bj][1][2], v[bj][1][3]);
                        *(v4u*)(dst + 32 * bj) = w; }
                }
            }
    }
};

__device__ __forceinline__ void unpk(const v4u w, f32x4& a, f32x4& b) { a = (f32x4){bflo(w.x), bfhi(w.x), bflo(w.y), bfhi(w.y)}; b = (f32x4){bflo(w.z), bfhi(w.z), bflo(w.w), bfhi(w.w)}; }
__device__ __forceinline__ void split_store(const f32x4 h0, const f32x4 h1, bf16* hi, bf16* lo) {
    v4u w; w.x = pk2(h0[0], h0[1]); w.y = pk2(h0[2], h0[3]); w.z = pk2(h1[0], h1[1]); w.w = pk2(h1[2], h1[3]); *(v4u*)hi = w;
    f32x4 a, b; unpk(w, a, b); const f32x4 d0 = h0 - a, d1 = h1 - b;
    v4u l; l.x = pk2(d0[0], d0[1]); l.y = pk2(d0[2], d0[3]); l.z = pk2(d1[0], d1[1]); l.w = pk2(d1[2], d1[3]); *(v4u*)lo = l;
}
struct EpiRes {
    static constexpr bool PERM = true, AFTER_DRAIN = false;
    bf16* hi; bf16* lo; float* ssout; int use_lo, write_lo;
    __device__ __forceinline__ void operator()(const pg8::f32x4 (&acc)[2][2][4][2], const pg8::Unit& u, int wr, int wc, int fr, int fq) const {
        const int row0 = u.pm * 256 + wr * 64 + fr, col0 = u.pn * 256 + wc * 32 + 8 * fq;
        constexpr int LA = 2;
        v4u bq[8][4];
#pragma unroll
        for (int g = 0; g < LA; ++g) { const size_t off = (size_t)(row0 + (g >> 2) * 128 + (g & 3) * 16) * DM + col0;
#pragma unroll
            for (int bj = 0; bj < 2; ++bj) { bq[g][2 * bj] = *(const v4u*)(hi + off + bj * 128); bq[g][2 * bj + 1] = use_lo ? *(const v4u*)(lo + off + bj * 128) : (v4u){0u, 0u, 0u, 0u}; } }
#pragma unroll
        for (int g = 0; g < 8; ++g) {
            if (g + LA < 8) { const int gn = g + LA; const size_t off = (size_t)(row0 + (gn >> 2) * 128 + (gn & 3) * 16) * DM + col0;
#pragma unroll
                for (int bj = 0; bj < 2; ++bj) { bq[gn][2 * bj] = *(const v4u*)(hi + off + bj * 128); bq[gn][2 * bj + 1] = use_lo ? *(const v4u*)(lo + off + bj * 128) : (v4u){0u, 0u, 0u, 0u}; } }
            const int ai = g >> 2, m = g & 3;
            const int r = row0 + ai * 128 + m * 16; const size_t off = (size_t)r * DM + col0; float s2 = 0.f;
#pragma unroll
            for (int bj = 0; bj < 2; ++bj) {
                f32x4 a0, a1, l0, l1; unpk(bq[g][2 * bj], a0, a1); unpk(bq[g][2 * bj + 1], l0, l1);
                const f32x4 h0 = (a0 + l0) + acc[ai][bj][m][0], h1 = (a1 + l1) + acc[ai][bj][m][1];
                if (write_lo) split_store(h0, h1, hi + off + bj * 128, lo + off + bj * 128);
                else { v4u w; w.x = pk2(h0[0], h0[1]); w.y = pk2(h0[2], h0[3]); w.z = pk2(h1[0], h1[1]); w.w = pk2(h1[2], h1[3]); *(v4u*)(hi + off + bj * 128) = w; }
                s2 += (h0[0] * h0[0] + h0[1] * h0[1]) + (h0[2] * h0[2] + h0[3] * h0[3]) + (h1[0] * h1[0] + h1[1] * h1[1]) + (h1[2] * h1[2] + h1[3] * h1[3]);
            }
            s2 += __shfl_xor(s2, 16); s2 += __shfl_xor(s2, 32);
            if (fq == 0) ssout[(size_t)r * 16 + u.pn * 4 + wc] = s2;
            asm volatile("" ::: "memory");
        }
    }
};
struct EpiFF1 {
    static constexpr bool PERM = true, AFTER_DRAIN = false;
    const float* ss; bf16* f;
    __device__ __forceinline__ void operator()(const pg8::f32x4 (&acc)[2][2][4][2], const pg8::Unit& u, int wr, int wc, int fr, int fq) const {
        const int row0 = u.pm * 256 + wr * 64 + fr, col0 = u.pn * 256 + wc * 32 + 8 * fq;
        float rsv[8];
#pragma unroll
        for (int g = 0; g < 8; ++g) { rsv[g] = row_rs(ss, row0 + (g >> 2) * 128 + (g & 3) * 16); if (g & 1) asm volatile("" : "+v"(rsv[g - 1]), "+v"(rsv[g]) :: "memory"); }
#pragma unroll
        for (int ai = 0; ai < 2; ++ai)
#pragma unroll
            for (int m = 0; m < 4; ++m) {
                const int r = row0 + ai * 128 + m * 16; const float rs = rsv[ai * 4 + m]; bf16* dst = f + (size_t)r * DFF + col0;
#pragma unroll
                for (int bj = 0; bj < 2; ++bj) {
                    f32x4 a = acc[ai][bj][m][0] * rs, b = acc[ai][bj][m][1] * rs;
#pragma unroll
                    for (int j = 0; j < 4; ++j) { a[j] = fmaxf(a[j], 0.f); a[j] *= a[j]; b[j] = fmaxf(b[j], 0.f); b[j] *= b[j]; }
                    v4u w; w.x = pk2(a[0], a[1]); w.y = pk2(a[2], a[3]); w.z = pk2(b[0], b[1]); w.w = pk2(b[2], b[3]); *(v4u*)(dst + bj * 128) = w;
                }
            }
    }
};
struct EpiT {
    static constexpr bool PERM = true, AFTER_DRAIN = false;
    bf16* t;
    __device__ __forceinline__ void operator()(const pg8::f32x4 (&acc)[2][2][4][2], const pg8::Unit& u, int wr, int wc, int fr, int fq) const {
        const int row0 = u.pm * 256 + wr * 64 + fr, col0 = u.pn * 256 + wc * 32 + 8 * fq;
#pragma unroll
        for (int ai = 0; ai < 2; ++ai)
#pragma unroll
            for (int m = 0; m < 4; ++m) {
                bf16* dst = t + (size_t)(row0 + ai * 128 + m * 16) * DM + col0;
#pragma unroll
                for (int bj = 0; bj < 2; ++bj) { const f32x4 a = acc[ai][bj][m][0], b = acc[ai][bj][m][1];
                    v4u w; w.x = pk2(a[0], a[1]); w.y = pk2(a[2], a[3]); w.z = pk2(b[0], b[1]); w.w = pk2(b[2], b[3]); *(v4u*)(dst + bj * 128) = w; }
            }
    }
};
struct EpiGate {
    static constexpr bool PERM = true, AFTER_DRAIN = false;
    const float* ss; const bf16* hi; bf16* lo; bf16* tx; float* ssout; float* fout;
    __device__ __forceinline__ void operator()(const pg8::f32x4 (&acc)[2][2][4][2], const pg8::Unit& u, int wr, int wc, int fr, int fq) const {
        const int row0 = u.pm * 256 + wr * 64 + fr, col0 = u.pn * 256 + wc * 32 + 8 * fq;
        float rsv[8];
#pragma unroll
        for (int g = 0; g < 8; ++g) { rsv[g] = row_rs(ss, row0 + (g >> 2) * 128 + (g & 3) * 16) * (-1.4426950408889634f); if (g & 1) asm volatile("" : "+v"(rsv[g - 1]), "+v"(rsv[g]) :: "memory"); }
        v4u hq[16], lq[16], tq[16];
        { const size_t off = (size_t)row0 * DM + col0; tq[0] = *(const v4u*)(tx + off); hq[0] = *(const v4u*)(hi + off); lq[0] = *(const v4u*)(lo + off); }
        float s2 = 0.f;
#pragma unroll
        for (int q = 0; q < 16; ++q) {
            if (q + 1 < 16) { const int gn = (q + 1) >> 1, bn = (q + 1) & 1; const size_t off = (size_t)(row0 + (gn >> 2) * 128 + (gn & 3) * 16) * DM + col0 + bn * 128;
                tq[q + 1] = *(const v4u*)(tx + off); hq[q + 1] = *(const v4u*)(hi + off); lq[q + 1] = *(const v4u*)(lo + off); }
            const int g = q >> 1, bj = q & 1, ai = g >> 2, m = g & 3;
            const int r = row0 + ai * 128 + m * 16; const float rs = rsv[g]; const size_t off = (size_t)r * DM + col0 + bj * 128;
            f32x4 t0, t1, a0, a1, l0, l1; unpk(tq[q], t0, t1); unpk(hq[q], a0, a1); unpk(lq[q], l0, l1);
            f32x4 g0 = acc[ai][bj][m][0] * rs, g1 = acc[ai][bj][m][1] * rs;
#pragma unroll
            for (int j = 0; j < 4; ++j) { g0[j] = __builtin_amdgcn_rcpf(1.f + __builtin_amdgcn_exp2f(g0[j])); g1[j] = __builtin_amdgcn_rcpf(1.f + __builtin_amdgcn_exp2f(g1[j])); }
            const f32x4 h0 = (a0 + l0) + g0 * t0, h1 = (a1 + l1) + g1 * t1;
            { v4u w; w.x = pk2(h0[0], h0[1]); w.y = pk2(h0[2], h0[3]); w.z = pk2(h1[0], h1[1]); w.w = pk2(h1[2], h1[3]); *(v4u*)(tx + off) = w; }
            if (fout) { *(f32x4*)(fout + off) = h0; *(f32x4*)(fout + off + 4) = h1; }
            s2 += (h0[0] * h0[0] + h0[1] * h0[1]) + (h0[2] * h0[2] + h0[3] * h0[3]) + (h1[0] * h1[0] + h1[1] * h1[1]) + (h1[2] * h1[2] + h1[3] * h1[3]);
            if (bj == 1) {
                s2 += __shfl_xor(s2, 16); s2 += __shfl_xor(s2, 32);
                if (fq == 0) ssout[(size_t)r * 16 + u.pn * 4 + wc] = s2;
                s2 = 0.f;
            }
            asm volatile("" ::: "memory");
        }
    }
};

struct TSched {
    int c, c0, G;
    __device__ __forceinline__ bool next(int i, pg8::Unit& u) const { if (c < c0) return false; const int un = (c - c0) + i * (G - c0); if (un >= 256) return false; u.pm = un >> 2; u.pn = un & 3; return true; }
    __device__ __forceinline__ void a_ready(const pg8::Unit&) const {}
    __device__ __forceinline__ void done(const pg8::Unit&) const {}
};
__device__ __forceinline__ void tr_item(const float* W, int K, int N, bf16* WT, LAS float* scr, int item, int lane, const float* g, bool hperm) {
    const int nblk = N / 32, kb = item / nblk, nb = item % nblk, k0 = 64 * kb, n0 = 32 * nb;
    const int kr = lane >> 3, nq = (lane & 7) * 4;
    f32x4 v[8];
#pragma unroll
    for (int i = 0; i < 8; ++i) v[i] = *(const f32x4*)(W + (size_t)(k0 + 8 * i + kr) * N + n0 + nq);
    if (g) {
#pragma unroll
        for (int i = 0; i < 8; ++i) v[i] = v[i] * g[k0 + 8 * i + kr];
    }
#pragma unroll
    for (int i = 0; i < 8; ++i) { LAS float* d = scr + (8 * i + kr) * 33 + nq; d[0] = v[i][0]; d[1] = v[i][1]; d[2] = v[i][2]; d[3] = v[i][3]; }
    LDS_WAIT(); asm volatile("" ::: "memory");
    int d0 = n0; if (hperm) { const int gi = (n0 >> 5) & 7; d0 = (n0 & ~255) + 32 * (4 * (gi & 1) + (gi >> 1)); }
    const int c = lane & 7;
#pragma unroll
    for (int j = 0; j < 4; ++j) { const int n = (lane >> 3) + 8 * j; const LAS float* sp = scr + (8 * c) * 33 + n;
        v4u o; o.x = pk2(sp[0 * 33], sp[1 * 33]); o.y = pk2(sp[2 * 33], sp[3 * 33]); o.z = pk2(sp[4 * 33], sp[5 * 33]); o.w = pk2(sp[6 * 33], sp[7 * 33]);
        *(v4u*)(WT + (size_t)(d0 + n) * K + k0 + 8 * c) = o; }
    LDS_WAIT(); asm volatile("" ::: "memory");
}

__device__ __forceinline__ int crow(int r, int hf) { return (r & 3) + 8 * (r >> 2) + 4 * hf; }
__device__ __forceinline__ void attn_task(const bf16* Q, const bf16* K, const bf16* VT, bf16* Y, int b, int h, int qb, int lane) {
    const int t = lane & 31, hf = lane >> 5, q0 = qb * 32;
    const size_t hb = (size_t)(b * 8 + h) * 64;
    const bf16* qp = Q + ((hb + qb) * 4 * 64 + lane) * 8;
    bf16x8 qr[4];
#pragma unroll
    for (int kk = 0; kk < 4; ++kk) qr[kk] = *(const bf16x8*)(qp + kk * 512);
    const bf16* kbase = K + (hb * 4 * 64 + lane) * 8;
    const bf16* vbase = VT + (hb * 4 * 64 + lane) * 8;
    f32x16 o0, o1;
#pragma unroll
    for (int r = 0; r < 16; ++r) { o0[r] = 0.f; o1[r] = 0.f; }
    float carry = 1.f;
    bf16x8 kn[4], vn[4];
#pragma unroll
    for (int i = 0; i < 4; ++i) { kn[i] = *(const bf16x8*)(kbase + (size_t)qb * 2048 + i * 512); vn[i] = *(const bf16x8*)(vbase + (size_t)qb * 2048 + i * 512); }
    for (int j = qb; j >= 0; --j) {
        bf16x8 kf[4], vf[4];
#pragma unroll
        for (int i = 0; i < 4; ++i) { kf[i] = kn[i]; vf[i] = vn[i]; }
        { const int jn = j > 0 ? j - 1 : 0;
#pragma unroll
          for (int i = 0; i < 4; ++i) { kn[i] = *(const bf16x8*)(kbase + (size_t)jn * 2048 + i * 512); vn[i] = *(const bf16x8*)(vbase + (size_t)jn * 2048 + i * 512); } }
        f32x16 z;
#pragma unroll
        for (int r = 0; r < 16; ++r) z[r] = 0.f;
#pragma unroll
        for (int kk = 0; kk < 4; ++kk) z = __builtin_amdgcn_mfma_f32_32x32x16_bf16(kf[kk], qr[kk], z, 0, 0, 0);
        float om[16], w[16];
        const bool diag = (j == qb);
#pragma unroll
        for (int r = 0; r < 16; ++r) {
            const float e = __builtin_amdgcn_exp2f(fminf(z[r], 100.f));
            float o = __builtin_amdgcn_rcpf(1.f + e), bt = e * o;
            if (diag) { const bool valid = (16 * (r >> 3) + 8 * hf + (r & 7)) < t; o = valid ? o : 1.f; bt = valid ? bt : 0.f; }
            om[r] = o; w[r] = bt;
        }
        float R[2];
#pragma unroll
        for (int ks = 0; ks < 2; ++ks) {
            float x = om[8 * ks + 7];
#pragma unroll
            for (int jj = 6; jj >= 0; --jj) { w[8 * ks + jj] *= x; x *= om[8 * ks + jj]; }
            R[ks] = x;
        }
        const float Rp0 = __shfl_xor(R[0], 32), Rp1 = __shfl_xor(R[1], 32);
        const float T1 = R[1] * Rp1, T0 = R[0] * Rp0;
        const float L1 = hf ? carry : carry * Rp1;
        const float c0 = carry * T1, L0 = hf ? c0 : c0 * Rp0;
        carry = c0 * T0;
#pragma unroll
        for (int jj = 0; jj < 8; ++jj) { w[jj] *= L0; w[8 + jj] *= L1; }
#pragma unroll
        for (int ks = 0; ks < 2; ++ks) {
            v4u pw; pw.x = pk2(w[8 * ks], w[8 * ks + 1]); pw.y = pk2(w[8 * ks + 2], w[8 * ks + 3]); pw.z = pk2(w[8 * ks + 4], w[8 * ks + 5]); pw.w = pk2(w[8 * ks + 6], w[8 * ks + 7]);
            const bf16x8 pf = __builtin_bit_cast(bf16x8, pw);
            o0 = __builtin_amdgcn_mfma_f32_32x32x16_bf16(vf[ks], pf, o0, 0, 0, 0);
            o1 = __builtin_amdgcn_mfma_f32_32x32x16_bf16(vf[2 + ks], pf, o1, 0, 0, 0);
        }
#if ATT_EARLY_EXIT
        if (__all(carry == 0.f)) break;
#endif
    }
    bf16* yp = Y + (size_t)(b * SEQ + q0 + t) * DM + 256 + h * 64 + 4 * hf;
#pragma unroll
    for (int g = 0; g < 4; ++g) {
        v2u a; a.x = pk2(o0[4 * g], o0[4 * g + 1]); a.y = pk2(o0[4 * g + 2], o0[4 * g + 3]); *(v2u*)(yp + 8 * g) = a;
        v2u c; c.x = pk2(o1[4 * g], o1[4 * g + 1]); c.y = pk2(o1[4 * g + 2], o1[4 * g + 3]); *(v2u*)(yp + 32 + 8 * g) = c;
    }
}
__device__ __forceinline__ void sgu_task(const bf16* VNT, const bf16* WSB, const bf16* CU, const float* bias, bf16* Y, int task, int lane) {
    const int tb = task & 3, g = (task >> 2) & 3, c = (task >> 4) & 15, b = task >> 8;
    const int t = lane & 31, hf = lane >> 5;
    const bf16* ap = VNT + ((size_t)((b * 4 + g) * 16 + c) * 2 * 8 * 64 + lane) * 8;
    const bf16* bp = WSB + ((size_t)(g * 4 + tb) * 8 * 64 + lane) * 8;
    f32x16 a0, a1;
#pragma unroll
    for (int r = 0; r < 16; ++r) { a0[r] = 0.f; a1[r] = 0.f; }
    bf16x8 bfr[8], af0[8], af1[8];
#pragma unroll
    for (int ks = 0; ks < 8; ++ks) { bfr[ks] = *(const bf16x8*)(bp + 512 * ks); af0[ks] = *(const bf16x8*)(ap + 512 * ks); af1[ks] = *(const bf16x8*)(ap + 4096 + 512 * ks); }
#pragma unroll
    for (int ks = 0; ks < 8; ++ks) {
        a0 = __builtin_amdgcn_mfma_f32_32x32x16_bf16(af0[ks], bfr[ks], a0, 0, 0, 0);
        a1 = __builtin_amdgcn_mfma_f32_32x32x16_bf16(af1[ks], bfr[ks], a1, 0, 0, 0);
    }
    const int tok = b * SEQ + 128 * c + 32 * tb + t;
    const float bs = bias[g * 128 + 32 * tb + t];
    const bf16* up = CU + (size_t)tok * 256 + 64 * g + 4 * hf;
    bf16* yp = Y + (size_t)tok * DM + 768 + 64 * g + 4 * hf;
#pragma unroll
    for (int gg = 0; gg < 4; ++gg) {
        const v2u u0 = *(const v2u*)(up + 8 * gg), u1 = *(const v2u*)(up + 32 + 8 * gg);
        v2u a; a.x = pk2(bflo(u0.x) * (a0[4 * gg] + bs), bfhi(u0.x) * (a0[4 * gg + 1] + bs)); a.y = pk2(bflo(u0.y) * (a0[4 * gg + 2] + bs), bfhi(u0.y) * (a0[4 * gg + 3] + bs)); *(v2u*)(yp + 8 * gg) = a;
        v2u d; d.x = pk2(bflo(u1.x) * (a1[4 * gg] + bs), bfhi(u1.x) * (a1[4 * gg + 1] + bs)); d.y = pk2(bflo(u1.y) * (a1[4 * gg + 2] + bs), bfhi(u1.y) * (a1[4 * gg + 3] + bs)); *(v2u*)(yp + 32 + 8 * gg) = d;
    }
}
__device__ __forceinline__ void unpack8(const v4u w, float (&f)[8]) { f[0] = bflo(w.x); f[1] = bfhi(w.x); f[2] = bflo(w.y); f[3] = bfhi(w.y); f[4] = bflo(w.z); f[5] = bfhi(w.z); f[6] = bflo(w.w); f[7] = bfhi(w.w); }
__device__ __forceinline__ void conv_task(const bf16* CONV, const float* cwt, bf16* Y, int task, int lane) {
    const int ch = (lane & 31) * 8;
    float w0[8], w1[8], w2[8];
#pragma unroll
    for (int e = 0; e < 8; ++e) { w0[e] = cwt[ch + e]; w1[e] = cwt[256 + ch + e]; w2[e] = cwt[512 + ch + e]; }
    const bf16* ab = CONV; const bf16* ac = CONV + (size_t)M * 256; const bf16* ah = CONV + (size_t)2 * M * 256;
#pragma unroll 2
    for (int it = 0; it < 8; ++it) {
        const int tok = task * 16 + it * 2 + (lane >> 5), s = tok & (SEQ - 1);
        const size_t o = (size_t)tok * 256 + ch;
        float fb[8], c0[8], h0[8], c1[8], h1[8], c2[8], h2[8];
        unpack8(*(const v4u*)(ab + o), fb); unpack8(*(const v4u*)(ac + o), c0); unpack8(*(const v4u*)(ah + o), h0);
        const v4u zz = (v4u){0u, 0u, 0u, 0u};
        unpack8(s >= 1 ? *(const v4u*)(ac + o - 256) : zz, c1); unpack8(s >= 1 ? *(const v4u*)(ah + o - 256) : zz, h1);
        unpack8(s >= 2 ? *(const v4u*)(ac + o - 512) : zz, c2); unpack8(s >= 2 ? *(const v4u*)(ah + o - 512) : zz, h2);
        float y[8];
#pragma unroll
        for (int e = 0; e < 8; ++e) y[e] = fb[e] * (w2[e] * (c0[e] * h0[e]) + w1[e] * (c1[e] * h1[e]) + w0[e] * (c2[e] * h2[e]));
        v4u w; w.x = pk2(y[0], y[1]); w.y = pk2(y[2], y[3]); w.z = pk2(y[4], y[5]); w.w = pk2(y[6], y[7]);
        *(v4u*)(Y + (size_t)tok * DM + ch) = w;
    }
}

#define RLX_AGENT __ATOMIC_RELAXED, __HIP_MEMORY_SCOPE_AGENT
#define XB_TMO      128
#define XB_XCNT(j)  (256  + 64 * (j))
#define XB_XSUB(j)  (1280 + 64 * (j))
#define XB_XGEN(j)  (2304 + 64 * (j))
#define XB_TOP      3328
#define XB_TOPGEN   3392
#define XCD_BAR_WORDS 3456
#define XB_SPIN_CAP (1u << 18)

__device__ __forceinline__ unsigned xb_ld(unsigned* p)              { return __hip_atomic_load(p, __ATOMIC_RELAXED, __HIP_MEMORY_SCOPE_AGENT); }
__device__ __forceinline__ unsigned xb_add(unsigned* p, unsigned v) { return __hip_atomic_fetch_add(p, v, __ATOMIC_RELAXED, __HIP_MEMORY_SCOPE_AGENT); }
__device__ __forceinline__ unsigned xb_xcc_id() { return (unsigned)__builtin_amdgcn_s_getreg((3 << 11) | 20) & 0xFu; }
#define XB_SPIN(cond, bar) do { unsigned _sp = 0; while (cond) { __builtin_amdgcn_s_sleep(1); \
    if ((++_sp & 255u) == 0u) { if (xb_ld(&(bar)[XB_TMO])) break; if (_sp > XB_SPIN_CAP) { atomicAdd(&(bar)[XB_TMO], 1u); break; } } } } while (0)

struct XcdBarrier {
    unsigned* bar; unsigned x;
    volatile LAS unsigned* st;
};

__device__ __forceinline__ XcdBarrier xcd_barrier_post(unsigned* bar, volatile LAS unsigned* st) {
    XcdBarrier b; b.bar = bar; b.x = xb_xcc_id(); b.st = st;
    if (threadIdx.x == 0) (void)xb_add(&bar[XB_XCNT(b.x)], 1u);
    return b;
}
__device__ __forceinline__ void xcd_barrier_complete(unsigned* bar, unsigned x, unsigned& nloc, unsigned& nx) {
    const unsigned G = gridDim.x * gridDim.y * gridDim.z;
    unsigned sum, cnt, mine, sp = 0u;
    for (;;) {
        sum = 0u; cnt = 0u; mine = 0u;
#pragma unroll
        for (unsigned j = 0; j < 16; ++j) { const unsigned c = xb_ld(&bar[XB_XCNT(j)]); sum += c; cnt += (c > 0u) ? 1u : 0u; mine = (j == x) ? c : mine; }
        if (sum == G) break;
        __builtin_amdgcn_s_sleep(1);
        if ((++sp & 255u) == 0u) { if (xb_ld(&bar[XB_TMO])) break; if (sp > XB_SPIN_CAP) { atomicAdd(&bar[XB_TMO], 1u); break; } }
    }
    nloc = mine > 0u ? mine : 1u; nx = cnt > 0u ? cnt : 1u;
}

__device__ __forceinline__ void xcd_barrier(const XcdBarrier& b) {
    asm volatile("s_waitcnt vmcnt(0)" ::: "memory");
    __syncthreads();
    if (threadIdx.x == 0) {
        unsigned* bar = b.bar;
        __builtin_amdgcn_s_waitcnt(0);
        unsigned nloc = b.st[0], nx = b.st[1];
        if (nloc == 0u) { xcd_barrier_complete(bar, b.x, nloc, nx); b.st[0] = nloc; b.st[1] = nx; }
        const unsigned old = xb_add(&bar[XB_XSUB(b.x)], 1u);
        const unsigned gen = old / nloc;
        if (old + 1u == (gen + 1u) * nloc) {
            __builtin_amdgcn_fence(__ATOMIC_RELEASE, "agent");
            asm volatile("s_waitcnt vmcnt(0)" ::: "memory");
            const unsigned og = xb_add(&bar[XB_TOP], 1u);
            const unsigned tg = og / nx;
            if (og + 1u == (tg + 1u) * nx) xb_add(&bar[XB_TOPGEN], 1u);
            else XB_SPIN(xb_ld(&bar[XB_TOPGEN]) == tg, bar);
            __builtin_amdgcn_fence(__ATOMIC_ACQUIRE, "agent");
            xb_add(&bar[XB_XGEN(b.x)], 1u);
            asm volatile("s_waitcnt vmcnt(0)" ::: "memory");
        } else {
            XB_SPIN(xb_ld(&bar[XB_XGEN(b.x)]) == gen, bar);
            __builtin_amdgcn_fence(__ATOMIC_ACQUIRE, "agent");
            asm volatile("s_waitcnt vmcnt(0)" ::: "memory");
        }
    }
    __syncthreads();
}

struct Args { const float* in[17]; float* out; unsigned char* ws; int ph_lo, ph_hi; };
__global__ void __launch_bounds__(NWAVES * 64, 2) mk_fwd(Args a) {
    extern __shared__ __attribute__((aligned(16))) unsigned char lds_raw[];
    LAS unsigned char* lds = (LAS unsigned char*)lds_raw;
    const int tid = threadIdx.x, lane = tid & 63, wave = __builtin_amdgcn_readfirstlane(tid >> 6);
    const int G = gridDim.x; const int bx = blockIdx.x; const int vcu = (G % 8 == 0) ? (bx % 8) * (G / 8) + bx / 8 : bx;
    const int gw = vcu * NWAVES + wave, NGW = G * NWAVES;
    const int lo = a.ph_lo, hi = a.ph_hi;
    volatile LAS unsigned* bst = (volatile LAS unsigned*)(lds + RING_BYTES);
    if (tid < 4) bst[tid] = 0u;
    __syncthreads();
    XcdBarrier bar = xcd_barrier_post((unsigned*)(a.ws + WS_CTL), bst);
    unsigned char* ws = a.ws;
    const float* x = a.in[0]; const float* p = a.in[1];
    bf16* Wb = (bf16*)(ws + WS_W); bf16* WSBb = (bf16*)(ws + WS_WSB); float* SS = (float*)(ws + WS_SS);
    bf16* HB = (bf16*)(ws + WS_HB); bf16* LO = (bf16*)(ws + WS_LO); bf16* XB = (bf16*)(ws + WS_XB);
    bf16* PB = (bf16*)a.out;
    unsigned char* big = ws + WS_BIG;
    bf16* CONV = (bf16*)(big + B_CONV); bf16* Qb = (bf16*)(big + B_Q); bf16* Kb = (bf16*)(big + B_K); bf16* VTb = (bf16*)(big + B_VT); bf16* CUb = (bf16*)(big + B_CU);
    bf16* VNTb = (bf16*)(big + B_VNT); bf16* Yb = (bf16*)(big + B_Y); bf16* Fb = (bf16*)big;
    float* H = a.out;
#define IN(k) (lo <= (k) && (k) < hi)
#define SEAM(k) do { if (IN(k) && IN((k) + 1)) { if ((k) == 0) cg::this_grid().sync(); else { for (int sr_ = 0; sr_ < PROBE_SYNC; ++sr_) xcd_barrier(bar); } } } while (0)

    if (IN(0)) for (int rep_ = 0; rep_ < PROBE_P; ++rep_) {
        LAS float* scr = (LAS float*)(lds + wave * 16384);
        constexpr int I_IN = (DM / 64) * (NIN / 32), I_OUT = (DM / 64) * (DM / 32), I_1 = (DM / 64) * (DFF / 32), I_2 = (DFF / 64) * (DM / 32), I_G = I_OUT, I_P = (PLE / 64) * (DM / 32);
        constexpr int I_LAYER = I_IN + I_OUT + I_1 + I_2 + I_G + I_P;
        for (int it = gw; it < DEPTH * I_LAYER; it += NGW) {
            const int l = it / I_LAYER; int r = it % I_LAYER; bf16* wl = Wb + (size_t)l * E_WLAYER;
            if (r < I_IN) { tr_item(a.in[3] + (size_t)l * DM * NIN, DM, NIN, wl + E_WIN, scr, r, lane, a.in[2] + l * DM, true); continue; } r -= I_IN;
            if (r < I_OUT) { tr_item(a.in[10] + (size_t)l * DM * DM, DM, DM, wl + E_WOUT, scr, r, lane, nullptr, false); continue; } r -= I_OUT;
            if (r < I_1) { tr_item(a.in[12] + (size_t)l * DM * DFF, DM, DFF, wl + E_W1, scr, r, lane, a.in[11] + l * DM, false); continue; } r -= I_1;
            if (r < I_2) { tr_item(a.in[13] + (size_t)l * DFF * DM, DFF, DM, wl + E_W2, scr, r, lane, nullptr, false); continue; } r -= I_2;
            if (r < I_G) { tr_item(a.in[15] + (size_t)l * DM * DM, DM, DM, wl + E_WG, scr, r, lane, a.in[14] + l * DM, false); continue; } r -= I_G;
            tr_item(a.in[16] + (size_t)l * PLE * DM, PLE, DM, wl + E_WP, scr, r, lane, nullptr, false);
        }
        for (int i = gw * 64 + lane; i < DEPTH * 4 * 128 * 128; i += NGW * 64) {
            const int e8 = i & 7, ln = (i >> 3) & 63, ks = (i >> 9) & 7, tb = (i >> 12) & 3, lg = i >> 14; const int t = 32 * tb + (ln & 31), sk = 16 * ks + 8 * (ln >> 5) + e8;
            WSBb[i] = (bf16)f2bf(sk <= t ? a.in[8][((size_t)lg * 128 + t) * 128 + sk] : 0.f); }
        for (int m = gw; m < M; m += NGW) {
            const f32x4* xr = (const f32x4*)(x + (size_t)m * DM) + lane; f32x4 v[4]; float s = 0.f;
#pragma unroll
            for (int j = 0; j < 4; ++j) { v[j] = xr[64 * j]; s += (v[j].x * v[j].x + v[j].y * v[j].y) + (v[j].z * v[j].z + v[j].w * v[j].w); }
            s = wave_sum(s);
            v2u* o8 = (v2u*)(XB + (size_t)m * DM) + lane;
            v2u* l8 = (v2u*)(LO + (size_t)m * DM) + lane;
#pragma unroll
            for (int j = 0; j < 4; ++j) { v2u w; w.x = pk2(v[j].x, v[j].y); w.y = pk2(v[j].z, v[j].w); o8[64 * j] = w;
                v2u d; d.x = pk2(v[j].x - bflo(w.x), v[j].y - bfhi(w.x)); d.y = pk2(v[j].z - bflo(w.y), v[j].w - bfhi(w.y)); l8[64 * j] = d; }
            if (lane < 16) SS[(size_t)m * 16 + lane] = lane == 0 ? s : 0.f;
        }
        for (int it = gw; it < M * PLE / 512; it += NGW) { const size_t o = (size_t)it * 512 + lane * 8; const f32x4 u0 = *(const f32x4*)(p + o), u1 = *(const f32x4*)(p + o + 4);
            v4u w; w.x = pk2(u0.x, u0.y); w.y = pk2(u0.z, u0.w); w.z = pk2(u1.x, u1.y); w.w = pk2(u1.z, u1.w); *(v4u*)(PB + o) = w; }
        asm volatile("s_waitcnt vmcnt(0) lgkmcnt(0)" ::: "memory"); __syncthreads();
    }
    SEAM(0);

    for (int l = 0; l < DEPTH; ++l) {
        const int pb = 1 + 6 * l;
        const bf16* wl = Wb + (size_t)l * E_WLAYER;
        bf16* bufX = (l & 1) ? HB : XB; bf16* bufT = (l & 1) ? XB : HB;
        float* ss1 = SS; float* ss2 = SS + (size_t)M * 16; float* ss3 = SS + (size_t)2 * M * 16; float* ss1n = ss1;
        if (IN(pb)) for (int rep_ = 0; rep_ < PROBE_A; ++rep_) {
#ifndef NO_A
            { pg8::Gemm g{bufX, wl + E_WIN, M, NIN, DM}; pg8::StaticOrder S; S.init(M, NIN, G, bx);
              EpiInProj E{ss1, CONV, Qb, Kb, VTb, CUb, VNTb, a.in[5] + l * 64, a.in[6] + l * 64, a.in[7] + l * 256};
              pg8::gemm_phase<EpiInProj, pg8::StaticOrder, true, true>(lds, g, S, E); }
            { int kp = PLE; asm volatile("" : "+s"(kp)); pg8::Gemm g{PB, wl + E_WP, M, DM, kp}; TSched S{bx, (M / 256 * (NIN / 256)) % G, G};
              EpiT E{bufT};
              pg8::gemm_phase<EpiT, TSched, true, true>(lds, g, S, E); }
#endif
        }
        SEAM(pb);
        if (IN(pb + 1)) for (int rep_ = 0; rep_ < PROBE_B; ++rep_) {
            int lane_ = lane; asm volatile("" : "+v"(lane_));
#ifndef NO_ATT
            for (int pr = gw; pr < 2048; pr += NGW) { const int bh = pr >> 5, i = pr & 31;
                attn_task(Qb, Kb, VTb, Yb, bh >> 3, bh & 7, 63 - i, lane_);
                attn_task(Qb, Kb, VTb, Yb, bh >> 3, bh & 7, i, lane_); }
#endif
#ifndef NO_SGU
            for (int tk = gw; tk < 2048; tk += NGW) sgu_task(VNTb, WSBb + (size_t)l * 4 * 128 * 128, CUb, a.in[9] + l * 512, Yb, tk, lane_);
#endif
#ifndef NO_CONV
            for (int tk = gw; tk < 1024; tk += NGW) conv_task(CONV, a.in[4] + l * 768, Yb, tk, lane_);
#endif
            const float* pl = p + (size_t)(l + 1 < DEPTH ? l + 1 : l) * M * PLE;
#pragma unroll 4
            for (int it = gw; it < M * PLE / 512; it += NGW) { const size_t o = (size_t)it * 512 + lane_ * 8; const f32x4 u0 = *(const f32x4*)(pl + o), u1 = *(const f32x4*)(pl + o + 4);
                v4u w; w.x = pk2(u0.x, u0.y); w.y = pk2(u0.z, u0.w); w.z = pk2(u1.x, u1.y); w.w = pk2(u1.z, u1.w); *(v4u*)(PB + o) = w; }
            asm volatile("s_waitcnt vmcnt(0) lgkmcnt(0)" ::: "memory"); __syncthreads();
        }
        SEAM(pb + 1);
        if (IN(pb + 2)) {
#ifndef NO_C
#ifndef NO_O
            { pg8::Gemm g{Yb, wl + E_WOUT, M, DM, DM}; pg8::StaticOrder S; S.init(M, DM, G, bx);
              EpiRes E{bufX, LO, ss2, l == 0 ? 1 : 0, 0};
              pg8::gemm_phase<EpiRes, pg8::StaticOrder, true, true>(lds, g, S, E); }
#endif
#endif
        }
        SEAM(pb + 2);
        if (IN(pb + 3)) for (int rep_ = 0; rep_ < PROBE_D; ++rep_) {
#ifndef NO_D
            pg8::Gemm g{bufX, wl + E_W1, M, DFF, DM}; pg8::StaticOrder S; S.init(M, DFF, G, bx);
            EpiFF1 E{ss2, Fb};
            pg8::gemm_phase<EpiFF1, pg8::StaticOrder, true, true>(lds, g, S, E);
#endif
        }
        SEAM(pb + 3);
        if (IN(pb + 4)) {
#ifndef NO_E
            pg8::Gemm g{Fb, wl + E_W2, M, DM, DFF}; pg8::StaticOrder S; S.init(M, DM, G, bx);
            EpiRes E{bufX, LO, ss3, 0, 1};
            pg8::gemm_phase<EpiRes, pg8::StaticOrder, true, true>(lds, g, S, E);
#endif
        }
        SEAM(pb + 4);
        if (IN(pb + 5)) {
#ifndef NO_F
            pg8::Gemm g{bufX, wl + E_WG, M, DM, DM}; pg8::StaticOrder S; S.init(M, DM, G, bx);
            EpiGate E{ss3, bufX, LO, bufT, ss1n, l == DEPTH - 1 ? H : (float*)nullptr};
            pg8::gemm_phase<EpiGate, pg8::StaticOrder, true, true>(lds, g, S, E);
#endif
        }
        SEAM(pb + 5);
    }
#undef IN
#undef SEAM
}

extern "C" void kernel_launch(void* const* d_in, const int* in_sizes, int n_in, void* d_out, int out_size, void* d_ws, size_t ws_size, hipStream_t stream) {
    static int grid = 0;
    if (grid == 0) {
        if (n_in != 17 || in_sizes[0] != M * DM || out_size != M * DM || ws_size < WS_TOTAL) { fprintf(stderr, "kernel_launch: unexpected shapes (n_in %d, in0 %d, out %d, ws %zu, need %zu)\n", n_in, n_in > 0 ? in_sizes[0] : -1, out_size, ws_size, (size_t)WS_TOTAL); grid = -1; return; }
        int dev = 0, cus = 0, per_cu = 0;
        hipGetDevice(&dev); hipDeviceGetAttribute(&cus, hipDeviceAttributeMultiprocessorCount, dev);
        if (hipFuncSetAttribute((const void*)mk_fwd, hipFuncAttributeMaxDynamicSharedMemorySize, LDS_BYTES) != hipSuccess) { fprintf(stderr, "kernel_launch: hipFuncSetAttribute failed\n"); grid = -1; return; }
        if (hipOccupancyMaxActiveBlocksPerMultiprocessor(&per_cu, (const void*)mk_fwd, NWAVES * 64, LDS_BYTES) != hipSuccess || per_cu < 1) { fprintf(stderr, "kernel_launch: occupancy query says %d\n", per_cu); per_cu = 1; }
        (void)hipGetLastError();
        grid = cus * 1;
    }
    if (grid < 0) return;
#ifdef DBG_MEMSET
    (void)hipMemsetAsync(d_ws, 0xAA, WS_END, stream); (void)hipMemsetAsync(d_out, 0xAA, (size_t)M * DM * 4, stream);
#endif
    if (hipMemsetAsync((char*)d_ws + WS_CTL, 0, CTL_BYTES, stream) != hipSuccess) { fprintf(stderr, "kernel_launch: memset of the barrier words failed\n"); return; }
    Args a{};
    for (int i = 0; i < 17; ++i) a.in[i] = (const float*)d_in[i];
    a.out = (float*)d_out; a.ws = (unsigned char*)d_ws;
#if MK_N_LAUNCHES == 1
    a.ph_lo = 0; a.ph_hi = NPHASE;
    void* args[] = {&a};
    hipError_t e = hipLaunchCooperativeKernel((const void*)mk_fwd, dim3(grid), dim3(NWAVES * 64), args, LDS_BYTES, stream);
    if (e != hipSuccess) fprintf(stderr, "cooperative launch failed: %s (grid %d)\n", hipGetErrorString(e), grid);
#else
    for (int ph = 0; ph < NPHASE; ++ph) { a.ph_lo = ph; a.ph_hi = ph + 1; hipLaunchKernelGGL(mk_fwd, dim3(grid), dim3(NWAVES * 64), LDS_BYTES, stream, a); }
#endif
}
```

```cpp
#include <hip/hip_runtime.h>
#include <hip/hip_cooperative_groups.h>
#include <cstdio>
#include <cstdint>
namespace cg = cooperative_groups;
namespace pg8 {
#define PG8_LAS __attribute__((address_space(3)))
typedef unsigned short bf16_t;
typedef short bf16x8 __attribute__((ext_vector_type(8)));
typedef float f32x4 __attribute__((ext_vector_type(4)));
typedef unsigned u32x4 __attribute__((ext_vector_type(4)));
constexpr int BM = 256, BK = 64, HALF = 128, HTB = HALF * BK * 2  , STAGE_BYTES = 8 * HTB, NXCD = 8, WGM = 8;

__host__ __device__ __forceinline__ int lds_byte(int r, int c) { const int st = (r >> 4) * 2 + (c >> 5), rr = r & 15, cc = c & 31, ob = rr * 64 + cc * 2; return st * 1024 + (ob ^ (((ob >> 9) & 1) << 5)); }
__host__ __device__ __forceinline__ void stage_rc(int b, int& R, int& C) { const int st = b / 1024, sb = b % 1024, swz = sb ^ (((sb >> 9) & 1) << 5); R = (st >> 1) * 16 + swz / 64; C = (st & 1) * 32 + (swz % 64) / 2; }
__host__ __device__ __forceinline__ int perm32(int rho) { const int n = rho >> 4, i = rho & 15; return 8 * (i >> 2) + 4 * n + (i & 3); }

struct Unit { int pm, pn; };
struct Gemm { const bf16_t* A; const bf16_t* Bt; int M, N, K; };

struct StaticOrder {
    int nM, nN, nwg, G, c;
    __host__ __device__ void init(int M, int N, int G_, int c_) { nM = M / BM; nN = N / BM; nwg = nM * nN; G = G_; c = c_; }
    __host__ __device__ bool next(int i, Unit& u) const {
        const long L = (long)i * G + c; if (L >= nwg) return false;
        int wgid = (int)L; { const int q = nwg / NXCD, r = nwg % NXCD, xcd = wgid % NXCD, off = wgid / NXCD; wgid = (xcd < r ? xcd * (q + 1) : r * (q + 1) + (xcd - r) * q) + off; }
        const int nig = WGM * nN, gid = wgid / nig, fm = gid * WGM, gsz = (nM - fm) < WGM ? (nM - fm) : WGM;
        u.pm = fm + ((wgid % nig) % gsz); u.pn = (wgid % nig) / gsz; return true;
    }
    __device__ __forceinline__ void a_ready(const Unit&) const {}
    __device__ __forceinline__ void done(const Unit&) const {}
};

__device__ __forceinline__ unsigned cvt_pk_bf16(float lo, float hi) { unsigned r; asm volatile("v_cvt_pk_bf16_f32 %0, %1, %2" : "=v"(r) : "v"(lo), "v"(hi)); return r; }
typedef float f32x2 __attribute__((ext_vector_type(2)));
__device__ __forceinline__ f32x2 gelu_pk(f32x2 v) {
    const f32x2 av = __builtin_elementwise_abs(v), d = av * 0.2316418882f + 1.0f;
    f32x2 t; t.x = __builtin_amdgcn_rcpf(d.x); t.y = __builtin_amdgcn_rcpf(d.y);
    f32x2 q = t * 0.5307027145f + (-0.7265760135f); q = q * t + 0.7107068705f; q = q * t + (-0.142248368f); q = q * t + 0.127414796f; q = q * t;
    const f32x2 s = (v * v) * (-0.72134752044f);
    f32x2 e; e.x = __builtin_amdgcn_exp2f(s.x); e.y = __builtin_amdgcn_exp2f(s.y);
    const f32x2 m = v * (q * e), r = v - m;
    f32x2 o; o.x = v.x < 0.f ? m.x : r.x; o.y = v.y < 0.f ? m.y : r.y; return o;
}

template <int ACT  > struct EpiBf16 {
    static constexpr bool PERM = true, AFTER_DRAIN = false; static_assert(ACT == 0 || ACT == 1, "EpiBf16: ACT is 0 (none) or 1 (gelu_pk)");
    bf16_t* O; int ldc; const float* bias; int split_cols; size_t split_stride; float scale0;
    __device__ __forceinline__ void operator()(const f32x4 (&acc)[2][2][4][2], const Unit& u, int wr, int wc, int fr, int fq) const {
        const int row0 = u.pm * BM + wr * 64 + fr; int colt = u.pn * BM; bf16_t* base = O;
        float sc = 1.f; if (split_cols) { const int t = colt / split_cols; base += (size_t)t * split_stride; colt -= t * split_cols; if (t == 0) sc = scale0; }
        const int col0 = colt + wc * 32 + 8 * fq, bcol0 = u.pn * BM + wc * 32 + 8 * fq;
        f32x4 bv[2][2];
#pragma unroll
        for (int bj = 0; bj < 2; ++bj)
#pragma unroll
            for (int n = 0; n < 2; ++n) bv[bj][n] = bias ? *(const f32x4*)(bias + bcol0 + bj * HALF + 4 * n) : (f32x4){0.f, 0.f, 0.f, 0.f};
#pragma unroll
        for (int ai = 0; ai < 2; ++ai)
#pragma unroll
            for (int m = 0; m < 4; ++m) { bf16_t* rowp = base + (size_t)(row0 + ai * HALF + m * 16) * ldc + col0;
#pragma unroll
                for (int bj = 0; bj < 2; ++bj) { f32x4 v0 = acc[ai][bj][m][0] + bv[bj][0], v1 = acc[ai][bj][m][1] + bv[bj][1];
                    if (ACT == 1) { f32x2 a = gelu_pk((f32x2){v0[0], v0[1]}), b = gelu_pk((f32x2){v0[2], v0[3]}), c = gelu_pk((f32x2){v1[0], v1[1]}), d = gelu_pk((f32x2){v1[2], v1[3]});
                        v0 = (f32x4){a.x, a.y, b.x, b.y}; v1 = (f32x4){c.x, c.y, d.x, d.y}; }
                    v0 = v0 * sc; v1 = v1 * sc; u32x4 w; w.x = cvt_pk_bf16(v0[0], v0[1]); w.y = cvt_pk_bf16(v0[2], v0[3]); w.z = cvt_pk_bf16(v1[0], v1[1]); w.w = cvt_pk_bf16(v1[2], v1[3]);
                    *(u32x4*)(rowp + bj * HALF) = w; } }
    }
};
template <class Epi, class Sched, bool ALIGN_EPI = false, bool SP2 = false>
__device__ __forceinline__ void gemm_phase(PG8_LAS unsigned char* lds, const Gemm g, const Sched& S, const Epi& E) {
    int tid_ = threadIdx.x; asm volatile("" : "+v"(tid_));
    const int tid = tid_, wid = __builtin_amdgcn_readfirstlane(tid >> 6), lane = tid & 63, wr = wid >> 2, wc = wid & 3, fr = lane & 15, fq = lane >> 4;
    const int K = g.K, nt = K / BK;
    unsigned voffA[2], voffB[2];
#pragma unroll
    for (int i = 0; i < 2; ++i) { int R, C; stage_rc(tid * 16 + i * 8192, R, C); const int Rb = Epi::PERM ? ((R & ~31) + perm32(R & 31)) : R;
        voffA[i] = (unsigned)(R * K + C) * 2u; voffB[i] = (unsigned)(Rb * K + C) * 2u; }
    const size_t kstep = (size_t)(BK * 2);
    const size_t hstep = (size_t)HALF * K * 2;
    const size_t tstep = 2 * hstep;
    const unsigned ldsw = (unsigned)wid * 1024u;
    const int aoff = lds_byte(wr * 64 + fr, fq * 8), boff = lds_byte(wc * 32 + fr, fq * 8);
#define PG8_SA(b, h) (((b) * 2 + (h)) * HTB)
#define PG8_SB(b, h) ((4 + (b) * 2 + (h)) * HTB)
#define PG8_STAGE(bufoff, gbase, voff) do { _Pragma("unroll") for (int _i = 0; _i < 2; ++_i) \
        __builtin_amdgcn_global_load_lds((const unsigned*)((const char*)(gbase) + (voff)[_i]), (PG8_LAS unsigned*)(lds + (bufoff) + ldsw + _i * 8192), 16, 0, 0); } while (0)
#define PG8_LDA(dst, b, h) do { _Pragma("unroll") for (int m = 0; m < 4; ++m) _Pragma("unroll") for (int k = 0; k < 2; ++k) dst[m][k] = *(const PG8_LAS bf16x8*)(lds + PG8_SA(b, h) + aoff + m * 2048 + k * 1024); } while (0)
#define PG8_LDB(dst, b, h) do { _Pragma("unroll") for (int n = 0; n < 2; ++n) _Pragma("unroll") for (int k = 0; k < 2; ++k) dst[n][k] = *(const PG8_LAS bf16x8*)(lds + PG8_SB(b, h) + boff + n * 2048 + k * 1024); } while (0)
#define PG8_MMA(ai, bj, At, Bt) do { __builtin_amdgcn_s_setprio(1); _Pragma("unroll") for (int m = 0; m < 4; ++m) _Pragma("unroll") for (int n = 0; n < 2; ++n) _Pragma("unroll") for (int k = 0; k < 2; ++k) \
        acc[ai][bj][m][n] = __builtin_amdgcn_mfma_f32_16x16x32_bf16(Bt[n][k], At[m][k], acc[ai][bj][m][n], 0, 0, 0); __builtin_amdgcn_s_setprio(0); } while (0)
#define PG8_WAIT_V(n) asm volatile("s_waitcnt vmcnt(" #n ")" ::: "memory")
#define PG8_WAIT_L(n) asm volatile("s_waitcnt lgkmcnt(" #n ")" ::: "memory")
#define PG8_BAR __builtin_amdgcn_s_barrier()
#define PG8_SCHED __builtin_amdgcn_sched_barrier(0)
    Unit cur, nxt; int ui = 0;
    if (!S.next(0, cur)) return;
    f32x4 acc[2][2][4][2];
#pragma unroll
    for (int a = 0; a < 2; ++a)
#pragma unroll
        for (int b = 0; b < 2; ++b)
#pragma unroll
            for (int m = 0; m < 4; ++m)
#pragma unroll
                for (int n = 0; n < 2; ++n) acc[a][b][m][n] = (f32x4){0.f, 0.f, 0.f, 0.f};
    bf16x8 At[4][2], B0[2][2], B1[2][2];
    const char* cA = (const char*)g.A + (size_t)cur.pm * tstep; const char* cB = (const char*)g.Bt + (size_t)cur.pn * tstep;
    S.a_ready(cur);
    if constexpr (SP2) {
        PG8_STAGE(PG8_SB(0, 0), cB, voffB); PG8_STAGE(PG8_SB(0, 1), cB + hstep, voffB); PG8_STAGE(PG8_SA(0, 0), cA, voffA); PG8_STAGE(PG8_SA(0, 1), cA + hstep, voffA);
        if (wr == 1) PG8_BAR;
        PG8_WAIT_V(2); PG8_BAR;
        PG8_STAGE(PG8_SB(1, 0), cB + kstep, voffB); PG8_STAGE(PG8_SA(1, 0), cA + kstep, voffA); PG8_STAGE(PG8_SB(1, 1), cB + hstep + kstep, voffB);
        PG8_WAIT_V(6); PG8_BAR;
    } else {
        PG8_STAGE(PG8_SB(0, 0), cB, voffB); PG8_STAGE(PG8_SA(0, 0), cA, voffA); PG8_STAGE(PG8_SB(0, 1), cB + hstep, voffB); PG8_STAGE(PG8_SA(0, 1), cA + hstep, voffA);
        if (wr == 1) PG8_BAR;
        PG8_WAIT_V(4); PG8_BAR;
        PG8_STAGE(PG8_SB(1, 0), cB + kstep, voffB); PG8_STAGE(PG8_SA(1, 0), cA + kstep, voffA); PG8_STAGE(PG8_SB(1, 1), cB + hstep + kstep, voffB);
        PG8_WAIT_V(6); PG8_BAR;
    }
    for (;;) {
        const bool has_next = S.next(ui + 1, nxt);
        const char* nA = has_next ? (const char*)g.A + (size_t)nxt.pm * tstep : cA; const char* nB = has_next ? (const char*)g.Bt + (size_t)nxt.pn * tstep : cB;
        for (int t = 0; t < nt; t += 2) {
            const bool last = (t == nt - 2);
            const char* a1 = cA + (size_t)(t + 1) * kstep;
            const char* a2 = last ? nA : cA + (size_t)(t + 2) * kstep; const char* b2 = last ? nB : cB + (size_t)(t + 2) * kstep;
            const char* a3 = a2 + kstep; const char* b3 = b2 + kstep;
            if (last && has_next) S.a_ready(nxt);
            if constexpr (SP2) {
            PG8_LDB(B0, 0, 0); PG8_LDB(B1, 0, 1); PG8_SCHED; PG8_LDA(At, 0, 0); PG8_STAGE(PG8_SA(1, 1), a1 + hstep, voffA);
            PG8_WAIT_V(8); PG8_WAIT_L(0); PG8_BAR; PG8_MMA(0, 0, At, B0); PG8_MMA(0, 1, At, B1); PG8_BAR; PG8_SCHED;
            PG8_LDA(At, 0, 1); PG8_STAGE(PG8_SB(0, 0), b2, voffB); PG8_STAGE(PG8_SB(0, 1), b2 + hstep, voffB); PG8_STAGE(PG8_SA(0, 0), a2, voffA);
            PG8_WAIT_V(8); PG8_WAIT_L(0); PG8_BAR; PG8_MMA(1, 0, At, B0); PG8_MMA(1, 1, At, B1); PG8_BAR; PG8_SCHED;
            PG8_LDB(B0, 1, 0); PG8_LDB(B1, 1, 1); PG8_SCHED; PG8_LDA(At, 1, 0); PG8_STAGE(PG8_SA(0, 1), a2 + hstep, voffA);
            PG8_WAIT_V(8); PG8_WAIT_L(0); PG8_BAR; PG8_MMA(0, 0, At, B0); PG8_MMA(0, 1, At, B1); PG8_BAR; PG8_SCHED;
            PG8_LDA(At, 1, 1); PG8_STAGE(PG8_SB(1, 0), b3, voffB); PG8_STAGE(PG8_SB(1, 1), b3 + hstep, voffB); PG8_STAGE(PG8_SA(1, 0), a3, voffA);
            PG8_WAIT_V(8); PG8_WAIT_L(0); PG8_BAR; PG8_MMA(1, 0, At, B0); PG8_MMA(1, 1, At, B1); PG8_BAR; PG8_SCHED;
            } else {
            PG8_LDB(B0, 0, 0); PG8_SCHED; PG8_LDA(At, 0, 0); PG8_STAGE(PG8_SA(1, 1), a1 + hstep, voffA);
            PG8_WAIT_L(8); PG8_BAR; PG8_WAIT_L(0); PG8_MMA(0, 0, At, B0); PG8_BAR; PG8_SCHED;
            PG8_LDB(B1, 0, 1); PG8_STAGE(PG8_SB(0, 0), b2, voffB);
            PG8_BAR; PG8_WAIT_L(0); PG8_MMA(0, 1, At, B1); PG8_BAR;
            PG8_LDA(At, 0, 1); PG8_STAGE(PG8_SA(0, 0), a2, voffA);
            PG8_BAR; PG8_WAIT_L(0); PG8_MMA(1, 0, At, B0); PG8_BAR; PG8_SCHED;
            PG8_STAGE(PG8_SB(0, 1), b2 + hstep, voffB);
            PG8_WAIT_V(6); PG8_BAR; PG8_MMA(1, 1, At, B1); PG8_BAR;
            PG8_LDB(B0, 1, 0); PG8_SCHED; PG8_LDA(At, 1, 0); PG8_STAGE(PG8_SA(0, 1), a2 + hstep, voffA);
            PG8_WAIT_L(8); PG8_BAR; PG8_WAIT_L(0); PG8_MMA(0, 0, At, B0); PG8_BAR; PG8_SCHED;
            PG8_LDB(B1, 1, 1); PG8_STAGE(PG8_SB(1, 0), b3, voffB);
            PG8_BAR; PG8_WAIT_L(0); PG8_MMA(0, 1, At, B1); PG8_BAR;
            PG8_LDA(At, 1, 1); PG8_STAGE(PG8_SA(1, 0), a3, voffA);
            PG8_BAR; PG8_WAIT_L(0); PG8_MMA(1, 0, At, B0); PG8_BAR; PG8_SCHED;
            PG8_STAGE(PG8_SB(1, 1), b3 + hstep, voffB);
            PG8_WAIT_V(6); PG8_BAR; PG8_MMA(1, 1, At, B1); PG8_BAR;
            }
        }
        if constexpr (ALIGN_EPI) { if (wr == 0) PG8_BAR; }
        if constexpr (!Epi::AFTER_DRAIN) { E(acc, cur, wr, wc, fr, fq); S.done(cur); }
        if (!has_next) break;
#pragma unroll
        for (int a = 0; a < 2; ++a)
#pragma unroll
            for (int b = 0; b < 2; ++b)
#pragma unroll
                for (int m = 0; m < 4; ++m)
#pragma unroll
                    for (int n = 0; n < 2; ++n) acc[a][b][m][n] = (f32x4){0.f, 0.f, 0.f, 0.f};
        cur = nxt; cA = nA; cB = nB; ++ui;
        if constexpr (ALIGN_EPI) { if (wr == 1) PG8_BAR; }
    }
    PG8_WAIT_V(0);
    if constexpr (!ALIGN_EPI) { if (wr == 0) PG8_BAR; }
    PG8_BAR;
    if constexpr (Epi::AFTER_DRAIN) { E.fused(acc, cur, wr, wc, fr, fq, lds, wid, lane); S.done(cur); }
#undef PG8_SA
#undef PG8_SB
#undef PG8_STAGE
#undef PG8_LDA
#undef PG8_LDB
#undef PG8_MMA
#undef PG8_WAIT_V
#undef PG8_WAIT_L
#undef PG8_BAR
#undef PG8_SCHED
}
}

#ifndef MK_N_LAUNCHES
#define MK_N_LAUNCHES 1
#endif
#ifndef ATT_EARLY_EXIT
#define ATT_EARLY_EXIT 1
#endif
constexpr int NWAVES = 8;
constexpr int M = 16384, DM = 1024, SEQ = 2048, DEPTH = 4, NIN = 2816, DFF = 4096, PLE = 256;
constexpr float EPS = 1e-6f;
constexpr float C2 = 0.125f * 1.4426950408889634f;
constexpr int NPHASE = 1 + 6 * DEPTH;
#ifndef PROBE_B
#define PROBE_B 1
#endif
#ifndef PROBE_SYNC
#define PROBE_SYNC 1
#endif
#ifndef PROBE_P
#define PROBE_P 1
#endif
#ifndef PROBE_A
#define PROBE_A 1
#endif
#ifndef PROBE_D
#define PROBE_D 1
#endif

typedef unsigned short bf16;
#define LAS __attribute__((address_space(3)))
typedef unsigned v4u __attribute__((ext_vector_type(4)));
typedef unsigned v2u __attribute__((ext_vector_type(2)));
typedef float f32x4 __attribute__((ext_vector_type(4)));
typedef float f32x2 __attribute__((ext_vector_type(2)));
typedef float f32x16 __attribute__((ext_vector_type(16)));
typedef short bf16x8 __attribute__((ext_vector_type(8)));
typedef short s16x4 __attribute__((ext_vector_type(4)));
#define LDS_WAIT() asm volatile("s_waitcnt lgkmcnt(0)" ::: "memory")

constexpr size_t E_WIN = 0, E_WOUT = (size_t)NIN * DM, E_W1 = E_WOUT + (size_t)DM * DM, E_W2 = E_W1 + (size_t)DFF * DM, E_WG = E_W2 + (size_t)DFF * DM, E_WP = E_WG + (size_t)DM * DM,
                 E_WLAYER = E_WP + (size_t)PLE * DM;
constexpr size_t WS_W = 0, WS_WSB = WS_W + (size_t)DEPTH * E_WLAYER * 2, WS_SS = WS_WSB + (size_t)DEPTH * 4 * 128 * 128 * 2, WS_HB = WS_SS + (size_t)3 * M * 16 * 4,
                 WS_LO = WS_HB + (size_t)M * DM * 2, WS_XB = WS_LO + (size_t)M * DM * 2, WS_BIG = WS_XB + (size_t)M * DM * 2, WS_END = WS_BIG + (size_t)M * DFF * 2;
constexpr size_t B_CONV = 0, B_Q = B_CONV + (size_t)3 * M * 256 * 2, B_K = B_Q + (size_t)M * 512 * 2, B_VT = B_K + (size_t)M * 512 * 2, B_CU = B_VT + (size_t)M * 512 * 2,
                 B_VNT = B_CU + (size_t)M * 256 * 2, B_Y = B_VNT + (size_t)M * 256 * 2, B_ENDMIX = B_Y + (size_t)M * DM * 2;
static_assert(B_ENDMIX <= (size_t)M * DFF * 2, "mixer tensors fit under the F overlay");
constexpr size_t WS_CTL = WS_END, CTL_BYTES = 32768, WS_TOTAL = WS_CTL + CTL_BYTES;
constexpr int RING_BYTES = 131072, LDS_BYTES = 132096;

__device__ __forceinline__ unsigned f2bf(float f) { unsigned u = __builtin_bit_cast(unsigned, f); return (u + 0x7fffu + ((u >> 16) & 1u)) >> 16; }
typedef __bf16 bf16x2_t __attribute__((ext_vector_type(2)));
__device__ __forceinline__ unsigned pk2(float lo, float hi) { f32x2 v = {lo, hi}; bf16x2_t b = __builtin_convertvector(v, bf16x2_t); return __builtin_bit_cast(unsigned, b); }
__device__ __forceinline__ float bflo(unsigned u) { return __builtin_bit_cast(float, u << 16); }
__device__ __forceinline__ float bfhi(unsigned u) { return __builtin_bit_cast(float, u & 0xffff0000u); }
__device__ __forceinline__ float wave_sum(float v) {
#pragma unroll
    for (int o = 1; o < 64; o <<= 1) v += __shfl_xor(v, o);
    return v;
}

__device__ __forceinline__ float row_rs(const float* ssp, int r) {
    const f32x4* q = (const f32x4*)(ssp + (size_t)r * 16); const f32x4 a = q[0], b = q[1], c = q[2], d = q[3];
    const float s = ((a[0] + a[1]) + (a[2] + a[3])) + ((b[0] + b[1]) + (b[2] + b[3])) + ((c[0] + c[1]) + (c[2] + c[3])) + ((d[0] + d[1]) + (d[2] + d[3]));
    return rsqrtf(s * (1.f / 1024.f) + EPS);
}
struct EpiInProj {
    static constexpr bool PERM = true, AFTER_DRAIN = false;
    const float* ss; bf16* conv; bf16* q; bf16* k; bf16* vt; bf16* cu; bf16* vnt; const float* qg; const float* kg; const float* sg;
    __device__ __forceinline__ void operator()(const pg8::f32x4 (&acc)[2][2][4][2], const pg8::Unit& u, int wr, int wc, int fr, int fq) const {
        const int sec = u.pn;
        const int row0 = u.pm * 256 + wr * 64 + fr;
        const int cw = 64 * wc + 8 * fq;
        const bool normed = (sec >= 3 && sec < 7) || sec == 10;
        float rsv[8];
#pragma unroll
        for (int g = 0; g < 8; ++g) { rsv[g] = row_rs(ss, row0 + (g >> 2) * 128 + (g & 3) * 16); if (g & 1) asm volatile("" : "+v"(rsv[g - 1]), "+v"(rsv[g]) :: "memory"); }
        f32x4 gv[2][2];
#pragma unroll
        for (int bj = 0; bj < 2; ++bj)
#pragma unroll
            for (int n = 0; n < 2; ++n) {
                if (sec >= 3 && sec < 7) { const float* g = sec < 5 ? qg : kg; const float sc = sec < 5 ? C2 : 1.f; gv[bj][n] = *(const f32x4*)(g + 32 * bj + 8 * fq + 4 * n) * sc; }
                else if (sec == 10) gv[bj][n] = *(const f32x4*)(sg + cw + 32 * bj + 4 * n);
                else gv[bj][n] = (f32x4){1.f, 1.f, 1.f, 1.f};
            }
#pragma unroll
        for (int ai = 0; ai < 2; ++ai)
#pragma unroll
            for (int m = 0; m < 4; ++m) {
                const int r = row0 + ai * 128 + m * 16;
                const float rs = rsv[ai * 4 + m];
                f32x4 v[2][2];
#pragma unroll
                for (int bj = 0; bj < 2; ++bj)
#pragma unroll
                    for (int n = 0; n < 2; ++n) v[bj][n] = acc[ai][bj][m][n] * rs;
                if (sec >= 9) {
#pragma unroll
                    for (int bj = 0; bj < 2; ++bj)
#pragma unroll
                        for (int n = 0; n < 2; ++n) { const pg8::f32x2 a = pg8::gelu_pk((pg8::f32x2){v[bj][n][0], v[bj][n][1]}), b = pg8::gelu_pk((pg8::f32x2){v[bj][n][2], v[bj][n][3]}); v[bj][n] = (f32x4){a.x, a.y, b.x, b.y}; }
                }
                if (normed) {
                    float s2 = 0.f;
#pragma unroll
                    for (int bj = 0; bj < 2; ++bj)
#pragma unroll
                        for (int n = 0; n < 2; ++n) { const f32x4 x = v[bj][n]; s2 += (x[0] * x[0] + x[1] * x[1]) + (x[2] * x[2] + x[3] * x[3]); }
                    s2 += __shfl_xor(s2, 16); s2 += __shfl_xor(s2, 32);
                    const float rn = rsqrtf(s2 * (1.f / 64.f) + EPS);
#pragma unroll
                    for (int bj = 0; bj < 2; ++bj)
#pragma unroll
                        for (int n = 0; n < 2; ++n) v[bj][n] = v[bj][n] * rn * gv[bj][n];
                }
                const int b = r >> 11, s = r & 2047;
                if (sec == 10) {
                    const int sl = s & 127;
                    bf16* base = vnt + ((((size_t)((b * 4 + wc) * 16 + (s >> 7)) * 2) * 8 + (sl >> 4)) * 64 + ((sl >> 3) & 1) * 32 + 8 * fq) * 8 + (sl & 7);
#pragma unroll
                    for (int bj = 0; bj < 2; ++bj)
#pragma unroll
                        for (int n = 0; n < 2; ++n)
#pragma unroll
                            for (int j = 0; j < 4; ++j) base[(size_t)bj * 8 * 64 * 8 + (4 * n + j) * 8] = (bf16)f2bf(v[bj][n][j]);
                } else if (sec == 7 || sec == 8) {
                    const int kk_ = s & 31;
                    bf16* base = vt + (((size_t)((b * 8 + 4 * (sec - 7) + wc) * 64 + (s >> 5)) * 4 + (kk_ >> 4)) * 64 + ((kk_ >> 3) & 1) * 32 + 8 * fq) * 8 + (kk_ & 7);
#pragma unroll
                    for (int bj = 0; bj < 2; ++bj)
#pragma unroll
                        for (int n = 0; n < 2; ++n)
#pragma unroll
                            for (int j = 0; j < 4; ++j) base[(size_t)bj * 2 * 64 * 8 + (4 * n + j) * 8] = (bf16)f2bf(v[bj][n][j]);
                } else if (sec >= 3 && sec < 7) {
                    const bool isq = sec < 5;
                    const int sl = s & 31, pos = isq ? sl : ((sl & 0x13) | ((sl & 4) << 1) | ((sl & 8) >> 1));
                    bf16* base = (isq ? q : k) + (((size_t)((b * 8 + 4 * ((sec - 3) & 1) + wc) * 64 + (s >> 5)) * 4 + (fq >> 1)) * 64 + (fq & 1) * 32 + pos) * 8;
#pragma unroll
                    for (int bj = 0; bj < 2; ++bj) { v4u w; w.x = pk2(v[bj][0][0], v[bj][0][1]); w.y = pk2(v[bj][0][2], v[bj][0][3]); w.z = pk2(v[bj][1][0], v[bj][1][1]); w.w = pk2(v[bj][1][2], v[bj][1][3]);
                        *(v4u*)(base + (size_t)bj * 2 * 64 * 8) = w; }
                } else {
                    bf16* dst; int ld;
                    if (sec < 3) { dst = conv + (size_t)sec * M * 256 + cw; ld = 256; }
                    else { dst = cu + cw; ld = 256; }
                    dst += (size_t)r * ld;
#pragma unroll
                    for (int bj = 0; bj < 2; ++bj) { v4u w; w.x = pk2(v[bj][0][0], v[bj][0][1]); w.y = pk2(v[bj][0][2], v[bj][0][3]); w.z = pk2(v[bj][1][0], v[bj][1][1]); w.w = pk2(v[bj][1][2], v[bj][1][3]);
                        *(v4u*)(dst + 32 * bj) = w; }
                }
            }
    }
};

__device__ __forceinline__ void unpk(const v4u w, f32x4& a, f32x4& b) { a = (f32x4){bflo(w.x), bfhi(w.x), bflo(w.y), bfhi(w.y)}; b = (f32x4){bflo(w.z), bfhi(w.z), bflo(w.w), bfhi(w.w)}; }
__device__ __forceinline__ void split_store(const f32x4 h0, const f32x4 h1, bf16* hi, bf16* lo) {
    v4u w; w.x = pk2(h0[0], h0[1]); w.y = pk2(h0[2], h0[3]); w.z = pk2(h1[0], h1[1]); w.w = pk2(h1[2], h1[3]); *(v4u*)hi = w;
    f32x4 a, b; unpk(w, a, b); const f32x4 d0 = h0 - a, d1 = h1 - b;
    v4u l; l.x = pk2(d0[0], d0[1]); l.y = pk2(d0[2], d0[3]); l.z = pk2(d1[0], d1[1]); l.w = pk2(d1[2], d1[3]); *(v4u*)lo = l;
}
struct EpiRes {
    static constexpr bool PERM = true, AFTER_DRAIN = false;
    bf16* hi; bf16* lo; float* ssout; int use_lo, write_lo;
    __device__ __forceinline__ void operator()(const pg8::f32x4 (&acc)[2][2][4][2], const pg8::Unit& u, int wr, int wc, int fr, int fq) const {
        const int row0 = u.pm * 256 + wr * 64 + fr, col0 = u.pn * 256 + wc * 32 + 8 * fq;
        constexpr int LA = 2;
        v4u bq[8][4];
#pragma unroll
        for (int g = 0; g < LA; ++g) { const size_t off = (size_t)(row0 + (g >> 2) * 128 + (g & 3) * 16) * DM + col0;
#pragma unroll
            for (int bj = 0; bj < 2; ++bj) { bq[g][2 * bj] = *(const v4u*)(hi + off + bj * 128); bq[g][2 * bj + 1] = use_lo ? *(const v4u*)(lo + off + bj * 128) : (v4u){0u, 0u, 0u, 0u}; } }
#pragma unroll
        for (int g = 0; g < 8; ++g) {
            if (g + LA < 8) { const int gn = g + LA; const size_t off = (size_t)(row0 + (gn >> 2) * 128 + (gn & 3) * 16) * DM + col0;
#pragma unroll
                for (int bj = 0; bj < 2; ++bj) { bq[gn][2 * bj] = *(const v4u*)(hi + off + bj * 128); bq[gn][2 * bj + 1] = use_lo ? *(const v4u*)(lo + off + bj * 128) : (v4u){0u, 0u, 0u, 0u}; } }
            const int ai = g >> 2, m = g & 3;
            const int r = row0 + ai * 128 + m * 16; const size_t off = (size_t)r * DM + col0; float s2 = 0.f;
#pragma unroll
            for (int bj = 0; bj < 2; ++bj) {
                f32x4 a0, a1, l0, l1; unpk(bq[g][2 * bj], a0, a1); unpk(bq[g][2 * bj + 1], l0, l1);
                const f32x4 h0 = (a0 + l0) + acc[ai][bj][m][0], h1 = (a1 + l1) + acc[ai][bj][m][1];
                if (write_lo) split_store(h0, h1, hi + off + bj * 128, lo + off + bj * 128);
                else { v4u w; w.x = pk2(h0[0], h0[1]); w.y = pk2(h0[2], h0[3]); w.z = pk2(h1[0], h1[1]); w.w = pk2(h1[2], h1[3]); *(v4u*)(hi + off + bj * 128) = w; }
                s2 += (h0[0] * h0[0] + h0[1] * h0[1]) + (h0[2] * h0[2] + h0[3] * h0[3]) + (h1[0] * h1[0] + h1[1] * h1[1]) + (h1[2] * h1[2] + h1[3] * h1[3]);
            }
            s2 += __shfl_xor(s2, 16); s2 += __shfl_xor(s2, 32);
            if (fq == 0) ssout[(size_t)r * 16 + u.pn * 4 + wc] = s2;
            asm volatile("" ::: "memory");
        }
    }
};
struct EpiFF1 {
    static constexpr bool PERM = true, AFTER_DRAIN = false;
    const float* ss; bf16* f;
    __device__ __forceinline__ void operator()(const pg8::f32x4 (&acc)[2][2][4][2], const pg8::Unit& u, int wr, int wc, int fr, int fq) const {
        const int row0 = u.pm * 256 + wr * 64 + fr, col0 = u.pn * 256 + wc * 32 + 8 * fq;
        float rsv[8];
#pragma unroll
        for (int g = 0; g < 8; ++g) { rsv[g] = row_rs(ss, row0 + (g >> 2) * 128 + (g & 3) * 16); if (g & 1) asm volatile("" : "+v"(rsv[g - 1]), "+v"(rsv[g]) :: "memory"); }
#pragma unroll
        for (int ai = 0; ai < 2; ++ai)
#pragma unroll
            for (int m = 0; m < 4; ++m) {
                const int r = row0 + ai * 128 + m * 16; const float rs = rsv[ai * 4 + m]; bf16* dst = f + (size_t)r * DFF + col0;
#pragma unroll
                for (int bj = 0; bj < 2; ++bj) {
                    f32x4 a = acc[ai][bj][m][0] * rs, b = acc[ai][bj][m][1] * rs;
#pragma unroll
                    for (int j = 0; j < 4; ++j) { a[j] = fmaxf(a[j], 0.f); a[j] *= a[j]; b[j] = fmaxf(b[j], 0.f); b[j] *= b[j]; }
                    v4u w; w.x = pk2(a[0], a[1]); w.y = pk2(a[2], a[3]); w.z = pk2(b[0], b[1]); w.w = pk2(b[2], b[3]); *(v4u*)(dst + bj * 128) = w;
                }
            }
    }
};
struct EpiT {
    static constexpr bool PERM = true, AFTER_DRAIN = false;
    bf16* t;
    __device__ __forceinline__ void operator()(const pg8::f32x4 (&acc)[2][2][4][2], const pg8::Unit& u, int wr, int wc, int fr, int fq) const {
        const int row0 = u.pm * 256 + wr * 64 + fr, col0 = u.pn * 256 + wc * 32 + 8 * fq;
#pragma unroll
        for (int ai = 0; ai < 2; ++ai)
#pragma unroll
            for (int m = 0; m < 4; ++m) {
                bf16* dst = t + (size_t)(row0 + ai * 128 + m * 16) * DM + col0;
#pragma unroll
                for (int bj = 0; bj < 2; ++bj) { const f32x4 a = acc[ai][bj][m][0], b = acc[ai][bj][m][1];
                    v4u w; w.x = pk2(a[0], a[1]); w.y = pk2(a[2], a[3]); w.z = pk2(b[0], b[1]); w.w = pk2(b[2], b[3]); *(v4u*)(dst + bj * 128) = w; }
            }
    }
};
struct EpiGate {
    static constexpr bool PERM = true, AFTER_DRAIN = false;
    const float* ss; const bf16* hi; bf16* lo; bf16* tx; float* ssout; float* fout;
    __device__ __forceinline__ void operator()(const pg8::f32x4 (&acc)[2][2][4][2], const pg8::Unit& u, int wr, int wc, int fr, int fq) const {
        const int row0 = u.pm * 256 + wr * 64 + fr, col0 = u.pn * 256 + wc * 32 + 8 * fq;
        float rsv[8];
#pragma unroll
        for (int g = 0; g < 8; ++g) { rsv[g] = row_rs(ss, row0 + (g >> 2) * 128 + (g & 3) * 16) * (-1.4426950408889634f); if (g & 1) asm volatile("" : "+v"(rsv[g - 1]), "+v"(rsv[g]) :: "memory"); }
        v4u hq[16], lq[16], tq[16];
        { const size_t off = (size_t)row0 * DM + col0; tq[0] = *(const v4u*)(tx + off); hq[0] = *(const v4u*)(hi + off); lq[0] = *(const v4u*)(lo + off); }
        float s2 = 0.f;
#pragma unroll
        for (int q = 0; q < 16; ++q) {
            if (q + 1 < 16) { const int gn = (q + 1) >> 1, bn = (q + 1) & 1; const size_t off = (size_t)(row0 + (gn >> 2) * 128 + (gn & 3) * 16) * DM + col0 + bn * 128;
                tq[q + 1] = *(const v4u*)(tx + off); hq[q + 1] = *(const v4u*)(hi + off); lq[q + 1] = *(const v4u*)(lo + off); }
            const int g = q >> 1, bj = q & 1, ai = g >> 2, m = g & 3;
            const int r = row0 + ai * 128 + m * 16; const float rs = rsv[g]; const size_t off = (size_t)r * DM + col0 + bj * 128;
            f32x4 t0, t1, a0, a1, l0, l1; unpk(tq[q], t0, t1); unpk(hq[q], a0, a1); unpk(lq[q], l0, l1);
            f32x4 g0 = acc[ai][bj][m][0] * rs, g1 = acc[ai][bj][m][1] * rs;
#pragma unroll
            for (int j = 0; j < 4; ++j) { g0[j] = __builtin_amdgcn_rcpf(1.f + __builtin_amdgcn_exp2f(g0[j])); g1[j] = __builtin_amdgcn_rcpf(1.f + __builtin_amdgcn_exp2f(g1[j])); }
            const f32x4 h0 = (a0 + l0) + g0 * t0, h1 = (a1 + l1) + g1 * t1;
            { v4u w; w.x = pk2(h0[0], h0[1]); w.y = pk2(h0[2], h0[3]); w.z = pk2(h1[0], h1[1]); w.w = pk2(h1[2], h1[3]); *(v4u*)(tx + off) = w; }
            if (fout) { *(f32x4*)(fout + off) = h0; *(f32x4*)(fout + off + 4) = h1; }
            s2 += (h0[0] * h0[0] + h0[1] * h0[1]) + (h0[2] * h0[2] + h0[3] * h0[3]) + (h1[0] * h1[0] + h1[1] * h1[1]) + (h1[2] * h1[2] + h1[3] * h1[3]);
            if (bj == 1) {
                s2 += __shfl_xor(s2, 16); s2 += __shfl_xor(s2, 32);
                if (fq == 0) ssout[(size_t)r * 16 + u.pn * 4 + wc] = s2;
                s2 = 0.f;
            }
            asm volatile("" ::: "memory");
        }
    }
};

struct TSched {
    int c, c0, G;
    __device__ __forceinline__ bool next(int i, pg8::Unit& u) const {
        if (c < c0) return false;
        if (G == 256 && c0 == 192) { if (i >= 4) return false; u.pm = 8 * (c & 7) + ((c - c0) >> 3); u.pn = i; return true; }
        const int un = (c - c0) + i * (G - c0); if (un >= 256) return false; u.pm = un >> 2; u.pn = un & 3; return true; }
    __device__ __forceinline__ void a_ready(const pg8::Unit&) const {}
    __device__ __forceinline__ void done(const pg8::Unit&) const {}
};
__device__ __forceinline__ void tr_item(const float* W, int K, int N, bf16* WT, LAS float* scr, int item, int lane, const float* g, bool hperm) {
    const int nblk = N / 32, kb = item / nblk, nb = item % nblk, k0 = 64 * kb, n0 = 32 * nb;
    const int kr = lane >> 3, nq = (lane & 7) * 4;
    f32x4 v[8];
#pragma unroll
    for (int i = 0; i < 8; ++i) v[i] = *(const f32x4*)(W + (size_t)(k0 + 8 * i + kr) * N + n0 + nq);
    if (g) {
#pragma unroll
        for (int i = 0; i < 8; ++i) v[i] = v[i] * g[k0 + 8 * i + kr];
    }
#pragma unroll
    for (int i = 0; i < 8; ++i) { LAS float* d = scr + (8 * i + kr) * 33 + nq; d[0] = v[i][0]; d[1] = v[i][1]; d[2] = v[i][2]; d[3] = v[i][3]; }
    LDS_WAIT(); asm volatile("" ::: "memory");
    int d0 = n0; if (hperm) { const int gi = (n0 >> 5) & 7; d0 = (n0 & ~255) + 32 * (4 * (gi & 1) + (gi >> 1)); }
    const int c = lane & 7;
#pragma unroll
    for (int j = 0; j < 4; ++j) { const int n = (lane >> 3) + 8 * j; const LAS float* sp = scr + (8 * c) * 33 + n;
        v4u o; o.x = pk2(sp[0 * 33], sp[1 * 33]); o.y = pk2(sp[2 * 33], sp[3 * 33]); o.z = pk2(sp[4 * 33], sp[5 * 33]); o.w = pk2(sp[6 * 33], sp[7 * 33]);
        *(v4u*)(WT + (size_t)(d0 + n) * K + k0 + 8 * c) = o; }
    LDS_WAIT(); asm volatile("" ::: "memory");
}

__device__ __forceinline__ int crow(int r, int hf) { return (r & 3) + 8 * (r >> 2) + 4 * hf; }
__device__ __forceinline__ void attn_task(const bf16* Q, const bf16* K, const bf16* VT, bf16* Y, int b, int h, int qb, int lane) {
    const int t = lane & 31, hf = lane >> 5, q0 = qb * 32;
    const size_t hb = (size_t)(b * 8 + h) * 64;
    const bf16* qp = Q + ((hb + qb) * 4 * 64 + lane) * 8;
    bf16x8 qr[4];
#pragma unroll
    for (int kk = 0; kk < 4; ++kk) qr[kk] = *(const bf16x8*)(qp + kk * 512);
    const bf16* kbase = K + (hb * 4 * 64 + lane) * 8;
    const bf16* vbase = VT + (hb * 4 * 64 + lane) * 8;
    f32x16 o0, o1;
#pragma unroll
    for (int r = 0; r < 16; ++r) { o0[r] = 0.f; o1[r] = 0.f; }
    float carry = 1.f;
    bf16x8 kn[4], vn[4];
#pragma unroll
    for (int i = 0; i < 4; ++i) { kn[i] = *(const bf16x8*)(kbase + (size_t)qb * 2048 + i * 512); vn[i] = *(const bf16x8*)(vbase + (size_t)qb * 2048 + i * 512); }
    for (int j = qb; j >= 0; --j) {
        bf16x8 kf[4], vf[4];
#pragma unroll
        for (int i = 0; i < 4; ++i) { kf[i] = kn[i]; vf[i] = vn[i]; }
        { const int jn = j > 0 ? j - 1 : 0;
#pragma unroll
          for (int i = 0; i < 4; ++i) { kn[i] = *(const bf16x8*)(kbase + (size_t)jn * 2048 + i * 512); vn[i] = *(const bf16x8*)(vbase + (size_t)jn * 2048 + i * 512); } }
        f32x16 z;
#pragma unroll
        for (int r = 0; r < 16; ++r) z[r] = 0.f;
#pragma unroll
        for (int kk = 0; kk < 4; ++kk) z = __builtin_amdgcn_mfma_f32_32x32x16_bf16(kf[kk], qr[kk], z, 0, 0, 0);
        float om[16], w[16];
        const bool diag = (j == qb);
#pragma unroll
        for (int r = 0; r < 16; ++r) {
            const float e = __builtin_amdgcn_exp2f(fminf(z[r], 100.f));
            float o = __builtin_amdgcn_rcpf(1.f + e), bt = e * o;
            if (diag) { const bool valid = (16 * (r >> 3) + 8 * hf + (r & 7)) < t; o = valid ? o : 1.f; bt = valid ? bt : 0.f; }
            om[r] = o; w[r] = bt;
        }
        float R[2];
#pragma unroll
        for (int ks = 0; ks < 2; ++ks) {
            float x = om[8 * ks + 7];
#pragma unroll
            for (int jj = 6; jj >= 0; --jj) { w[8 * ks + jj] *= x; x *= om[8 * ks + jj]; }
            R[ks] = x;
        }
        const float Rp0 = __shfl_xor(R[0], 32), Rp1 = __shfl_xor(R[1], 32);
        const float T1 = R[1] * Rp1, T0 = R[0] * Rp0;
        const float L1 = hf ? carry : carry * Rp1;
        const float c0 = carry * T1, L0 = hf ? c0 : c0 * Rp0;
        carry = c0 * T0;
#pragma unroll
        for (int jj = 0; jj < 8; ++jj) { w[jj] *= L0; w[8 + jj] *= L1; }
#pragma unroll
        for (int ks = 0; ks < 2; ++ks) {
            v4u pw; pw.x = pk2(w[8 * ks], w[8 * ks + 1]); pw.y = pk2(w[8 * ks + 2], w[8 * ks + 3]); pw.z = pk2(w[8 * ks + 4], w[8 * ks + 5]); pw.w = pk2(w[8 * ks + 6], w[8 * ks + 7]);
            const bf16x8 pf = __builtin_bit_cast(bf16x8, pw);
            o0 = __builtin_amdgcn_mfma_f32_32x32x16_bf16(vf[ks], pf, o0, 0, 0, 0);
            o1 = __builtin_amdgcn_mfma_f32_32x32x16_bf16(vf[2 + ks], pf, o1, 0, 0, 0);
        }
#if ATT_EARLY_EXIT
        if (__all(carry == 0.f)) break;
#endif
    }
    bf16* yp = Y + (size_t)(b * SEQ + q0 + t) * DM + 256 + h * 64 + 4 * hf;
#pragma unroll
    for (int g = 0; g < 4; ++g) {
        v2u a; a.x = pk2(o0[4 * g], o0[4 * g + 1]); a.y = pk2(o0[4 * g + 2], o0[4 * g + 3]); *(v2u*)(yp + 8 * g) = a;
        v2u c; c.x = pk2(o1[4 * g], o1[4 * g + 1]); c.y = pk2(o1[4 * g + 2], o1[4 * g + 3]); *(v2u*)(yp + 32 + 8 * g) = c;
    }
}
__device__ __forceinline__ void sgu_task(const bf16* VNT, const bf16* WSB, const bf16* CU, const float* bias, bf16* Y, int task, int lane) {
    const int tb = task & 3, g = (task >> 2) & 3, c = (task >> 4) & 15, b = task >> 8;
    const int t = lane & 31, hf = lane >> 5;
    const bf16* ap = VNT + ((size_t)((b * 4 + g) * 16 + c) * 2 * 8 * 64 + lane) * 8;
    const bf16* bp = WSB + ((size_t)(g * 4 + tb) * 8 * 64 + lane) * 8;
    f32x16 a0, a1;
#pragma unroll
    for (int r = 0; r < 16; ++r) { a0[r] = 0.f; a1[r] = 0.f; }
    bf16x8 bfr[8], af0[8], af1[8];
#pragma unroll
    for (int ks = 0; ks < 8; ++ks) { bfr[ks] = *(const bf16x8*)(bp + 512 * ks); af0[ks] = *(const bf16x8*)(ap + 512 * ks); af1[ks] = *(const bf16x8*)(ap + 4096 + 512 * ks); }
#pragma unroll
    for (int ks = 0; ks < 8; ++ks) {
        a0 = __builtin_amdgcn_mfma_f32_32x32x16_bf16(af0[ks], bfr[ks], a0, 0, 0, 0);
        a1 = __builtin_amdgcn_mfma_f32_32x32x16_bf16(af1[ks], bfr[ks], a1, 0, 0, 0);
    }
    const int tok = b * SEQ + 128 * c + 32 * tb + t;
    const float bs = bias[g * 128 + 32 * tb + t];
    const bf16* up = CU + (size_t)tok * 256 + 64 * g + 4 * hf;
    bf16* yp = Y + (size_t)tok * DM + 768 + 64 * g + 4 * hf;
#pragma unroll
    for (int gg = 0; gg < 4; ++gg) {
        const v2u u0 = *(const v2u*)(up + 8 * gg), u1 = *(const v2u*)(up + 32 + 8 * gg);
        v2u a; a.x = pk2(bflo(u0.x) * (a0[4 * gg] + bs), bfhi(u0.x) * (a0[4 * gg + 1] + bs)); a.y = pk2(bflo(u0.y) * (a0[4 * gg + 2] + bs), bfhi(u0.y) * (a0[4 * gg + 3] + bs)); *(v2u*)(yp + 8 * gg) = a;
        v2u d; d.x = pk2(bflo(u1.x) * (a1[4 * gg] + bs), bfhi(u1.x) * (a1[4 * gg + 1] + bs)); d.y = pk2(bflo(u1.y) * (a1[4 * gg + 2] + bs), bfhi(u1.y) * (a1[4 * gg + 3] + bs)); *(v2u*)(yp + 32 + 8 * gg) = d;
    }
}
__device__ __forceinline__ void unpack8(const v4u w, float (&f)[8]) { f[0] = bflo(w.x); f[1] = bfhi(w.x); f[2] = bflo(w.y); f[3] = bfhi(w.y); f[4] = bflo(w.z); f[5] = bfhi(w.z); f[6] = bflo(w.w); f[7] = bfhi(w.w); }
__device__ __forceinline__ void conv_task(const bf16* CONV, const float* cwt, bf16* Y, int task, int lane) {
    const int ch = (lane & 31) * 8;
    float w0[8], w1[8], w2[8];
#pragma unroll
    for (int e = 0; e < 8; ++e) { w0[e] = cwt[ch + e]; w1[e] = cwt[256 + ch + e]; w2[e] = cwt[512 + ch + e]; }
    const bf16* ab = CONV; const bf16* ac = CONV + (size_t)M * 256; const bf16* ah = CONV + (size_t)2 * M * 256;
#pragma unroll 2
    for (int it = 0; it < 4; ++it) {
        const int tok = task * 8 + it * 2 + (lane >> 5), s = tok & (SEQ - 1);
        const size_t o = (size_t)tok * 256 + ch;
        float fb[8], c0[8], h0[8], c1[8], h1[8], c2[8], h2[8];
        unpack8(*(const v4u*)(ab + o), fb); unpack8(*(const v4u*)(ac + o), c0); unpack8(*(const v4u*)(ah + o), h0);
        const v4u zz = (v4u){0u, 0u, 0u, 0u};
        unpack8(s >= 1 ? *(const v4u*)(ac + o - 256) : zz, c1); unpack8(s >= 1 ? *(const v4u*)(ah + o - 256) : zz, h1);
        unpack8(s >= 2 ? *(const v4u*)(ac + o - 512) : zz, c2); unpack8(s >= 2 ? *(const v4u*)(ah + o - 512) : zz, h2);
        float y[8];
#pragma unroll
        for (int e = 0; e < 8; ++e) y[e] = fb[e] * (w2[e] * (c0[e] * h0[e]) + w1[e] * (c1[e] * h1[e]) + w0[e] * (c2[e] * h2[e]));
        v4u w; w.x = pk2(y[0], y[1]); w.y = pk2(y[2], y[3]); w.z = pk2(y[4], y[5]); w.w = pk2(y[6], y[7]);
        *(v4u*)(Y + (size_t)tok * DM + ch) = w;
    }
}

#define RLX_AGENT __ATOMIC_RELAXED, __HIP_MEMORY_SCOPE_AGENT
#define XB_TMO      128
#define XB_XCNT(j)  (256  + 64 * (j))
#define XB_XSUB(j)  (1280 + 64 * (j))
#define XB_XGEN(j)  (2304 + 64 * (j))
#define XB_TOP      3328
#define XB_TOPGEN   3392
#define XCD_BAR_WORDS 3456
#define XB_SPIN_CAP (1u << 18)

__device__ __forceinline__ unsigned xb_ld(unsigned* p)              { return __hip_atomic_load(p, __ATOMIC_RELAXED, __HIP_MEMORY_SCOPE_AGENT); }
__device__ __forceinline__ unsigned xb_add(unsigned* p, unsigned v) { return __hip_atomic_fetch_add(p, v, __ATOMIC_RELAXED, __HIP_MEMORY_SCOPE_AGENT); }
__device__ __forceinline__ unsigned xb_xcc_id() { return (unsigned)__builtin_amdgcn_s_getreg((3 << 11) | 20) & 0xFu; }
#define XB_SPIN(cond, bar) do { unsigned _sp = 0; while (cond) { __builtin_amdgcn_s_sleep(1); \
    if ((++_sp & 255u) == 0u) { if (xb_ld(&(bar)[XB_TMO])) break; if (_sp > XB_SPIN_CAP) { atomicAdd(&(bar)[XB_TMO], 1u); break; } } } } while (0)

struct XcdBarrier {
    unsigned* bar; unsigned x;
    volatile LAS unsigned* st;
};

__device__ __forceinline__ XcdBarrier xcd_barrier_post(unsigned* bar, volatile LAS unsigned* st) {
    XcdBarrier b; b.bar = bar; b.x = xb_xcc_id(); b.st = st;
    if (threadIdx.x == 0) (void)xb_add(&bar[XB_XCNT(b.x)], 1u);
    return b;
}
__device__ __forceinline__ void xcd_barrier_complete(unsigned* bar, unsigned x, unsigned& nloc, unsigned& nx) {
    const unsigned G = gridDim.x * gridDim.y * gridDim.z;
    unsigned sum, cnt, mine, sp = 0u;
    for (;;) {
        sum = 0u; cnt = 0u; mine = 0u;
#pragma unroll
        for (unsigned j = 0; j < 16; ++j) { const unsigned c = xb_ld(&bar[XB_XCNT(j)]); sum += c; cnt += (c > 0u) ? 1u : 0u; mine = (j == x) ? c : mine; }
        if (sum == G) break;
        __builtin_amdgcn_s_sleep(1);
        if ((++sp & 255u) == 0u) { if (xb_ld(&bar[XB_TMO])) break; if (sp > XB_SPIN_CAP) { atomicAdd(&bar[XB_TMO], 1u); break; } }
    }
    nloc = mine > 0u ? mine : 1u; nx = cnt > 0u ? cnt : 1u;
}

__device__ __forceinline__ void xcd_barrier(const XcdBarrier& b, bool local_seam) {
    asm volatile("s_waitcnt vmcnt(0)" ::: "memory");
    __syncthreads();
    if (threadIdx.x == 0) {
        unsigned* bar = b.bar;
        __builtin_amdgcn_s_waitcnt(0);
        unsigned nloc = b.st[0], nx = b.st[1];
        if (nloc == 0u) { xcd_barrier_complete(bar, b.x, nloc, nx); b.st[0] = nloc; b.st[1] = nx; }
        const unsigned old = xb_add(&bar[XB_XSUB(b.x)], 1u);
        const unsigned gen = old / nloc;
        const bool local = local_seam && (b.st[2] != 0u);
        if (old + 1u == (gen + 1u) * nloc) {
            if (!local) {
            __builtin_amdgcn_fence(__ATOMIC_RELEASE, "agent");
            asm volatile("s_waitcnt vmcnt(0)" ::: "memory");
            const unsigned og = xb_add(&bar[XB_TOP], 1u);
            const unsigned tg = og / nx;
            if (og + 1u == (tg + 1u) * nx) xb_add(&bar[XB_TOPGEN], 1u);
            else XB_SPIN(xb_ld(&bar[XB_TOPGEN]) == tg, bar);
            }
            __builtin_amdgcn_fence(__ATOMIC_ACQUIRE, "agent");
            xb_add(&bar[XB_XGEN(b.x)], 1u);
            asm volatile("s_waitcnt vmcnt(0)" ::: "memory");
        } else {
            XB_SPIN(xb_ld(&bar[XB_XGEN(b.x)]) == gen, bar);
            __builtin_amdgcn_fence(__ATOMIC_ACQUIRE, "agent");
            asm volatile("s_waitcnt vmcnt(0)" ::: "memory");
        }
    }
    __syncthreads();
}

struct Args { const float* in[17]; float* out; unsigned char* ws; int ph_lo, ph_hi; };
__global__ void __launch_bounds__(NWAVES * 64, 2) mk_fwd(Args a) {
    extern __shared__ __attribute__((aligned(16))) unsigned char lds_raw[];
    LAS unsigned char* lds = (LAS unsigned char*)lds_raw;
    const int tid = threadIdx.x, lane = tid & 63, wave = __builtin_amdgcn_readfirstlane(tid >> 6);
    const int G = gridDim.x; const int bx = blockIdx.x; const int vcu = (G % 8 == 0) ? (bx % 8) * (G / 8) + bx / 8 : bx;
    const int gw = vcu * NWAVES + wave, NGW = G * NWAVES;
    const int lo = a.ph_lo, hi = a.ph_hi;
    volatile LAS unsigned* bst = (volatile LAS unsigned*)(lds + RING_BYTES);
    if (tid < 4) bst[tid] = 0u;
    __syncthreads();
    XcdBarrier bar = xcd_barrier_post((unsigned*)(a.ws + WS_CTL), bst);
    unsigned* xcctab = (unsigned*)(a.ws + WS_CTL) + XCD_BAR_WORDS;
    if (tid == 0) __hip_atomic_store(xcctab + bx, bar.x + 1u, __ATOMIC_RELAXED, __HIP_MEMORY_SCOPE_AGENT);
    unsigned char* ws = a.ws;
    const float* x = a.in[0]; const float* p = a.in[1];
    bf16* Wb = (bf16*)(ws + WS_W); bf16* WSBb = (bf16*)(ws + WS_WSB); float* SS = (float*)(ws + WS_SS);
    bf16* HB = (bf16*)(ws + WS_HB); bf16* LO = (bf16*)(ws + WS_LO); bf16* XB = (bf16*)(ws + WS_XB);
    bf16* PB = (bf16*)a.out;
    unsigned char* big = ws + WS_BIG;
    bf16* CONV = (bf16*)(big + B_CONV); bf16* Qb = (bf16*)(big + B_Q); bf16* Kb = (bf16*)(big + B_K); bf16* VTb = (bf16*)(big + B_VT); bf16* CUb = (bf16*)(big + B_CU);
    bf16* VNTb = (bf16*)(big + B_VNT); bf16* Yb = (bf16*)(big + B_Y); bf16* Fb = (bf16*)big;
    float* H = a.out;
#define IN(k) (lo <= (k) && (k) < hi)
#define SEAM(k, loc) do { if (IN(k) && IN((k) + 1)) { if ((k) == 0) cg::this_grid().sync(); else { for (int sr_ = 0; sr_ < PROBE_SYNC; ++sr_) xcd_barrier(bar, loc); } } } while (0)

    if (IN(0)) for (int rep_ = 0; rep_ < PROBE_P; ++rep_) {
        LAS float* scr = (LAS float*)(lds + wave * 16384);
        constexpr int I_IN = (DM / 64) * (NIN / 32), I_OUT = (DM / 64) * (DM / 32), I_1 = (DM / 64) * (DFF / 32), I_2 = (DFF / 64) * (DM / 32), I_G = I_OUT, I_P = (PLE / 64) * (DM / 32);
        constexpr int I_LAYER = I_IN + I_OUT + I_1 + I_2 + I_G + I_P;
        for (int it = gw; it < DEPTH * I_LAYER; it += NGW) {
            const int l = it / I_LAYER; int r = it % I_LAYER; bf16* wl = Wb + (size_t)l * E_WLAYER;
            if (r < I_IN) { tr_item(a.in[3] + (size_t)l * DM * NIN, DM, NIN, wl + E_WIN, scr, r, lane, a.in[2] + l * DM, true); continue; } r -= I_IN;
            if (r < I_OUT) { tr_item(a.in[10] + (size_t)l * DM * DM, DM, DM, wl + E_WOUT, scr, r, lane, nullptr, false); continue; } r -= I_OUT;
            if (r < I_1) { tr_item(a.in[12] + (size_t)l * DM * DFF, DM, DFF, wl + E_W1, scr, r, lane, a.in[11] + l * DM, false); continue; } r -= I_1;
            if (r < I_2) { tr_item(a.in[13] + (size_t)l * DFF * DM, DFF, DM, wl + E_W2, scr, r, lane, nullptr, false); continue; } r -= I_2;
            if (r < I_G) { tr_item(a.in[15] + (size_t)l * DM * DM, DM, DM, wl + E_WG, scr, r, lane, a.in[14] + l * DM, false); continue; } r -= I_G;
            tr_item(a.in[16] + (size_t)l * PLE * DM, PLE, DM, wl + E_WP, scr, r, lane, nullptr, false);
        }
        for (int i = gw * 64 + lane; i < DEPTH * 4 * 128 * 128; i += NGW * 64) {
            const int e8 = i & 7, ln = (i >> 3) & 63, ks = (i >> 9) & 7, tb = (i >> 12) & 3, lg = i >> 14; const int t = 32 * tb + (ln & 31), sk = 16 * ks + 8 * (ln >> 5) + e8;
            WSBb[i] = (bf16)f2bf(sk <= t ? a.in[8][((size_t)lg * 128 + t) * 128 + sk] : 0.f); }
        for (int m = gw; m < M; m += NGW) {
            const f32x4* xr = (const f32x4*)(x + (size_t)m * DM) + lane; f32x4 v[4]; float s = 0.f;
#pragma unroll
            for (int j = 0; j < 4; ++j) { v[j] = xr[64 * j]; s += (v[j].x * v[j].x + v[j].y * v[j].y) + (v[j].z * v[j].z + v[j].w * v[j].w); }
            s = wave_sum(s);
            v2u* o8 = (v2u*)(XB + (size_t)m * DM) + lane;
            v2u* l8 = (v2u*)(LO + (size_t)m * DM) + lane;
#pragma unroll
            for (int j = 0; j < 4; ++j) { v2u w; w.x = pk2(v[j].x, v[j].y); w.y = pk2(v[j].z, v[j].w); o8[64 * j] = w;
                v2u d; d.x = pk2(v[j].x - bflo(w.x), v[j].y - bfhi(w.x)); d.y = pk2(v[j].z - bflo(w.y), v[j].w - bfhi(w.y)); l8[64 * j] = d; }
            if (lane < 16) SS[(size_t)m * 16 + lane] = lane == 0 ? s : 0.f;
        }
        for (int it = gw; it < M * PLE / 512; it += NGW) { const size_t o = (size_t)it * 512 + lane * 8; const f32x4 u0 = *(const f32x4*)(p + o), u1 = *(const f32x4*)(p + o + 4);
            v4u w; w.x = pk2(u0.x, u0.y); w.y = pk2(u0.z, u0.w); w.z = pk2(u1.x, u1.y); w.w = pk2(u1.z, u1.w); *(v4u*)(PB + o) = w; }
        asm volatile("s_waitcnt vmcnt(0) lgkmcnt(0)" ::: "memory"); __syncthreads();
    }
    SEAM(0, false);
    if (lo == 0 && hi == NPHASE) {
        if (wave == 0) {
            bool ok = (G == 256);
            for (int i = lane; i < G; i += 64) { const unsigned me = __hip_atomic_load(xcctab + i, __ATOMIC_RELAXED, __HIP_MEMORY_SCOPE_AGENT), first = __hip_atomic_load(xcctab + (i & 7), __ATOMIC_RELAXED, __HIP_MEMORY_SCOPE_AGENT);
                ok = ok && (me != 0u) && (me == first); }
            const bool all_ok = __all(ok);
            if (lane == 0) bst[2] = all_ok ? 1u : 0u;
        }
        __syncthreads();
    }

    for (int l = 0; l < DEPTH; ++l) {
        const int pb = 1 + 6 * l;
        const bf16* wl = Wb + (size_t)l * E_WLAYER;
        bf16* bufX = (l & 1) ? HB : XB; bf16* bufT = (l & 1) ? XB : HB;
        float* ss1 = SS; float* ss2 = SS + (size_t)M * 16; float* ss3 = SS + (size_t)2 * M * 16; float* ss1n = ss1;
        if (IN(pb)) for (int rep_ = 0; rep_ < PROBE_A; ++rep_) {
#ifndef NO_A
            { pg8::Gemm g{bufX, wl + E_WIN, M, NIN, DM}; pg8::StaticOrder S; S.init(M, NIN, G, bx);
              EpiInProj E{ss1, CONV, Qb, Kb, VTb, CUb, VNTb, a.in[5] + l * 64, a.in[6] + l * 64, a.in[7] + l * 256};
              pg8::gemm_phase<EpiInProj, pg8::StaticOrder, true, true>(lds, g, S, E); }
            { int kp = PLE; asm volatile("" : "+s"(kp)); pg8::Gemm g{PB, wl + E_WP, M, DM, kp}; TSched S{bx, (M / 256 * (NIN / 256)) % G, G};
              EpiT E{bufT};
              pg8::gemm_phase<EpiT, TSched, true, true>(lds, g, S, E); }
#endif
        }
        SEAM(pb, true);
        if (IN(pb + 1)) for (int rep_ = 0; rep_ < PROBE_B; ++rep_) {
            int lane_ = lane; asm volatile("" : "+v"(lane_));
#pragma unroll 1
            for (int part = 0; part < 2; ++part) {
            if ((part == 0) == (wave < 4)) {
#ifndef NO_ATT
            for (int pr = gw; pr < 2048; pr += NGW) { const int bh = pr >> 5, i = pr & 31;
                attn_task(Qb, Kb, VTb, Yb, bh >> 3, bh & 7, 63 - i, lane_);
                attn_task(Qb, Kb, VTb, Yb, bh >> 3, bh & 7, i, lane_); }
#endif
            } else {
#ifndef NO_SGU
            for (int tk = gw; tk < 2048; tk += NGW) sgu_task(VNTb, WSBb + (size_t)l * 4 * 128 * 128, CUb, a.in[9] + l * 512, Yb, tk, lane_);
#endif
#ifndef NO_CONV
            for (int tk = gw; tk < 2048; tk += NGW) conv_task(CONV, a.in[4] + l * 768, Yb, tk, lane_);
#endif
            const float* pl = p + (size_t)(l + 1 < DEPTH ? l + 1 : l) * M * PLE;
#pragma unroll 4
            for (int t_ = gw; t_ < (l + 1 < DEPTH ? M * PLE / 512 : 0); t_ += NGW) { const int it = ((t_ >> 8) & 7) * 1024 + (t_ >> 11) * 256 + (t_ & 255);
                const size_t o = (size_t)it * 512 + lane_ * 8; const f32x4 u0 = *(const f32x4*)(pl + o), u1 = *(const f32x4*)(pl + o + 4);
                v4u w; w.x = pk2(u0.x, u0.y); w.y = pk2(u0.z, u0.w); w.z = pk2(u1.x, u1.y); w.w = pk2(u1.z, u1.w); *(v4u*)(PB + o) = w; }
            }
            }
            asm volatile("s_waitcnt vmcnt(0) lgkmcnt(0)" ::: "memory"); __syncthreads();
        }
        SEAM(pb + 1, true);
        if (IN(pb + 2)) {
#ifndef NO_C
#ifndef NO_O
            { pg8::Gemm g{Yb, wl + E_WOUT, M, DM, DM}; pg8::StaticOrder S; S.init(M, DM, G, bx);
              EpiRes E{bufX, LO, ss2, l == 0 ? 1 : 0, 0};
              pg8::gemm_phase<EpiRes, pg8::StaticOrder, true, true>(lds, g, S, E); }
#endif
#endif
        }
        SEAM(pb + 2, false);
        if (IN(pb + 3)) for (int rep_ = 0; rep_ < PROBE_D; ++rep_) {
#ifndef NO_D
            pg8::Gemm g{bufX, wl + E_W1, M, DFF, DM}; pg8::StaticOrder S; S.init(M, DFF, G, bx);
            EpiFF1 E{ss2, Fb};
            pg8::gemm_phase<EpiFF1, pg8::StaticOrder, true, true>(lds, g, S, E);
#endif
        }
        SEAM(pb + 3, true);
        if (IN(pb + 4)) {
#ifndef NO_E
            pg8::Gemm g{Fb, wl + E_W2, M, DM, DFF}; pg8::StaticOrder S; S.init(M, DM, G, bx);
            EpiRes E{bufX, LO, ss3, 0, 1};
            pg8::gemm_phase<EpiRes, pg8::StaticOrder, true, true>(lds, g, S, E);
#endif
        }
        SEAM(pb + 4, true);
        if (IN(pb + 5)) {
#ifndef NO_F
            pg8::Gemm g{bufX, wl + E_WG, M, DM, DM}; pg8::StaticOrder S; S.init(M, DM, G, bx);
            EpiGate E{ss3, bufX, LO, bufT, ss1n, l == DEPTH - 1 ? H : (float*)nullptr};
            pg8::gemm_phase<EpiGate, pg8::StaticOrder, true, true>(lds, g, S, E);
#endif
        }
        SEAM(pb + 5, false);
    }
#undef IN
#undef SEAM
}

extern "C" void kernel_launch(void* const* d_in, const int* in_sizes, int n_in, void* d_out, int out_size, void* d_ws, size_t ws_size, hipStream_t stream) {
    static int grid = 0;
    if (grid == 0) {
        if (n_in != 17 || in_sizes[0] != M * DM || out_size != M * DM || ws_size < WS_TOTAL) { fprintf(stderr, "kernel_launch: unexpected shapes (n_in %d, in0 %d, out %d, ws %zu, need %zu)\n", n_in, n_in > 0 ? in_sizes[0] : -1, out_size, ws_size, (size_t)WS_TOTAL); grid = -1; return; }
        int dev = 0, cus = 0, per_cu = 0;
        hipGetDevice(&dev); hipDeviceGetAttribute(&cus, hipDeviceAttributeMultiprocessorCount, dev);
        if (hipFuncSetAttribute((const void*)mk_fwd, hipFuncAttributeMaxDynamicSharedMemorySize, LDS_BYTES) != hipSuccess) { fprintf(stderr, "kernel_launch: hipFuncSetAttribute failed\n"); grid = -1; return; }
        if (hipOccupancyMaxActiveBlocksPerMultiprocessor(&per_cu, (const void*)mk_fwd, NWAVES * 64, LDS_BYTES) != hipSuccess || per_cu < 1) { fprintf(stderr, "kernel_launch: occupancy query says %d\n", per_cu); per_cu = 1; }
        (void)hipGetLastError();
        grid = cus * 1;
    }
    if (grid < 0) return;
#ifdef DBG_MEMSET
    (void)hipMemsetAsync(d_ws, 0xAA, WS_END, stream); (void)hipMemsetAsync(d_out, 0xAA, (size_t)M * DM * 4, stream);
#endif
    if (hipMemsetAsync((char*)d_ws + WS_CTL, 0, CTL_BYTES, stream) != hipSuccess) { fprintf(stderr, "kernel_launch: memset of the barrier words failed\n"); return; }
    Args a{};
    for (int i = 0; i < 17; ++i) a.in[i] = (const float*)d_in[i];
    a.out = (float*)d_out; a.ws = (unsigned char*)d_ws;
#if MK_N_LAUNCHES == 1
    a.ph_lo = 0; a.ph_hi = NPHASE;
    void* args[] = {&a};
    hipError_t e = hipLaunchCooperativeKernel((const void*)mk_fwd, dim3(grid), dim3(NWAVES * 64), args, LDS_BYTES, stream);
    if (e != hipSuccess) fprintf(stderr, "cooperative launch failed: %s (grid %d)\n", hipGetErrorString(e), grid);
#else
    for (int ph = 0; ph < NPHASE; ++ph) { a.ph_lo = ph; a.ph_hi = ph + 1; hipLaunchKernelGGL(mk_fwd, dim3(grid), dim3(NWAVES * 64), LDS_BYTES, stream, a); }
#endif
}
```

```cpp
#include <hip/hip_runtime.h>
#include <hip/hip_cooperative_groups.h>
#include <cstdio>
#include <cstdint>
namespace cg = cooperative_groups;
namespace pg8 {
#define PG8_LAS __attribute__((address_space(3)))
typedef unsigned short bf16_t;
typedef short bf16x8 __attribute__((ext_vector_type(8)));
typedef float f32x4 __attribute__((ext_vector_type(4)));
typedef unsigned u32x4 __attribute__((ext_vector_type(4)));
constexpr int BM = 256, BK = 64, HALF = 128, HTB = HALF * BK * 2  , STAGE_BYTES = 8 * HTB, NXCD = 8, WGM = 8;

__host__ __device__ __forceinline__ int lds_byte(int r, int c) { const int st = (r >> 4) * 2 + (c >> 5), rr = r & 15, cc = c & 31, ob = rr * 64 + cc * 2; return st * 1024 + (ob ^ (((ob >> 9) & 1) << 5)); }
__host__ __device__ __forceinline__ void stage_rc(int b, int& R, int& C) { const int st = b / 1024, sb = b % 1024, swz = sb ^ (((sb >> 9) & 1) << 5); R = (st >> 1) * 16 + swz / 64; C = (st & 1) * 32 + (swz % 64) / 2; }
__host__ __device__ __forceinline__ int perm32(int rho) { const int n = rho >> 4, i = rho & 15; return 8 * (i >> 2) + 4 * n + (i & 3); }

struct Unit { int pm, pn; };
struct Gemm { const bf16_t* A; const bf16_t* Bt; int M, N, K; };

struct StaticOrder {
    int nM, nN, nwg, G, c;
    __host__ __device__ void init(int M, int N, int G_, int c_) { nM = M / BM; nN = N / BM; nwg = nM * nN; G = G_; c = c_; }
    __host__ __device__ bool next(int i, Unit& u) const {
        const long L = (long)i * G + c; if (L >= nwg) return false;
        int wgid = (int)L; { const int q = nwg / NXCD, r = nwg % NXCD, xcd = wgid % NXCD, off = wgid / NXCD; wgid = (xcd < r ? xcd * (q + 1) : r * (q + 1) + (xcd - r) * q) + off; }
        const int nig = WGM * nN, gid = wgid / nig, fm = gid * WGM, gsz = (nM - fm) < WGM ? (nM - fm) : WGM;
        u.pm = fm + ((wgid % nig) % gsz); u.pn = (wgid % nig) / gsz; return true;
    }
    __device__ __forceinline__ void a_ready(const Unit&) const {}
    __device__ __forceinline__ void done(const Unit&) const {}
};

__device__ __forceinline__ unsigned cvt_pk_bf16(float lo, float hi) { unsigned r; asm volatile("v_cvt_pk_bf16_f32 %0, %1, %2" : "=v"(r) : "v"(lo), "v"(hi)); return r; }
typedef float f32x2 __attribute__((ext_vector_type(2)));
__device__ __forceinline__ f32x2 gelu_pk(f32x2 v) {
    const f32x2 av = __builtin_elementwise_abs(v), d = av * 0.2316418882f + 1.0f;
    f32x2 t; t.x = __builtin_amdgcn_rcpf(d.x); t.y = __builtin_amdgcn_rcpf(d.y);
    f32x2 q = t * 0.5307027145f + (-0.7265760135f); q = q * t + 0.7107068705f; q = q * t + (-0.142248368f); q = q * t + 0.127414796f; q = q * t;
    const f32x2 s = (v * v) * (-0.72134752044f);
    f32x2 e; e.x = __builtin_amdgcn_exp2f(s.x); e.y = __builtin_amdgcn_exp2f(s.y);
    const f32x2 m = v * (q * e), r = v - m;
    f32x2 o; o.x = v.x < 0.f ? m.x : r.x; o.y = v.y < 0.f ? m.y : r.y; return o;
}

template <int ACT  > struct EpiBf16 {
    static constexpr bool PERM = true, AFTER_DRAIN = false; static_assert(ACT == 0 || ACT == 1, "EpiBf16: ACT is 0 (none) or 1 (gelu_pk)");
    bf16_t* O; int ldc; const float* bias; int split_cols; size_t split_stride; float scale0;
    __device__ __forceinline__ void operator()(const f32x4 (&acc)[2][2][4][2], const Unit& u, int wr, int wc, int fr, int fq) const {
        const int row0 = u.pm * BM + wr * 64 + fr; int colt = u.pn * BM; bf16_t* base = O;
        float sc = 1.f; if (split_cols) { const int t = colt / split_cols; base += (size_t)t * split_stride; colt -= t * split_cols; if (t == 0) sc = scale0; }
        const int col0 = colt + wc * 32 + 8 * fq, bcol0 = u.pn * BM + wc * 32 + 8 * fq;
        f32x4 bv[2][2];
#pragma unroll
        for (int bj = 0; bj < 2; ++bj)
#pragma unroll
            for (int n = 0; n < 2; ++n) bv[bj][n] = bias ? *(const f32x4*)(bias + bcol0 + bj * HALF + 4 * n) : (f32x4){0.f, 0.f, 0.f, 0.f};
#pragma unroll
        for (int ai = 0; ai < 2; ++ai)
#pragma unroll
            for (int m = 0; m < 4; ++m) { bf16_t* rowp = base + (size_t)(row0 + ai * HALF + m * 16) * ldc + col0;
#pragma unroll
                for (int bj = 0; bj < 2; ++bj) { f32x4 v0 = acc[ai][bj][m][0] + bv[bj][0], v1 = acc[ai][bj][m][1] + bv[bj][1];
                    if (ACT == 1) { f32x2 a = gelu_pk((f32x2){v0[0], v0[1]}), b = gelu_pk((f32x2){v0[2], v0[3]}), c = gelu_pk((f32x2){v1[0], v1[1]}), d = gelu_pk((f32x2){v1[2], v1[3]});
                        v0 = (f32x4){a.x, a.y, b.x, b.y}; v1 = (f32x4){c.x, c.y, d.x, d.y}; }
                    v0 = v0 * sc; v1 = v1 * sc; u32x4 w; w.x = cvt_pk_bf16(v0[0], v0[1]); w.y = cvt_pk_bf16(v0[2], v0[3]); w.z = cvt_pk_bf16(v1[0], v1[1]); w.w = cvt_pk_bf16(v1[2], v1[3]);
                    *(u32x4*)(rowp + bj * HALF) = w; } }
    }
};
template <class Epi, class Sched, bool ALIGN_EPI = false, bool SP2 = false>
__device__ __forceinline__ void gemm_phase(PG8_LAS unsigned char* lds, const Gemm g, const Sched& S, const Epi& E) {
    int tid_ = threadIdx.x; asm volatile("" : "+v"(tid_));
    const int tid = tid_, wid = __builtin_amdgcn_readfirstlane(tid >> 6), lane = tid & 63, wr = wid >> 2, wc = wid & 3, fr = lane & 15, fq = lane >> 4;
    const int K = g.K, nt = K / BK;
    unsigned voffA[2], voffB[2];
#pragma unroll
    for (int i = 0; i < 2; ++i) { int R, C; stage_rc(tid * 16 + i * 8192, R, C); const int Rb = Epi::PERM ? ((R & ~31) + perm32(R & 31)) : R;
        voffA[i] = (unsigned)(R * K + C) * 2u; voffB[i] = (unsigned)(Rb * K + C) * 2u; }
    const size_t kstep = (size_t)(BK * 2);
    const size_t hstep = (size_t)HALF * K * 2;
    const size_t tstep = 2 * hstep;
    const unsigned ldsw = (unsigned)wid * 1024u;
    const int aoff = lds_byte(wr * 64 + fr, fq * 8), boff = lds_byte(wc * 32 + fr, fq * 8);
#define PG8_SA(b, h) (((b) * 2 + (h)) * HTB)
#define PG8_SB(b, h) ((4 + (b) * 2 + (h)) * HTB)
#define PG8_STAGE(bufoff, gbase, voff) do { _Pragma("unroll") for (int _i = 0; _i < 2; ++_i) \
        __builtin_amdgcn_global_load_lds((const unsigned*)((const char*)(gbase) + (voff)[_i]), (PG8_LAS unsigned*)(lds + (bufoff) + ldsw + _i * 8192), 16, 0, 0); } while (0)
#define PG8_LDA(dst, b, h) do { _Pragma("unroll") for (int m = 0; m < 4; ++m) _Pragma("unroll") for (int k = 0; k < 2; ++k) dst[m][k] = *(const PG8_LAS bf16x8*)(lds + PG8_SA(b, h) + aoff + m * 2048 + k * 1024); } while (0)
#define PG8_LDB(dst, b, h) do { _Pragma("unroll") for (int n = 0; n < 2; ++n) _Pragma("unroll") for (int k = 0; k < 2; ++k) dst[n][k] = *(const PG8_LAS bf16x8*)(lds + PG8_SB(b, h) + boff + n * 2048 + k * 1024); } while (0)
#define PG8_MMA(ai, bj, At, Bt) do { __builtin_amdgcn_s_setprio(1); _Pragma("unroll") for (int m = 0; m < 4; ++m) _Pragma("unroll") for (int n = 0; n < 2; ++n) _Pragma("unroll") for (int k = 0; k < 2; ++k) \
        acc[ai][bj][m][n] = __builtin_amdgcn_mfma_f32_16x16x32_bf16(Bt[n][k], At[m][k], acc[ai][bj][m][n], 0, 0, 0); __builtin_amdgcn_s_setprio(0); } while (0)
#define PG8_WAIT_V(n) asm volatile("s_waitcnt vmcnt(" #n ")" ::: "memory")
#define PG8_WAIT_L(n) asm volatile("s_waitcnt lgkmcnt(" #n ")" ::: "memory")
#define PG8_BAR __builtin_amdgcn_s_barrier()
#define PG8_SCHED __builtin_amdgcn_sched_barrier(0)
    Unit cur, nxt; int ui = 0;
    if (!S.next(0, cur)) return;
    f32x4 acc[2][2][4][2];
#pragma unroll
    for (int a = 0; a < 2; ++a)
#pragma unroll
        for (int b = 0; b < 2; ++b)
#pragma unroll
            for (int m = 0; m < 4; ++m)
#pragma unroll
                for (int n = 0; n < 2; ++n) acc[a][b][m][n] = (f32x4){0.f, 0.f, 0.f, 0.f};
    bf16x8 At[4][2], B0[2][2], B1[2][2];
    const char* cA = (const char*)g.A + (size_t)cur.pm * tstep; const char* cB = (const char*)g.Bt + (size_t)cur.pn * tstep;
    S.a_ready(cur);
    if constexpr (SP2) {
        PG8_STAGE(PG8_SB(0, 0), cB, voffB); PG8_STAGE(PG8_SB(0, 1), cB + hstep, voffB); PG8_STAGE(PG8_SA(0, 0), cA, voffA); PG8_STAGE(PG8_SA(0, 1), cA + hstep, voffA);
        if (wr == 1) PG8_BAR;
        PG8_WAIT_V(2); PG8_BAR;
        PG8_STAGE(PG8_SB(1, 0), cB + kstep, voffB); PG8_STAGE(PG8_SA(1, 0), cA + kstep, voffA); PG8_STAGE(PG8_SB(1, 1), cB + hstep + kstep, voffB);
        PG8_WAIT_V(6); PG8_BAR;
    } else {
        PG8_STAGE(PG8_SB(0, 0), cB, voffB); PG8_STAGE(PG8_SA(0, 0), cA, voffA); PG8_STAGE(PG8_SB(0, 1), cB + hstep, voffB); PG8_STAGE(PG8_SA(0, 1), cA + hstep, voffA);
        if (wr == 1) PG8_BAR;
        PG8_WAIT_V(4); PG8_BAR;
        PG8_STAGE(PG8_SB(1, 0), cB + kstep, voffB); PG8_STAGE(PG8_SA(1, 0), cA + kstep, voffA); PG8_STAGE(PG8_SB(1, 1), cB + hstep + kstep, voffB);
        PG8_WAIT_V(6); PG8_BAR;
    }
    for (;;) {
        const bool has_next = S.next(ui + 1, nxt);
        const char* nA = has_next ? (const char*)g.A + (size_t)nxt.pm * tstep : cA; const char* nB = has_next ? (const char*)g.Bt + (size_t)nxt.pn * tstep : cB;
        for (int t = 0; t < nt; t += 2) {
            const bool last = (t == nt - 2);
            const char* a1 = cA + (size_t)(t + 1) * kstep;
            const char* a2 = last ? nA : cA + (size_t)(t + 2) * kstep; const char* b2 = last ? nB : cB + (size_t)(t + 2) * kstep;
            const char* a3 = a2 + kstep; const char* b3 = b2 + kstep;
            if (last && has_next) S.a_ready(nxt);
            if constexpr (SP2) {
            PG8_LDB(B0, 0, 0); PG8_LDB(B1, 0, 1); PG8_SCHED; PG8_LDA(At, 0, 0); PG8_STAGE(PG8_SA(1, 1), a1 + hstep, voffA);
            PG8_WAIT_V(8); PG8_WAIT_L(0); PG8_BAR; PG8_MMA(0, 0, At, B0); PG8_MMA(0, 1, At, B1); PG8_BAR; PG8_SCHED;
            PG8_LDA(At, 0, 1); PG8_STAGE(PG8_SB(0, 0), b2, voffB); PG8_STAGE(PG8_SB(0, 1), b2 + hstep, voffB); PG8_STAGE(PG8_SA(0, 0), a2, voffA);
            PG8_WAIT_V(8); PG8_WAIT_L(0); PG8_BAR; PG8_MMA(1, 0, At, B0); PG8_MMA(1, 1, At, B1); PG8_BAR; PG8_SCHED;
            PG8_LDB(B0, 1, 0); PG8_LDB(B1, 1, 1); PG8_SCHED; PG8_LDA(At, 1, 0); PG8_STAGE(PG8_SA(0, 1), a2 + hstep, voffA);
            PG8_WAIT_V(8); PG8_WAIT_L(0); PG8_BAR; PG8_MMA(0, 0, At, B0); PG8_MMA(0, 1, At, B1); PG8_BAR; PG8_SCHED;
            PG8_LDA(At, 1, 1); PG8_STAGE(PG8_SB(1, 0), b3, voffB); PG8_STAGE(PG8_SB(1, 1), b3 + hstep, voffB); PG8_STAGE(PG8_SA(1, 0), a3, voffA);
            PG8_WAIT_V(8); PG8_WAIT_L(0); PG8_BAR; PG8_MMA(1, 0, At, B0); PG8_MMA(1, 1, At, B1); PG8_BAR; PG8_SCHED;
            } else {
            PG8_LDB(B0, 0, 0); PG8_SCHED; PG8_LDA(At, 0, 0); PG8_STAGE(PG8_SA(1, 1), a1 + hstep, voffA);
            PG8_WAIT_L(8); PG8_BAR; PG8_WAIT_L(0); PG8_MMA(0, 0, At, B0); PG8_BAR; PG8_SCHED;
            PG8_LDB(B1, 0, 1); PG8_STAGE(PG8_SB(0, 0), b2, voffB);
            PG8_BAR; PG8_WAIT_L(0); PG8_MMA(0, 1, At, B1); PG8_BAR;
            PG8_LDA(At, 0, 1); PG8_STAGE(PG8_SA(0, 0), a2, voffA);
            PG8_BAR; PG8_WAIT_L(0); PG8_MMA(1, 0, At, B0); PG8_BAR; PG8_SCHED;
            PG8_STAGE(PG8_SB(0, 1), b2 + hstep, voffB);
            PG8_WAIT_V(6); PG8_BAR; PG8_MMA(1, 1, At, B1); PG8_BAR;
            PG8_LDB(B0, 1, 0); PG8_SCHED; PG8_LDA(At, 1, 0); PG8_STAGE(PG8_SA(0, 1), a2 + hstep, voffA);
            PG8_WAIT_L(8); PG8_BAR; PG8_WAIT_L(0); PG8_MMA(0, 0, At, B0); PG8_BAR; PG8_SCHED;
            PG8_LDB(B1, 1, 1); PG8_STAGE(PG8_SB(1, 0), b3, voffB);
            PG8_BAR; PG8_WAIT_L(0); PG8_MMA(0, 1, At, B1); PG8_BAR;
            PG8_LDA(At, 1, 1); PG8_STAGE(PG8_SA(1, 0), a3, voffA);
            PG8_BAR; PG8_WAIT_L(0); PG8_MMA(1, 0, At, B0); PG8_BAR; PG8_SCHED;
            PG8_STAGE(PG8_SB(1, 1), b3 + hstep, voffB);
            PG8_WAIT_V(6); PG8_BAR; PG8_MMA(1, 1, At, B1); PG8_BAR;
            }
        }
        if constexpr (ALIGN_EPI) { if (wr == 0) PG8_BAR; }
        if constexpr (!Epi::AFTER_DRAIN) { E(acc, cur, wr, wc, fr, fq); S.done(cur); }
        if (!has_next) break;
#pragma unroll
        for (int a = 0; a < 2; ++a)
#pragma unroll
            for (int b = 0; b < 2; ++b)
#pragma unroll
                for (int m = 0; m < 4; ++m)
#pragma unroll
                    for (int n = 0; n < 2; ++n) acc[a][b][m][n] = (f32x4){0.f, 0.f, 0.f, 0.f};
        cur = nxt; cA = nA; cB = nB; ++ui;
        if constexpr (ALIGN_EPI) { if (wr == 1) PG8_BAR; }
    }
    PG8_WAIT_V(0);
    if constexpr (!ALIGN_EPI) { if (wr == 0) PG8_BAR; }
    PG8_BAR;
    if constexpr (Epi::AFTER_DRAIN) { E.fused(acc, cur, wr, wc, fr, fq, lds, wid, lane); S.done(cur); }
#undef PG8_SA
#undef PG8_SB
#undef PG8_STAGE
#undef PG8_LDA
#undef PG8_LDB
#undef PG8_MMA
#undef PG8_WAIT_V
#undef PG8_WAIT_L
#undef PG8_BAR
#undef PG8_SCHED
}
}

#ifndef MK_N_LAUNCHES
#define MK_N_LAUNCHES 1
#endif
#ifndef ATT_EARLY_EXIT
#define ATT_EARLY_EXIT 1
#endif
constexpr int NWAVES = 8;
constexpr int M = 16384, DM = 1024, SEQ = 2048, DEPTH = 4, NIN = 2816, DFF = 4096, PLE = 256;
constexpr float EPS = 1e-6f;
constexpr float C2 = 0.125f * 1.4426950408889634f;
constexpr int NPHASE = 1 + 6 * DEPTH;
#ifndef PROBE_B
#define PROBE_B 1
#endif
#ifndef PROBE_ATT
#define PROBE_ATT 1
#endif
#ifndef PROBE_SYNC
#define PROBE_SYNC 1
#endif
#ifndef PROBE_P
#define PROBE_P 1
#endif
#ifndef PROBE_A
#define PROBE_A 1
#endif
#ifndef PROBE_D
#define PROBE_D 1
#endif

typedef unsigned short bf16;
#define LAS __attribute__((address_space(3)))
typedef unsigned v4u __attribute__((ext_vector_type(4)));
typedef unsigned v2u __attribute__((ext_vector_type(2)));
typedef float f32x4 __attribute__((ext_vector_type(4)));
typedef float f32x2 __attribute__((ext_vector_type(2)));
typedef float f32x16 __attribute__((ext_vector_type(16)));
typedef short bf16x8 __attribute__((ext_vector_type(8)));
typedef short s16x4 __attribute__((ext_vector_type(4)));
#define LDS_WAIT() asm volatile("s_waitcnt lgkmcnt(0)" ::: "memory")

constexpr size_t E_WIN = 0, E_WOUT = (size_t)NIN * DM, E_W1 = E_WOUT + (size_t)DM * DM, E_W2 = E_W1 + (size_t)DFF * DM, E_WG = E_W2 + (size_t)DFF * DM, E_WP = E_WG + (size_t)DM * DM,
                 E_WLAYER = E_WP + (size_t)PLE * DM;
constexpr size_t WS_W = 0, WS_WSB = WS_W + (size_t)DEPTH * E_WLAYER * 2, WS_SS = WS_WSB + (size_t)DEPTH * 4 * 128 * 128 * 2, WS_HB = WS_SS + (size_t)3 * M * 16 * 4,
                 WS_LO = WS_HB + (size_t)M * DM * 2, WS_XB = WS_LO + (size_t)M * DM * 2, WS_BIG = WS_XB + (size_t)M * DM * 2, WS_END = WS_BIG + (size_t)M * DFF * 2;
constexpr size_t SLAB_E = (size_t)SEQ * DFF, O_CONV = 0, O_Q = O_CONV + (size_t)3 * SEQ * 256, O_K = O_Q + (size_t)SEQ * 512, O_VT = O_K + (size_t)SEQ * 512, O_CU = O_VT + (size_t)SEQ * 512,
                 O_VNT = O_CU + (size_t)SEQ * 256, O_Y = O_VNT + (size_t)SEQ * 256, O_PB = O_Y + (size_t)SEQ * DM, O_END = O_PB + (size_t)SEQ * PLE;
static_assert(O_END <= SLAB_E, "a batch element's mixer tensors + its bf16 p rows fit under its F rows");
constexpr size_t WS_CTL = WS_END, CTL_BYTES = 32768, WS_TOTAL = WS_CTL + CTL_BYTES;
constexpr int RING_BYTES = 131072, LDS_BYTES = 132096;

__device__ __forceinline__ unsigned f2bf(float f) { unsigned u = __builtin_bit_cast(unsigned, f); return (u + 0x7fffu + ((u >> 16) & 1u)) >> 16; }
typedef __bf16 bf16x2_t __attribute__((ext_vector_type(2)));
__device__ __forceinline__ unsigned pk2(float lo, float hi) { f32x2 v = {lo, hi}; bf16x2_t b = __builtin_convertvector(v, bf16x2_t); return __builtin_bit_cast(unsigned, b); }
__device__ __forceinline__ float bflo(unsigned u) { return __builtin_bit_cast(float, u << 16); }
__device__ __forceinline__ float bfhi(unsigned u) { return __builtin_bit_cast(float, u & 0xffff0000u); }
__device__ __forceinline__ float wave_sum(float v) {
#pragma unroll
    for (int o = 1; o < 64; o <<= 1) v += __shfl_xor(v, o);
    return v;
}

__device__ __forceinline__ float row_rs(const float* ssp, int r) {
    const f32x4* q = (const f32x4*)(ssp + (size_t)r * 16); const f32x4 a = q[0], b = q[1], c = q[2], d = q[3];
    const float s = ((a[0] + a[1]) + (a[2] + a[3])) + ((b[0] + b[1]) + (b[2] + b[3])) + ((c[0] + c[1]) + (c[2] + c[3])) + ((d[0] + d[1]) + (d[2] + d[3]));
    return rsqrtf(s * (1.f / 1024.f) + EPS);
}
struct EpiInProj {
    static constexpr bool PERM = true, AFTER_DRAIN = false;
    const float* ss; bf16* conv; bf16* q; bf16* k; bf16* vt; bf16* cu; bf16* vnt; const float* qg; const float* kg; const float* sg;
    __device__ __forceinline__ void operator()(const pg8::f32x4 (&acc)[2][2][4][2], const pg8::Unit& u, int wr, int wc, int fr, int fq) const {
        const int sec = u.pn;
        const int row0 = u.pm * 256 + wr * 64 + fr;
        const int cw = 64 * wc + 8 * fq;
        const bool normed = (sec >= 3 && sec < 7) || sec == 10;
        float rsv[8];
#pragma unroll
        for (int g = 0; g < 8; ++g) { rsv[g] = row_rs(ss, row0 + (g >> 2) * 128 + (g & 3) * 16); if (g & 1) asm volatile("" : "+v"(rsv[g - 1]), "+v"(rsv[g]) :: "memory"); }
        f32x4 gv[2][2];
#pragma unroll
        for (int bj = 0; bj < 2; ++bj)
#pragma unroll
            for (int n = 0; n < 2; ++n) {
                if (sec >= 3 && sec < 7) { const float* g = sec < 5 ? qg : kg; const float sc = sec < 5 ? C2 : 1.f; gv[bj][n] = *(const f32x4*)(g + 32 * bj + 8 * fq + 4 * n) * sc; }
                else if (sec == 10) gv[bj][n] = *(const f32x4*)(sg + cw + 32 * bj + 4 * n);
                else gv[bj][n] = (f32x4){1.f, 1.f, 1.f, 1.f};
            }
#pragma unroll
        for (int ai = 0; ai < 2; ++ai)
#pragma unroll
            for (int m = 0; m < 4; ++m) {
                const int r = row0 + ai * 128 + m * 16;
                const float rs = rsv[ai * 4 + m];
                f32x4 v[2][2];
#pragma unroll
                for (int bj = 0; bj < 2; ++bj)
#pragma unroll
                    for (int n = 0; n < 2; ++n) v[bj][n] = acc[ai][bj][m][n] * rs;
                if (sec >= 9) {
#pragma unroll
                    for (int bj = 0; bj < 2; ++bj)
#pragma unroll
                        for (int n = 0; n < 2; ++n) { const pg8::f32x2 a = pg8::gelu_pk((pg8::f32x2){v[bj][n][0], v[bj][n][1]}), b = pg8::gelu_pk((pg8::f32x2){v[bj][n][2], v[bj][n][3]}); v[bj][n] = (f32x4){a.x, a.y, b.x, b.y}; }
                }
                if (normed) {
                    float s2 = 0.f;
#pragma unroll
                    for (int bj = 0; bj < 2; ++bj)
#pragma unroll
                        for (int n = 0; n < 2; ++n) { const f32x4 x = v[bj][n]; s2 += (x[0] * x[0] + x[1] * x[1]) + (x[2] * x[2] + x[3] * x[3]); }
                    s2 += __shfl_xor(s2, 16); s2 += __shfl_xor(s2, 32);
                    const float rn = rsqrtf(s2 * (1.f / 64.f) + EPS);
#pragma unroll
                    for (int bj = 0; bj < 2; ++bj)
#pragma unroll
                        for (int n = 0; n < 2; ++n) v[bj][n] = v[bj][n] * rn * gv[bj][n];
                }
                const int s = r & 2047; const size_t bo = (size_t)(r >> 11) * SLAB_E;
                if (sec == 10) {
                    const int sl = s & 127;
                    bf16* base = vnt + bo + ((((size_t)(wc * 16 + (s >> 7)) * 2) * 8 + (sl >> 4)) * 64 + ((sl >> 3) & 1) * 32 + 8 * fq) * 8 + (sl & 7);
#pragma unroll
                    for (int bj = 0; bj < 2; ++bj)
#pragma unroll
                        for (int n = 0; n < 2; ++n)
#pragma unroll
                            for (int j = 0; j < 4; ++j) base[(size_t)bj * 8 * 64 * 8 + (4 * n + j) * 8] = (bf16)f2bf(v[bj][n][j]);
                } else if (sec == 7 || sec == 8) {
                    const int kk_ = s & 31;
                    bf16* base = vt + bo + (((size_t)((4 * (sec - 7) + wc) * 64 + (s >> 5)) * 4 + (kk_ >> 4)) * 64 + ((kk_ >> 3) & 1) * 32 + 8 * fq) * 8 + (kk_ & 7);
#pragma unroll
                    for (int bj = 0; bj < 2; ++bj)
#pragma unroll
                        for (int n = 0; n < 2; ++n)
#pragma unroll
                            for (int j = 0; j < 4; ++j) base[(size_t)bj * 2 * 64 * 8 + (4 * n + j) * 8] = (bf16)f2bf(v[bj][n][j]);
                } else if (sec >= 3 && sec < 7) {
                    const bool isq = sec < 5;
                    const int sl = s & 31, pos = isq ? sl : ((sl & 0x13) | ((sl & 4) << 1) | ((sl & 8) >> 1));
                    bf16* base = (isq ? q : k) + bo + (((size_t)((4 * ((sec - 3) & 1) + wc) * 64 + (s >> 5)) * 4 + (fq >> 1)) * 64 + (fq & 1) * 32 + pos) * 8;
#pragma unroll
                    for (int bj = 0; bj < 2; ++bj) { v4u w; w.x = pk2(v[bj][0][0], v[bj][0][1]); w.y = pk2(v[bj][0][2], v[bj][0][3]); w.z = pk2(v[bj][1][0], v[bj][1][1]); w.w = pk2(v[bj][1][2], v[bj][1][3]);
                        *(v4u*)(base + (size_t)bj * 2 * 64 * 8) = w; }
                } else {
                    bf16* dst; int ld;
                    if (sec < 3) { dst = conv + bo + (size_t)sec * SEQ * 256 + cw; ld = 256; }
                    else { dst = cu + bo + cw; ld = 256; }
                    dst += (size_t)s * ld;
#pragma unroll
                    for (int bj = 0; bj < 2; ++bj) { v4u w; w.x = pk2(v[bj][0][0], v[bj][0][1]); w.y = pk2(v[bj][0][2], v[bj][0][3]); w.z = pk2(v[bj][1][0], v[bj][1][1]); w.w = pk2(v[bj][1][2], v[bj][1][3]);
                        *(v4u*)(dst + 32 * bj) = w; }
                }
            }
    }
};

__device__ __forceinline__ void unpk(const v4u w, f32x4& a, f32x4& b) { a = (f32x4){bflo(w.x), bfhi(w.x), bflo(w.y), bfhi(w.y)}; b = (f32x4){bflo(w.z), bfhi(w.z), bflo(w.w), bfhi(w.w)}; }
__device__ __forceinline__ void split_store(const f32x4 h0, const f32x4 h1, bf16* hi, bf16* lo) {
    v4u w; w.x = pk2(h0[0], h0[1]); w.y = pk2(h0[2], h0[3]); w.z = pk2(h1[0], h1[1]); w.w = pk2(h1[2], h1[3]); *(v4u*)hi = w;
    f32x4 a, b; unpk(w, a, b); const f32x4 d0 = h0 - a, d1 = h1 - b;
    v4u l; l.x = pk2(d0[0], d0[1]); l.y = pk2(d0[2], d0[3]); l.z = pk2(d1[0], d1[1]); l.w = pk2(d1[2], d1[3]); *(v4u*)lo = l;
}
struct EpiRes {
    static constexpr bool PERM = true, AFTER_DRAIN = false;
    bf16* hi; bf16* lo; float* ssout; int use_lo, write_lo;
    __device__ __forceinline__ void operator()(const pg8::f32x4 (&acc)[2][2][4][2], const pg8::Unit& u, int wr, int wc, int fr, int fq) const {
        const int row0 = u.pm * 256 + wr * 64 + fr, col0 = u.pn * 256 + wc * 32 + 8 * fq;
        constexpr int LA = 2;
        v4u bq[8][4];
#pragma unroll
        for (int g = 0; g < LA; ++g) { const size_t off = (size_t)(row0 + (g >> 2) * 128 + (g & 3) * 16) * DM + col0;
#pragma unroll
            for (int bj = 0; bj < 2; ++bj) { bq[g][2 * bj] = *(const v4u*)(hi + off + bj * 128); bq[g][2 * bj + 1] = use_lo ? *(const v4u*)(lo + off + bj * 128) : (v4u){0u, 0u, 0u, 0u}; } }
#pragma unroll
        for (int g = 0; g < 8; ++g) {
            if (g + LA < 8) { const int gn = g + LA; const size_t off = (size_t)(row0 + (gn >> 2) * 128 + (gn & 3) * 16) * DM + col0;
#pragma unroll
                for (int bj = 0; bj < 2; ++bj) { bq[gn][2 * bj] = *(const v4u*)(hi + off + bj * 128); bq[gn][2 * bj + 1] = use_lo ? *(const v4u*)(lo + off + bj * 128) : (v4u){0u, 0u, 0u, 0u}; } }
            const int ai = g >> 2, m = g & 3;
            const int r = row0 + ai * 128 + m * 16; const size_t off = (size_t)r * DM + col0; float s2 = 0.f;
#pragma unroll
            for (int bj = 0; bj < 2; ++bj) {
                f32x4 a0, a1, l0, l1; unpk(bq[g][2 * bj], a0, a1); unpk(bq[g][2 * bj + 1], l0, l1);
                const f32x4 h0 = (a0 + l0) + acc[ai][bj][m][0], h1 = (a1 + l1) + acc[ai][bj][m][1];
                if (write_lo) split_store(h0, h1, hi + off + bj * 128, lo + off + bj * 128);
                else { v4u w; w.x = pk2(h0[0], h0[1]); w.y = pk2(h0[2], h0[3]); w.z = pk2(h1[0], h1[1]); w.w = pk2(h1[2], h1[3]); *(v4u*)(hi + off + bj * 128) = w; }
                s2 += (h0[0] * h0[0] + h0[1] * h0[1]) + (h0[2] * h0[2] + h0[3] * h0[3]) + (h1[0] * h1[0] + h1[1] * h1[1]) + (h1[2] * h1[2] + h1[3] * h1[3]);
            }
            s2 += __shfl_xor(s2, 16); s2 += __shfl_xor(s2, 32);
            if (fq == 0) ssout[(size_t)r * 16 + u.pn * 4 + wc] = s2;
            asm volatile("" ::: "memory");
        }
    }
};
struct EpiFF1 {
    static constexpr bool PERM = true, AFTER_DRAIN = false;
    const float* ss; bf16* f;
    __device__ __forceinline__ void operator()(const pg8::f32x4 (&acc)[2][2][4][2], const pg8::Unit& u, int wr, int wc, int fr, int fq) const {
        const int row0 = u.pm * 256 + wr * 64 + fr, col0 = u.pn * 256 + wc * 32 + 8 * fq;
        float rsv[8];
#pragma unroll
        for (int g = 0; g < 8; ++g) { rsv[g] = row_rs(ss, row0 + (g >> 2) * 128 + (g & 3) * 16); if (g & 1) asm volatile("" : "+v"(rsv[g - 1]), "+v"(rsv[g]) :: "memory"); }
#pragma unroll
        for (int ai = 0; ai < 2; ++ai)
#pragma unroll
            for (int m = 0; m < 4; ++m) {
                const int r = row0 + ai * 128 + m * 16; const float rs = rsv[ai * 4 + m]; bf16* dst = f + (size_t)r * DFF + col0;
#pragma unroll
                for (int bj = 0; bj < 2; ++bj) {
                    f32x4 a = acc[ai][bj][m][0] * rs, b = acc[ai][bj][m][1] * rs;
#pragma unroll
                    for (int j = 0; j < 4; ++j) { a[j] = fmaxf(a[j], 0.f); a[j] *= a[j]; b[j] = fmaxf(b[j], 0.f); b[j] *= b[j]; }
                    v4u w; w.x = pk2(a[0], a[1]); w.y = pk2(a[2], a[3]); w.z = pk2(b[0], b[1]); w.w = pk2(b[2], b[3]); *(v4u*)(dst + bj * 128) = w;
                }
            }
    }
};
struct EpiT {
    static constexpr bool PERM = true, AFTER_DRAIN = false;
    bf16* t;
    __device__ __forceinline__ void operator()(const pg8::f32x4 (&acc)[2][2][4][2], const pg8::Unit& u, int wr, int wc, int fr, int fq) const {
        const int row0 = u.pm * 256 + wr * 64 + fr, col0 = u.pn * 256 + wc * 32 + 8 * fq;
#pragma unroll
        for (int ai = 0; ai < 2; ++ai)
#pragma unroll
            for (int m = 0; m < 4; ++m) {
                bf16* dst = t + (size_t)(row0 + ai * 128 + m * 16) * DM + col0;
#pragma unroll
                for (int bj = 0; bj < 2; ++bj) { const f32x4 a = acc[ai][bj][m][0], b = acc[ai][bj][m][1];
                    v4u w; w.x = pk2(a[0], a[1]); w.y = pk2(a[2], a[3]); w.z = pk2(b[0], b[1]); w.w = pk2(b[2], b[3]); *(v4u*)(dst + bj * 128) = w; }
            }
    }
};
struct EpiGate {
    static constexpr bool PERM = true, AFTER_DRAIN = false;
    const float* ss; const bf16* hi; bf16* lo; bf16* tx; float* ssout; float* fout; int use_lo;
    __device__ __forceinline__ void operator()(const pg8::f32x4 (&acc)[2][2][4][2], const pg8::Unit& u, int wr, int wc, int fr, int fq) const {
        const int row0 = u.pm * 256 + wr * 64 + fr, col0 = u.pn * 256 + wc * 32 + 8 * fq;
        float rsv[8];
#pragma unroll
        for (int g = 0; g < 8; ++g) { rsv[g] = row_rs(ss, row0 + (g >> 2) * 128 + (g & 3) * 16) * (-1.4426950408889634f); if (g & 1) asm volatile("" : "+v"(rsv[g - 1]), "+v"(rsv[g]) :: "memory"); }
        v4u hq[16], lq[16], tq[16];
        { const size_t off = (size_t)row0 * DM + col0; tq[0] = *(const v4u*)(tx + off); hq[0] = *(const v4u*)(hi + off); lq[0] = use_lo ? *(const v4u*)(lo + off) : (v4u){0u, 0u, 0u, 0u}; }
        float s2 = 0.f;
#pragma unroll
        for (int q = 0; q < 16; ++q) {
            if (q + 1 < 16) { const int gn = (q + 1) >> 1, bn = (q + 1) & 1; const size_t off = (size_t)(row0 + (gn >> 2) * 128 + (gn & 3) * 16) * DM + col0 + bn * 128;
                tq[q + 1] = *(const v4u*)(tx + off); hq[q + 1] = *(const v4u*)(hi + off); lq[q + 1] = use_lo ? *(const v4u*)(lo + off) : (v4u){0u, 0u, 0u, 0u}; }
            const int g = q >> 1, bj = q & 1, ai = g >> 2, m = g & 3;
            const int r = row0 + ai * 128 + m * 16; const float rs = rsv[g]; const size_t off = (size_t)r * DM + col0 + bj * 128;
            f32x4 t0, t1, a0, a1, l0, l1; unpk(tq[q], t0, t1); unpk(hq[q], a0, a1); unpk(lq[q], l0, l1);
            f32x4 g0 = acc[ai][bj][m][0] * rs, g1 = acc[ai][bj][m][1] * rs;
#pragma unroll
            for (int j = 0; j < 4; ++j) { g0[j] = __builtin_amdgcn_rcpf(1.f + __builtin_amdgcn_exp2f(g0[j])); g1[j] = __builtin_amdgcn_rcpf(1.f + __builtin_amdgcn_exp2f(g1[j])); }
            const f32x4 h0 = (a0 + l0) + g0 * t0, h1 = (a1 + l1) + g1 * t1;
            if (!fout) { v4u w; w.x = pk2(h0[0], h0[1]); w.y = pk2(h0[2], h0[3]); w.z = pk2(h1[0], h1[1]); w.w = pk2(h1[2], h1[3]); *(v4u*)(tx + off) = w; }
            if (fout) { *(f32x4*)(fout + off) = h0; *(f32x4*)(fout + off + 4) = h1; }
            s2 += (h0[0] * h0[0] + h0[1] * h0[1]) + (h0[2] * h0[2] + h0[3] * h0[3]) + (h1[0] * h1[0] + h1[1] * h1[1]) + (h1[2] * h1[2] + h1[3] * h1[3]);
            if (bj == 1) {
                s2 += __shfl_xor(s2, 16); s2 += __shfl_xor(s2, 32);
                if (fq == 0 && !fout) ssout[(size_t)r * 16 + u.pn * 4 + wc] = s2;
                s2 = 0.f;
            }
            asm volatile("" ::: "memory");
        }
    }
};

struct TSched {
    int c, c0, G;
    __device__ __forceinline__ bool next(int i, pg8::Unit& u) const {
        if (c < c0) return false;
        if (G == 256 && c0 == 192) { if (i >= 4) return false; u.pm = 8 * (c & 7) + ((c - c0) >> 3); u.pn = i; return true; }
        const int un = (c - c0) + i * (G - c0); if (un >= 256) return false; u.pm = un >> 2; u.pn = un & 3; return true; }
    __device__ __forceinline__ void a_ready(const pg8::Unit&) const {}
    __device__ __forceinline__ void done(const pg8::Unit&) const {}
};
struct TrJob { const float* W; bf16* WT; const float* g; int K, N, item, hperm; };
__device__ __forceinline__ void tr_load(const TrJob& j, int lane, f32x4 (&v)[8]) {
    const int nblk = j.N / 32, kb = j.item / nblk, nb = j.item % nblk, k0 = 64 * kb, n0 = 32 * nb;
    const int kr = lane >> 3, nq = (lane & 7) * 4;
#pragma unroll
    for (int i = 0; i < 8; ++i) v[i] = *(const f32x4*)(j.W + (size_t)(k0 + 8 * i + kr) * j.N + n0 + nq);
    if (j.g) {
#pragma unroll
        for (int i = 0; i < 8; ++i) v[i] = v[i] * j.g[k0 + 8 * i + kr];
    }
}
__device__ __forceinline__ void tr_finish(const TrJob& j, int lane, const f32x4 (&v)[8], LAS float* scr) {
    const int nblk = j.N / 32, kb = j.item / nblk, nb = j.item % nblk, k0 = 64 * kb, n0 = 32 * nb;
    const int kr = lane >> 3, nq = (lane & 7) * 4;
#pragma unroll
    for (int i = 0; i < 8; ++i) { LAS float* d = scr + (8 * i + kr) * 33 + nq; d[0] = v[i][0]; d[1] = v[i][1]; d[2] = v[i][2]; d[3] = v[i][3]; }
    LDS_WAIT(); asm volatile("" ::: "memory");
    int d0 = n0; if (j.hperm) { const int gi = (n0 >> 5) & 7; d0 = (n0 & ~255) + 32 * (4 * (gi & 1) + (gi >> 1)); }
    const int c = lane & 7;
#pragma unroll
    for (int q = 0; q < 4; ++q) { const int n = (lane >> 3) + 8 * q; const LAS float* sp = scr + (8 * c) * 33 + n;
        v4u o; o.x = pk2(sp[0 * 33], sp[1 * 33]); o.y = pk2(sp[2 * 33], sp[3 * 33]); o.z = pk2(sp[4 * 33], sp[5 * 33]); o.w = pk2(sp[6 * 33], sp[7 * 33]);
        *(v4u*)(j.WT + (size_t)(d0 + n) * j.K + k0 + 8 * c) = o; }
    LDS_WAIT(); asm volatile("" ::: "memory");
}

__device__ __forceinline__ int crow(int r, int hf) { return (r & 3) + 8 * (r >> 2) + 4 * hf; }
__device__ __forceinline__ bool attn_tile(const bf16x8 (&kf)[4], const bf16x8 (&vf)[4], const bf16x8 (&qr)[4], f32x16& o0, f32x16& o1, float& carry, bool diag, int t, int hf) {
    f32x16 z;
#pragma unroll
    for (int r = 0; r < 16; ++r) z[r] = 0.f;
#pragma unroll
    for (int kk = 0; kk < 4; ++kk) z = __builtin_amdgcn_mfma_f32_32x32x16_bf16(kf[kk], qr[kk], z, 0, 0, 0);
    float e[16], w[16];
#pragma unroll
    for (int r = 0; r < 16; ++r) {
        float ev = __builtin_amdgcn_exp2f(__builtin_amdgcn_fmed3f(z[r], -3.0e38f, 31.f));
        if (diag) { const bool valid = (16 * (r >> 3) + 8 * hf + (r & 7)) < t; ev = valid ? ev : 0.f; }
        e[r] = ev;
    }
    float R[2], fb[2], ia_[2];
#pragma unroll
    for (int ks = 0; ks < 2; ++ks) {
        const int a = 8 * ks, b = 8 * ks + 4;
        const float da0 = 1.f + e[a], da1 = 1.f + e[a + 1], da2 = 1.f + e[a + 2], da3 = 1.f + e[a + 3];
        const float db0 = 1.f + e[b], db1 = 1.f + e[b + 1], db2 = 1.f + e[b + 2], db3 = 1.f + e[b + 3];
        const float pa2 = da0 * da1, pa3 = pa2 * da2, Pa = pa3 * da3;
        const float pb2 = db0 * db1, pb3 = pb2 * db2, Pb = pb3 * db3;
        const float ia = __builtin_amdgcn_rcpf(Pa), ib = __builtin_amdgcn_rcpf(Pb);
        w[a] = e[a]; w[a + 1] = e[a + 1] * da0; w[a + 2] = e[a + 2] * pa2; w[a + 3] = e[a + 3] * pa3;
        w[b] = e[b]; w[b + 1] = e[b + 1] * db0; w[b + 2] = e[b + 2] * pb2; w[b + 3] = e[b + 3] * pb3;
        ia_[ks] = ia; fb[ks] = ib; R[ks] = ia * ib;
        __builtin_amdgcn_sched_barrier(0);
    }
    const float Rp0 = __shfl_xor(R[0], 32), Rp1 = __shfl_xor(R[1], 32);
    const float T1 = R[1] * Rp1, T0 = R[0] * Rp0;
    const float L1 = hf ? carry : carry * Rp1;
    const float c0 = carry * T1, L0 = hf ? c0 : c0 * Rp0;
    carry = c0 * T0;
    { const float f0b = fb[0] * L0, f0a = ia_[0] * f0b, f1b = fb[1] * L1, f1a = ia_[1] * f1b;
#pragma unroll
      for (int jj = 0; jj < 4; ++jj) { w[jj] *= f0a; w[4 + jj] *= f0b; w[8 + jj] *= f1a; w[12 + jj] *= f1b; } }
#pragma unroll
    for (int ks = 0; ks < 2; ++ks) {
        v4u pw; pw.x = pk2(w[8 * ks], w[8 * ks + 1]); pw.y = pk2(w[8 * ks + 2], w[8 * ks + 3]); pw.z = pk2(w[8 * ks + 4], w[8 * ks + 5]); pw.w = pk2(w[8 * ks + 6], w[8 * ks + 7]);
        const bf16x8 pf = __builtin_bit_cast(bf16x8, pw);
        o0 = __builtin_amdgcn_mfma_f32_32x32x16_bf16(vf[ks], pf, o0, 0, 0, 0);
        o1 = __builtin_amdgcn_mfma_f32_32x32x16_bf16(vf[2 + ks], pf, o1, 0, 0, 0);
    }
#if ATT_EARLY_EXIT
    return __all(carry == 0.f);
#else
    return false;
#endif
}
#define ATT_LOAD(KD, VD, TJ) do { const size_t o_ = (size_t)(TJ) * 2048; _Pragma("unroll") for (int i_ = 0; i_ < 4; ++i_) { KD[i_] = *(const bf16x8*)(kbase + o_ + i_ * 512); VD[i_] = *(const bf16x8*)(vbase + o_ + i_ * 512); } \
        __builtin_amdgcn_sched_barrier(0); } while (0)
__device__ __forceinline__ void attn_task(const bf16* Q, const bf16* K, const bf16* VT, bf16* Y, int b, int h, int qb, int lane) {
    const int t = lane & 31, hf = lane >> 5, q0 = qb * 32;
    const size_t hb = (size_t)(b * 8 + h) * 64;
    const bf16* qp = Q + ((hb + qb) * 4 * 64 + lane) * 8;
    bf16x8 qr[4];
#pragma unroll
    for (int kk = 0; kk < 4; ++kk) qr[kk] = *(const bf16x8*)(qp + kk * 512);
    const bf16* kbase = K + (hb * 4 * 64 + lane) * 8;
    const bf16* vbase = VT + (hb * 4 * 64 + lane) * 8;
    f32x16 o0, o1;
#pragma unroll
    for (int r = 0; r < 16; ++r) { o0[r] = 0.f; o1[r] = 0.f; }
    float carry = 1.f;
    bf16x8 ka[4], va[4], kb[4], vb[4], kc[4], vc[4];
    ATT_LOAD(ka, va, qb);
    ATT_LOAD(kb, vb, qb > 0 ? qb - 1 : 0);
    ATT_LOAD(kc, vc, qb > 1 ? qb - 2 : 0);
    __builtin_amdgcn_s_waitcnt(0x4F70);
    bool done = attn_tile(ka, va, qr, o0, o1, carry, true, t, hf);
    int j = qb - 1;
    while (!done && j >= 0) {
        __builtin_amdgcn_s_waitcnt(0x0F70);
        ATT_LOAD(ka, va, j > 1 ? j - 2 : 0);
        done = attn_tile(kb, vb, qr, o0, o1, carry, false, t, hf); --j;
        if (done || j < 0) break;
        ATT_LOAD(kb, vb, j > 1 ? j - 2 : 0);
        done = attn_tile(kc, vc, qr, o0, o1, carry, false, t, hf); --j;
        if (done || j < 0) break;
        ATT_LOAD(kc, vc, j > 1 ? j - 2 : 0);
        __builtin_amdgcn_s_waitcnt(0x4F70);
        done = attn_tile(ka, va, qr, o0, o1, carry, false, t, hf); --j;
    }
    bf16* yp = Y + (size_t)(b * SEQ + q0 + t) * DM + 256 + h * 64 + 4 * hf;
#pragma unroll
    for (int g = 0; g < 4; ++g) {
        v2u a; a.x = pk2(o0[4 * g], o0[4 * g + 1]); a.y = pk2(o0[4 * g + 2], o0[4 * g + 3]); *(v2u*)(yp + 8 * g) = a;
        v2u c; c.x = pk2(o1[4 * g], o1[4 * g + 1]); c.y = pk2(o1[4 * g + 2], o1[4 * g + 3]); *(v2u*)(yp + 32 + 8 * g) = c;
    }
}
__device__ __forceinline__ void sgu_task(const bf16* VNT, const bf16* WSB, const bf16* CU, const float* bias, bf16* Y, int task, int lane) {
    const int tb = task & 3, g = (task >> 2) & 3, c = (task >> 4) & 15, b = task >> 8;
    const int t = lane & 31, hf = lane >> 5;
    const bf16* ap = VNT + ((size_t)((b * 4 + g) * 16 + c) * 2 * 8 * 64 + lane) * 8;
    const bf16* bp = WSB + ((size_t)(g * 4 + tb) * 8 * 64 + lane) * 8;
    f32x16 a0, a1;
#pragma unroll
    for (int r = 0; r < 16; ++r) { a0[r] = 0.f; a1[r] = 0.f; }
    bf16x8 bfr[8], af0[8], af1[8];
#pragma unroll
    for (int ks = 0; ks < 8; ++ks) { bfr[ks] = *(const bf16x8*)(bp + 512 * ks); af0[ks] = *(const bf16x8*)(ap + 512 * ks); af1[ks] = *(const bf16x8*)(ap + 4096 + 512 * ks); }
#pragma unroll
    for (int ks = 0; ks < 8; ++ks) {
        a0 = __builtin_amdgcn_mfma_f32_32x32x16_bf16(af0[ks], bfr[ks], a0, 0, 0, 0);
        a1 = __builtin_amdgcn_mfma_f32_32x32x16_bf16(af1[ks], bfr[ks], a1, 0, 0, 0);
    }
    const int tok = b * SEQ + 128 * c + 32 * tb + t;
    const float bs = bias[g * 128 + 32 * tb + t];
    const bf16* up = CU + (size_t)tok * 256 + 64 * g + 4 * hf;
    bf16* yp = Y + (size_t)tok * DM + 768 + 64 * g + 4 * hf;
#pragma unroll
    for (int gg = 0; gg < 4; ++gg) {
        const v2u u0 = *(const v2u*)(up + 8 * gg), u1 = *(const v2u*)(up + 32 + 8 * gg);
        v2u a; a.x = pk2(bflo(u0.x) * (a0[4 * gg] + bs), bfhi(u0.x) * (a0[4 * gg + 1] + bs)); a.y = pk2(bflo(u0.y) * (a0[4 * gg + 2] + bs), bfhi(u0.y) * (a0[4 * gg + 3] + bs)); *(v2u*)(yp + 8 * gg) = a;
        v2u d; d.x = pk2(bflo(u1.x) * (a1[4 * gg] + bs), bfhi(u1.x) * (a1[4 * gg + 1] + bs)); d.y = pk2(bflo(u1.y) * (a1[4 * gg + 2] + bs), bfhi(u1.y) * (a1[4 * gg + 3] + bs)); *(v2u*)(yp + 32 + 8 * gg) = d;
    }
}
__device__ __forceinline__ void unpack8(const v4u w, float (&f)[8]) { f[0] = bflo(w.x); f[1] = bfhi(w.x); f[2] = bflo(w.y); f[3] = bfhi(w.y); f[4] = bflo(w.z); f[5] = bfhi(w.z); f[6] = bflo(w.w); f[7] = bfhi(w.w); }
__device__ __forceinline__ void conv_task(const bf16* CONV, const float* cwt, bf16* Y, int task, int lane) {
    const int ch = (lane & 31) * 8;
    float w0[8], w1[8], w2[8];
#pragma unroll
    for (int e = 0; e < 8; ++e) { w0[e] = cwt[ch + e]; w1[e] = cwt[256 + ch + e]; w2[e] = cwt[512 + ch + e]; }
    const bf16* ab = CONV; const bf16* ac = CONV + (size_t)SEQ * 256; const bf16* ah = CONV + (size_t)2 * SEQ * 256;
#pragma unroll
    for (int it = 0; it < 4; ++it) {
        const int tok = task * 8 + it * 2 + (lane >> 5), s = tok & (SEQ - 1);
        const size_t o = (size_t)tok * 256 + ch;
        float fb[8], c0[8], h0[8], c1[8], h1[8], c2[8], h2[8];
        unpack8(*(const v4u*)(ab + o), fb); unpack8(*(const v4u*)(ac + o), c0); unpack8(*(const v4u*)(ah + o), h0);
        const v4u zz = (v4u){0u, 0u, 0u, 0u};
        unpack8(s >= 1 ? *(const v4u*)(ac + o - 256) : zz, c1); unpack8(s >= 1 ? *(const v4u*)(ah + o - 256) : zz, h1);
        unpack8(s >= 2 ? *(const v4u*)(ac + o - 512) : zz, c2); unpack8(s >= 2 ? *(const v4u*)(ah + o - 512) : zz, h2);
        float y[8];
#pragma unroll
        for (int e = 0; e < 8; ++e) y[e] = fb[e] * (w2[e] * (c0[e] * h0[e]) + w1[e] * (c1[e] * h1[e]) + w0[e] * (c2[e] * h2[e]));
        v4u w; w.x = pk2(y[0], y[1]); w.y = pk2(y[2], y[3]); w.z = pk2(y[4], y[5]); w.w = pk2(y[6], y[7]);
        *(v4u*)(Y + (size_t)tok * DM + ch) = w;
    }
}

#define RLX_AGENT __ATOMIC_RELAXED, __HIP_MEMORY_SCOPE_AGENT
#define XB_TMO      128
#define XB_XCNT(j)  (256  + 64 * (j))
#define XB_XSUB(j)  (1280 + 64 * (j))
#define XB_XGEN(j)  (2304 + 64 * (j))
#define XB_TOP      3328
#define XB_TOPGEN   3392
#define XCD_BAR_WORDS 3456
#define XB_SPIN_CAP (1u << 18)

__device__ __forceinline__ unsigned xb_ld(unsigned* p)              { return __hip_atomic_load(p, __ATOMIC_RELAXED, __HIP_MEMORY_SCOPE_AGENT); }
__device__ __forceinline__ unsigned xb_add(unsigned* p, unsigned v) { return __hip_atomic_fetch_add(p, v, __ATOMIC_RELAXED, __HIP_MEMORY_SCOPE_AGENT); }
__device__ __forceinline__ unsigned xb_xcc_id() { return (unsigned)__builtin_amdgcn_s_getreg((3 << 11) | 20) & 0xFu; }
#define XB_SPIN(cond, bar) do { unsigned _sp = 0; while (cond) { __builtin_amdgcn_s_sleep(1); \
    if ((++_sp & 255u) == 0u) { if (xb_ld(&(bar)[XB_TMO])) break; if (_sp > XB_SPIN_CAP) { atomicAdd(&(bar)[XB_TMO], 1u); break; } } } } while (0)

struct XcdBarrier {
    unsigned* bar; unsigned x;
    volatile LAS unsigned* st;
};

__device__ __forceinline__ XcdBarrier xcd_barrier_post(unsigned* bar, volatile LAS unsigned* st) {
    XcdBarrier b; b.bar = bar; b.x = xb_xcc_id(); b.st = st;
    if (threadIdx.x == 0) (void)xb_add(&bar[XB_XCNT(b.x)], 1u);
    return b;
}
__device__ __forceinline__ void xcd_barrier_complete(unsigned* bar, unsigned x, unsigned& nloc, unsigned& nx) {
    const unsigned G = gridDim.x * gridDim.y * gridDim.z;
    unsigned sum, cnt, mine, sp = 0u;
    for (;;) {
        sum = 0u; cnt = 0u; mine = 0u;
#pragma unroll
        for (unsigned j = 0; j < 16; ++j) { const unsigned c = xb_ld(&bar[XB_XCNT(j)]); sum += c; cnt += (c > 0u) ? 1u : 0u; mine = (j == x) ? c : mine; }
        if (sum == G) break;
        __builtin_amdgcn_s_sleep(1);
        if ((++sp & 255u) == 0u) { if (xb_ld(&bar[XB_TMO])) break; if (sp > XB_SPIN_CAP) { atomicAdd(&bar[XB_TMO], 1u); break; } }
    }
    nloc = mine > 0u ? mine : 1u; nx = cnt > 0u ? cnt : 1u;
}

__device__ __forceinline__ void xcd_barrier(const XcdBarrier& b, bool local_seam) {
    asm volatile("s_waitcnt vmcnt(0)" ::: "memory");
    __syncthreads();
    if (threadIdx.x == 0) {
        unsigned* bar = b.bar;
        __builtin_amdgcn_s_waitcnt(0);
        unsigned nloc = b.st[0], nx = b.st[1];
        if (nloc == 0u) { xcd_barrier_complete(bar, b.x, nloc, nx); b.st[0] = nloc; b.st[1] = nx; }
        const unsigned old = xb_add(&bar[XB_XSUB(b.x)], 1u);
        const unsigned gen = old / nloc;
        const bool local = local_seam && (b.st[2] != 0u);
        if (old + 1u == (gen + 1u) * nloc) {
            if (!local) {
            __builtin_amdgcn_fence(__ATOMIC_RELEASE, "agent");
            asm volatile("s_waitcnt vmcnt(0)" ::: "memory");
            const unsigned og = xb_add(&bar[XB_TOP], 1u);
            const unsigned tg = og / nx;
            if (og + 1u == (tg + 1u) * nx) xb_add(&bar[XB_TOPGEN], 1u);
            else XB_SPIN(xb_ld(&bar[XB_TOPGEN]) == tg, bar);
            }
            __builtin_amdgcn_fence(__ATOMIC_ACQUIRE, "agent");
            xb_add(&bar[XB_XGEN(b.x)], 1u);
            asm volatile("s_waitcnt vmcnt(0)" ::: "memory");
        } else {
            XB_SPIN(xb_ld(&bar[XB_XGEN(b.x)]) == gen, bar);
            __builtin_amdgcn_fence(__ATOMIC_ACQUIRE, "agent");
            asm volatile("s_waitcnt vmcnt(0)" ::: "memory");
        }
    }
    __syncthreads();
}

struct Args { const float* in[17]; float* out; unsigned char* ws; int ph_lo, ph_hi; };
__global__ void __launch_bounds__(NWAVES * 64, 2) mk_fwd(Args a) {
    extern __shared__ __attribute__((aligned(16))) unsigned char lds_raw[];
    LAS unsigned char* lds = (LAS unsigned char*)lds_raw;
    const int tid = threadIdx.x, lane = tid & 63, wave = __builtin_amdgcn_readfirstlane(tid >> 6);
    const int G = gridDim.x; const int bx = blockIdx.x; const int vcu = (G % 8 == 0) ? (bx % 8) * (G / 8) + bx / 8 : bx;
    const int gw = vcu * NWAVES + wave, NGW = G * NWAVES;
    const int lo = a.ph_lo, hi = a.ph_hi;
    volatile LAS unsigned* bst = (volatile LAS unsigned*)(lds + RING_BYTES);
    if (tid < 4) bst[tid] = 0u;
    __syncthreads();
    XcdBarrier bar = xcd_barrier_post((unsigned*)(a.ws + WS_CTL), bst);
    unsigned* xcctab = (unsigned*)(a.ws + WS_CTL) + XCD_BAR_WORDS;
    if (tid == 0) __hip_atomic_store(xcctab + bx, bar.x + 1u, __ATOMIC_RELAXED, __HIP_MEMORY_SCOPE_AGENT);
    unsigned char* ws = a.ws;
    const float* x = a.in[0]; const float* p = a.in[1];
    bf16* Wb = (bf16*)(ws + WS_W); bf16* WSBb = (bf16*)(ws + WS_WSB); float* SS = (float*)(ws + WS_SS);
    bf16* HB = (bf16*)(ws + WS_HB); bf16* LO = (bf16*)(ws + WS_LO); bf16* XB = (bf16*)(ws + WS_XB);
    unsigned char* big = ws + WS_BIG;
    bf16* BG = (bf16*)big;
    bf16* CONV = BG + O_CONV; bf16* Qb = BG + O_Q; bf16* Kb = BG + O_K; bf16* VTb = BG + O_VT; bf16* CUb = BG + O_CU; bf16* VNTb = BG + O_VNT; bf16* Yb = BG + O_Y; bf16* PBb = BG + O_PB; bf16* Fb = BG;
    const size_t bo_blk = (size_t)(bx & 7) * SLAB_E;
    float* H = a.out;
#define IN(k) (lo <= (k) && (k) < hi)
#define SEAM(k, loc) do { if (IN(k) && IN((k) + 1)) { if (a.ph_lo < 0) cg::this_grid().sync(); for (int sr_ = 0; sr_ < PROBE_SYNC; ++sr_) xcd_barrier(bar, loc); } } while (0)

    if (IN(0)) for (int rep_ = 0; rep_ < PROBE_P; ++rep_) {
        LAS float* scr = (LAS float*)(lds + wave * 16384);
        constexpr int I_IN = (DM / 64) * (NIN / 32), I_OUT = (DM / 64) * (DM / 32), I_1 = (DM / 64) * (DFF / 32), I_2 = (DFF / 64) * (DM / 32), I_G = I_OUT, I_P = (PLE / 64) * (DM / 32);
        constexpr int I_LAYER = I_IN + I_OUT + I_1 + I_2 + I_G + I_P;
#define TR_DECODE(J, IT) do { const int l_ = (IT) / I_LAYER; int r_ = (IT) % I_LAYER; bf16* wl_ = Wb + (size_t)l_ * E_WLAYER; \
            if (r_ < I_IN) { J = TrJob{a.in[3] + (size_t)l_ * DM * NIN, wl_ + E_WIN, a.in[2] + l_ * DM, DM, NIN, r_, 1}; } \
            else if ((r_ -= I_IN) < I_OUT) { J = TrJob{a.in[10] + (size_t)l_ * DM * DM, wl_ + E_WOUT, nullptr, DM, DM, r_, 0}; } \
            else if ((r_ -= I_OUT) < I_1) { J = TrJob{a.in[12] + (size_t)l_ * DM * DFF, wl_ + E_W1, a.in[11] + l_ * DM, DM, DFF, r_, 0}; } \
            else if ((r_ -= I_1) < I_2) { J = TrJob{a.in[13] + (size_t)l_ * DFF * DM, wl_ + E_W2, nullptr, DFF, DM, r_, 0}; } \
            else if ((r_ -= I_2) < I_G) { J = TrJob{a.in[15] + (size_t)l_ * DM * DM, wl_ + E_WG, a.in[14] + l_ * DM, DM, DM, r_, 0}; } \
            else { r_ -= I_G; J = TrJob{a.in[16] + (size_t)l_ * PLE * DM, wl_ + E_WP, nullptr, PLE, DM, r_, 0}; } } while (0)
        for (int it = gw; it < DEPTH * I_LAYER; it += 2 * NGW) {
            const int it2 = it + NGW; const bool has2 = it2 < DEPTH * I_LAYER;
            TrJob j1, j2; f32x4 v1[8], v2[8];
            TR_DECODE(j1, it); tr_load(j1, lane, v1);
            if (has2) { TR_DECODE(j2, it2); tr_load(j2, lane, v2); }
            tr_finish(j1, lane, v1, scr);
            if (has2) tr_finish(j2, lane, v2, scr);
        }
#undef TR_DECODE
        for (int i = gw * 64 + lane; i < DEPTH * 4 * 128 * 128; i += NGW * 64) {
            const int e8 = i & 7, ln = (i >> 3) & 63, ks = (i >> 9) & 7, tb = (i >> 12) & 3, lg = i >> 14; const int t = 32 * tb + (ln & 31), sk = 16 * ks + 8 * (ln >> 5) + e8;
            WSBb[i] = (bf16)f2bf(sk <= t ? a.in[8][((size_t)lg * 128 + t) * 128 + sk] : 0.f); }
        for (int m0 = gw; m0 < M; m0 += 2 * NGW) {
            f32x4 v[2][4]; float sq[2];
#pragma unroll
            for (int q = 0; q < 2; ++q) { const int m = m0 + q * NGW; sq[q] = 0.f; if (m < M) { const f32x4* xr = (const f32x4*)(x + (size_t)m * DM) + lane;
#pragma unroll
                for (int j = 0; j < 4; ++j) v[q][j] = xr[64 * j]; } }
#pragma unroll
            for (int q = 0; q < 2; ++q) { const int m = m0 + q * NGW; if (m < M) {
                float sacc = 0.f;
#pragma unroll
                for (int j = 0; j < 4; ++j) sacc += (v[q][j].x * v[q][j].x + v[q][j].y * v[q][j].y) + (v[q][j].z * v[q][j].z + v[q][j].w * v[q][j].w);
                sq[q] = wave_sum(sacc);
                v2u* o8 = (v2u*)(XB + (size_t)m * DM) + lane; v2u* l8 = (v2u*)(LO + (size_t)m * DM) + lane;
#pragma unroll
                for (int j = 0; j < 4; ++j) { v2u w; w.x = pk2(v[q][j].x, v[q][j].y); w.y = pk2(v[q][j].z, v[q][j].w); o8[64 * j] = w;
                    v2u d; d.x = pk2(v[q][j].x - bflo(w.x), v[q][j].y - bfhi(w.x)); d.y = pk2(v[q][j].z - bflo(w.y), v[q][j].w - bfhi(w.y)); l8[64 * j] = d; }
                if (lane < 16) SS[(size_t)m * 16 + lane] = lane == 0 ? sq[q] : 0.f; } }
        }
        for (int it = gw; it < M * PLE / 512; it += NGW) { const size_t o = (size_t)it * 512 + lane * 8; const f32x4 u0 = *(const f32x4*)(p + o), u1 = *(const f32x4*)(p + o + 4);
            v4u w; w.x = pk2(u0.x, u0.y); w.y = pk2(u0.z, u0.w); w.z = pk2(u1.x, u1.y); w.w = pk2(u1.z, u1.w); *(v4u*)(PBb + (size_t)(it >> 10) * SLAB_E + (o & (size_t)(SEQ * PLE - 1))) = w; }
        asm volatile("s_waitcnt vmcnt(0) lgkmcnt(0)" ::: "memory"); __syncthreads();
    }
    SEAM(0, false);
    if (lo == 0 && hi == NPHASE) {
        if (wave == 0) {
            bool ok = (G == 256);
            for (int i = lane; i < G; i += 64) { const unsigned me = __hip_atomic_load(xcctab + i, __ATOMIC_RELAXED, __HIP_MEMORY_SCOPE_AGENT), first = __hip_atomic_load(xcctab + (i & 7), __ATOMIC_RELAXED, __HIP_MEMORY_SCOPE_AGENT);
                ok = ok && (me != 0u) && (me == first); }
            const bool all_ok = __all(ok);
            if (lane == 0) bst[2] = all_ok ? 1u : 0u;
        }
        __syncthreads();
#ifdef PROBE_FAST
        if (bst[2] == 0u) { if (tid == 0) { const unsigned long long t0 = __builtin_amdgcn_s_memrealtime(); while (__builtin_amdgcn_s_memrealtime() - t0 < 40000ull) __builtin_amdgcn_s_sleep(8); } __syncthreads(); }
#endif
    }

    for (int l = 0; l < DEPTH; ++l) {
        const int pb = 1 + 6 * l;
        const bf16* wl = Wb + (size_t)l * E_WLAYER;
        bf16* bufX = (l & 1) ? HB : XB; bf16* bufT = (l & 1) ? XB : HB;
        float* ss1 = SS; float* ss2 = SS + (size_t)M * 16; float* ss3 = SS + (size_t)2 * M * 16; float* ss1n = ss1;
        if (IN(pb)) for (int rep_ = 0; rep_ < PROBE_A; ++rep_) {
#ifndef NO_A
            { pg8::Gemm g{bufX, wl + E_WIN, M, NIN, DM}; pg8::StaticOrder S; S.init(M, NIN, G, bx);
              EpiInProj E{ss1, CONV, Qb, Kb, VTb, CUb, VNTb, a.in[5] + l * 64, a.in[6] + l * 64, a.in[7] + l * 256};
              pg8::gemm_phase<EpiInProj, pg8::StaticOrder, true, true>(lds, g, S, E); }
            { int kp = PLE; asm volatile("" : "+s"(kp)); pg8::Gemm g{PBb + bo_blk - (size_t)(8 * (bx & 7)) * 256 * PLE, wl + E_WP, M, DM, kp};     TSched S{bx, (M / 256 * (NIN / 256)) % G, G};
              EpiT E{bufT};
              pg8::gemm_phase<EpiT, TSched, true, true>(lds, g, S, E); }
#endif
        }
        SEAM(pb, true);
        if (IN(pb + 1)) for (int rep_ = 0; rep_ < PROBE_B; ++rep_) {
            int lane_ = (int)__builtin_amdgcn_mbcnt_hi(~0u, __builtin_amdgcn_mbcnt_lo(~0u, 0u)); asm volatile("" : "+v"(lane_));
#pragma unroll 1
            for (int part = 0; part < 2; ++part) {
            if ((part == 0) == (wave < 4)) {
#ifndef NO_ATT
            for (int ra_ = 0; ra_ < PROBE_ATT; ++ra_)
            for (int pr = gw; pr < 2048; pr += NGW) { const int bh = pr >> 5, i = pr & 31;
                const size_t bo = (size_t)(bh >> 3) * SLAB_E;
                attn_task(Qb + bo, Kb + bo, VTb + bo, Yb + bo, 0, bh & 7, 63 - i, lane_);
                attn_task(Qb + bo, Kb + bo, VTb + bo, Yb + bo, 0, bh & 7, i, lane_); }
#endif
            } else {
#ifndef NO_SGU
            for (int tk = gw; tk < 2048; tk += NGW) { const size_t bo = (size_t)(tk >> 8) * SLAB_E; sgu_task(VNTb + bo, WSBb + (size_t)l * 4 * 128 * 128, CUb + bo, a.in[9] + l * 512, Yb + bo, tk & 255, lane_); }
#endif
#ifndef NO_CONV
            for (int tk = gw; tk < 2048; tk += NGW) { const size_t bo = (size_t)(tk >> 8) * SLAB_E; conv_task(CONV + bo, a.in[4] + l * 768, Yb + bo, tk & 255, lane_); }
#endif
            }
            }
            asm volatile("s_waitcnt vmcnt(0) lgkmcnt(0)" ::: "memory"); __syncthreads();
        }
        SEAM(pb + 1, true);
        if (IN(pb + 2)) {
#ifndef NO_C
#ifndef NO_O
            { pg8::Gemm g{Yb + bo_blk - (size_t)(8 * (bx & 7)) * 256 * DM, wl + E_WOUT, M, DM, DM}; pg8::StaticOrder S; S.init(M, DM, G, bx);
              EpiRes E{bufX, LO, ss2, l == 0 ? 1 : 0, 0};
              pg8::gemm_phase<EpiRes, pg8::StaticOrder, true, true>(lds, g, S, E); }
#endif
#endif
        }
        SEAM(pb + 2, true);
        if (IN(pb + 3)) for (int rep_ = 0; rep_ < PROBE_D; ++rep_) {
#ifndef NO_D
            pg8::Gemm g{bufX, wl + E_W1, M, DFF, DM}; pg8::StaticOrder S; S.init(M, DFF, G, bx);
            EpiFF1 E{ss2, Fb};
            pg8::gemm_phase<EpiFF1, pg8::StaticOrder, true, true>(lds, g, S, E);
#endif
        }
        SEAM(pb + 3, true);
        if (IN(pb + 4)) {
#ifndef NO_E
            pg8::Gemm g{Fb, wl + E_W2, M, DM, DFF}; pg8::StaticOrder S; S.init(M, DM, G, bx);
            EpiRes E{bufX, LO, ss3, 0, l == DEPTH - 1 ? 1 : 0};
            pg8::gemm_phase<EpiRes, pg8::StaticOrder, true, true>(lds, g, S, E);
#endif
        }
        SEAM(pb + 4, true);
        if (IN(pb + 5)) {
            if (l + 1 < DEPTH) {
                const float* pl = p + (size_t)(l + 1) * M * PLE;
#pragma unroll 4
                for (int t_ = gw; t_ < M * PLE / 512; t_ += NGW) { const int it = ((t_ >> 8) & 7) * 1024 + (t_ >> 11) * 256 + (t_ & 255);
                    const size_t o = (size_t)it * 512 + lane * 8; const f32x4 u0 = *(const f32x4*)(pl + o), u1 = *(const f32x4*)(pl + o + 4);
                    v4u w; w.x = pk2(u0.x, u0.y); w.y = pk2(u0.z, u0.w); w.z = pk2(u1.x, u1.y); w.w = pk2(u1.z, u1.w); *(v4u*)(PBb + (size_t)(it >> 10) * SLAB_E + (o & (size_t)(SEQ * PLE - 1))) = w; }
            }
#ifndef NO_F
            pg8::Gemm g{bufX, wl + E_WG, M, DM, DM}; pg8::StaticOrder S; S.init(M, DM, G, bx);
            EpiGate E{ss3, bufX, LO, bufT, ss1n, l == DEPTH - 1 ? H : (float*)nullptr, l == DEPTH - 1 ? 1 : 0};
            pg8::gemm_phase<EpiGate, pg8::StaticOrder, true, true>(lds, g, S, E);
#endif
        }
        SEAM(pb + 5, true);
    }
#undef IN
#undef SEAM
}

extern "C" void kernel_launch(void* const* d_in, const int* in_sizes, int n_in, void* d_out, int out_size, void* d_ws, size_t ws_size, hipStream_t stream) {
    static int grid = 0;
    if (grid == 0) {
        if (n_in != 17 || in_sizes[0] != M * DM || out_size != M * DM || ws_size < WS_TOTAL) { fprintf(stderr, "kernel_launch: unexpected shapes (n_in %d, in0 %d, out %d, ws %zu, need %zu)\n", n_in, n_in > 0 ? in_sizes[0] : -1, out_size, ws_size, (size_t)WS_TOTAL); grid = -1; return; }
        int dev = 0, cus = 0, per_cu = 0;
        hipGetDevice(&dev); hipDeviceGetAttribute(&cus, hipDeviceAttributeMultiprocessorCount, dev);
        if (hipFuncSetAttribute((const void*)mk_fwd, hipFuncAttributeMaxDynamicSharedMemorySize, LDS_BYTES) != hipSuccess) { fprintf(stderr, "kernel_launch: hipFuncSetAttribute failed\n"); grid = -1; return; }
        if (hipOccupancyMaxActiveBlocksPerMultiprocessor(&per_cu, (const void*)mk_fwd, NWAVES * 64, LDS_BYTES) != hipSuccess || per_cu < 1) { fprintf(stderr, "kernel_launch: occupancy query says %d\n", per_cu); per_cu = 1; }
        (void)hipGetLastError();
        grid = cus * 1;
        if (grid != 256) { fprintf(stderr, "kernel_launch: this kernel's per-batch-element workspace layout needs a 256-workgroup grid (256 CUs); found %d CUs\n", cus); grid = -1; return; }
    }
    if (grid < 0) return;
#ifdef DBG_MEMSET
    (void)hipMemsetAsync(d_ws, 0xAA, WS_END, stream); (void)hipMemsetAsync(d_out, 0xAA, (size_t)M * DM * 4, stream);
#endif
    if (hipMemsetAsync((char*)d_ws + WS_CTL, 0, CTL_BYTES, stream) != hipSuccess) { fprintf(stderr, "kernel_launch: memset of the barrier words failed\n"); return; }
    Args a{};
    for (int i = 0; i < 17; ++i) a.in[i] = (const float*)d_in[i];
    a.out = (float*)d_out; a.ws = (unsigned char*)d_ws;
#if MK_N_LAUNCHES == 1
    a.ph_lo = 0; a.ph_hi = NPHASE;
    void* args[] = {&a};
    hipError_t e = hipLaunchCooperativeKernel((const void*)mk_fwd, dim3(grid), dim3(NWAVES * 64), args, LDS_BYTES, stream);
    if (e != hipSuccess) fprintf(stderr, "cooperative launch failed: %s (grid %d)\n", hipGetErrorString(e), grid);
#else
    for (int ph = 0; ph < NPHASE; ++ph) { a.ph_lo = ph; a.ph_hi = ph + 1; hipLaunchKernelGGL(mk_fwd, dim3(grid), dim3(NWAVES * 64), LDS_BYTES, stream, a); }
#endif
}
```

```cpp
#include <hip/hip_runtime.h>
#include <hip/hip_cooperative_groups.h>
#include <cstdio>
#include <cstdint>
namespace cg = cooperative_groups;
namespace pg8 {
#define PG8_LAS __attribute__((address_space(3)))
typedef unsigned short bf16_t;
typedef short bf16x8 __attribute__((ext_vector_type(8)));
typedef float f32x4 __attribute__((ext_vector_type(4)));
typedef unsigned u32x4 __attribute__((ext_vector_type(4)));
constexpr int BM = 256, BK = 64, HALF = 128, HTB = HALF * BK * 2  , STAGE_BYTES = 8 * HTB, NXCD = 8, WGM = 8;

__host__ __device__ __forceinline__ int lds_byte(int r, int c) { const int st = (r >> 4) * 2 + (c >> 5), rr = r & 15, cc = c & 31, ob = rr * 64 + cc * 2; return st * 1024 + (ob ^ (((ob >> 9) & 1) << 5)); }
__host__ __device__ __forceinline__ void stage_rc(int b, int& R, int& C) { const int st = b / 1024, sb = b % 1024, swz = sb ^ (((sb >> 9) & 1) << 5); R = (st >> 1) * 16 + swz / 64; C = (st & 1) * 32 + (swz % 64) / 2; }
__host__ __device__ __forceinline__ int perm32(int rho) { const int n = rho >> 4, i = rho & 15; return 8 * (i >> 2) + 4 * n + (i & 3); }

struct Unit { int pm, pn; };
struct Gemm { const bf16_t* A; const bf16_t* Bt; int M, N, K; };

struct StaticOrder {
    int nM, nN, nwg, G, c;
    __host__ __device__ void init(int M, int N, int G_, int c_) { nM = M / BM; nN = N / BM; nwg = nM * nN; G = G_; c = c_; }
    __host__ __device__ bool next(int i, Unit& u) const {
        const long L = (long)i * G + c; if (L >= nwg) return false;
        int wgid = (int)L; { const int q = nwg / NXCD, r = nwg % NXCD, xcd = wgid % NXCD, off = wgid / NXCD; wgid = (xcd < r ? xcd * (q + 1) : r * (q + 1) + (xcd - r) * q) + off; }
        const int nig = WGM * nN, gid = wgid / nig, fm = gid * WGM, gsz = (nM - fm) < WGM ? (nM - fm) : WGM;
        u.pm = fm + ((wgid % nig) % gsz); u.pn = (wgid % nig) / gsz; return true;
    }
    __device__ __forceinline__ void a_ready(const Unit&) const {}
    __device__ __forceinline__ void done(const Unit&) const {}
};

__device__ __forceinline__ unsigned cvt_pk_bf16(float lo, float hi) { unsigned r; asm volatile("v_cvt_pk_bf16_f32 %0, %1, %2" : "=v"(r) : "v"(lo), "v"(hi)); return r; }
typedef float f32x2 __attribute__((ext_vector_type(2)));
__device__ __forceinline__ f32x2 gelu_pk(f32x2 v) {
    const f32x2 av = __builtin_elementwise_abs(v), d = av * 0.2316418882f + 1.0f;
    f32x2 t; t.x = __builtin_amdgcn_rcpf(d.x); t.y = __builtin_amdgcn_rcpf(d.y);
    f32x2 q = t * 0.5307027145f + (-0.7265760135f); q = q * t + 0.7107068705f; q = q * t + (-0.142248368f); q = q * t + 0.127414796f; q = q * t;
    const f32x2 s = (v * v) * (-0.72134752044f);
    f32x2 e; e.x = __builtin_amdgcn_exp2f(s.x); e.y = __builtin_amdgcn_exp2f(s.y);
    const f32x2 m = v * (q * e), r = v - m;
    f32x2 o; o.x = v.x < 0.f ? m.x : r.x; o.y = v.y < 0.f ? m.y : r.y; return o;
}

template <int ACT  > struct EpiBf16 {
    static constexpr bool PERM = true, AFTER_DRAIN = false; static_assert(ACT == 0 || ACT == 1, "EpiBf16: ACT is 0 (none) or 1 (gelu_pk)");
    bf16_t* O; int ldc; const float* bias; int split_cols; size_t split_stride; float scale0;
    __device__ __forceinline__ void operator()(const f32x4 (&acc)[2][2][4][2], const Unit& u, int wr, int wc, int fr, int fq) const {
        const int row0 = u.pm * BM + wr * 64 + fr; int colt = u.pn * BM; bf16_t* base = O;
        float sc = 1.f; if (split_cols) { const int t = colt / split_cols; base += (size_t)t * split_stride; colt -= t * split_cols; if (t == 0) sc = scale0; }
        const int col0 = colt + wc * 32 + 8 * fq, bcol0 = u.pn * BM + wc * 32 + 8 * fq;
        f32x4 bv[2][2];
#pragma unroll
        for (int bj = 0; bj < 2; ++bj)
#pragma unroll
            for (int n = 0; n < 2; ++n) bv[bj][n] = bias ? *(const f32x4*)(bias + bcol0 + bj * HALF + 4 * n) : (f32x4){0.f, 0.f, 0.f, 0.f};
#pragma unroll
        for (int ai = 0; ai < 2; ++ai)
#pragma unroll
            for (int m = 0; m < 4; ++m) { bf16_t* rowp = base + (size_t)(row0 + ai * HALF + m * 16) * ldc + col0;
#pragma unroll
                for (int bj = 0; bj < 2; ++bj) { f32x4 v0 = acc[ai][bj][m][0] + bv[bj][0], v1 = acc[ai][bj][m][1] + bv[bj][1];
                    if (ACT == 1) { f32x2 a = gelu_pk((f32x2){v0[0], v0[1]}), b = gelu_pk((f32x2){v0[2], v0[3]}), c = gelu_pk((f32x2){v1[0], v1[1]}), d = gelu_pk((f32x2){v1[2], v1[3]});
                        v0 = (f32x4){a.x, a.y, b.x, b.y}; v1 = (f32x4){c.x, c.y, d.x, d.y}; }
                    v0 = v0 * sc; v1 = v1 * sc; u32x4 w; w.x = cvt_pk_bf16(v0[0], v0[1]); w.y = cvt_pk_bf16(v0[2], v0[3]); w.z = cvt_pk_bf16(v1[0], v1[1]); w.w = cvt_pk_bf16(v1[2], v1[3]);
                    *(u32x4*)(rowp + bj * HALF) = w; } }
    }
};
template <class Epi, class Sched, bool ALIGN_EPI = false, bool SP2 = false>
__device__ __forceinline__ void gemm_phase(PG8_LAS unsigned char* lds, const Gemm g, const Sched& S, const Epi& E, const int wave_id  ) {
    int tid_ = wave_id * 64 + (int)__builtin_amdgcn_mbcnt_hi(~0u, __builtin_amdgcn_mbcnt_lo(~0u, 0u)); asm volatile("" : "+v"(tid_));
    const int tid = tid_, wid = __builtin_amdgcn_readfirstlane(tid >> 6), lane = tid & 63, wr = wid >> 2, wc = wid & 3, fr = lane & 15, fq = lane >> 4;
    const int K = g.K, nt = K / BK;
    unsigned voffA[2], voffB[2];
#pragma unroll
    for (int i = 0; i < 2; ++i) { int R, C; stage_rc(tid * 16 + i * 8192, R, C); const int Rb = Epi::PERM ? ((R & ~31) + perm32(R & 31)) : R;
        voffA[i] = (unsigned)(R * K + C) * 2u; voffB[i] = (unsigned)(Rb * K + C) * 2u; }
    const size_t kstep = (size_t)(BK * 2);
    const size_t hstep = (size_t)HALF * K * 2;
    const size_t tstep = 2 * hstep;
    const unsigned ldsw = (unsigned)wid * 1024u;
    const int aoff = lds_byte(wr * 64 + fr, fq * 8), boff = lds_byte(wc * 32 + fr, fq * 8);
#define PG8_SA(b, h) (((b) * 2 + (h)) * HTB)
#define PG8_SB(b, h) ((4 + (b) * 2 + (h)) * HTB)
#define PG8_STAGE(bufoff, gbase, voff) do { _Pragma("unroll") for (int _i = 0; _i < 2; ++_i) \
        __builtin_amdgcn_global_load_lds((const unsigned*)((const char*)(gbase) + (voff)[_i]), (PG8_LAS unsigned*)(lds + (bufoff) + ldsw + _i * 8192), 16, 0, 0); } while (0)
#define PG8_LDA(dst, b, h) do { _Pragma("unroll") for (int m = 0; m < 4; ++m) _Pragma("unroll") for (int k = 0; k < 2; ++k) dst[m][k] = *(const PG8_LAS bf16x8*)(lds + PG8_SA(b, h) + aoff + m * 2048 + k * 1024); } while (0)
#define PG8_LDB(dst, b, h) do { _Pragma("unroll") for (int n = 0; n < 2; ++n) _Pragma("unroll") for (int k = 0; k < 2; ++k) dst[n][k] = *(const PG8_LAS bf16x8*)(lds + PG8_SB(b, h) + boff + n * 2048 + k * 1024); } while (0)
#define PG8_MMA(ai, bj, At, Bt) do { __builtin_amdgcn_s_setprio(1); _Pragma("unroll") for (int m = 0; m < 4; ++m) _Pragma("unroll") for (int n = 0; n < 2; ++n) _Pragma("unroll") for (int k = 0; k < 2; ++k) \
        acc[ai][bj][m][n] = __builtin_amdgcn_mfma_f32_16x16x32_bf16(Bt[n][k], At[m][k], acc[ai][bj][m][n], 0, 0, 0); __builtin_amdgcn_s_setprio(0); } while (0)
#define PG8_WAIT_V(n) asm volatile("s_waitcnt vmcnt(" #n ")" ::: "memory")
#define PG8_WAIT_L(n) asm volatile("s_waitcnt lgkmcnt(" #n ")" ::: "memory")
#define PG8_BAR __builtin_amdgcn_s_barrier()
#define PG8_SCHED __builtin_amdgcn_sched_barrier(0)
    Unit cur, nxt; int ui = 0;
    if (!S.next(0, cur)) return;
    f32x4 acc[2][2][4][2];
#pragma unroll
    for (int a = 0; a < 2; ++a)
#pragma unroll
        for (int b = 0; b < 2; ++b)
#pragma unroll
            for (int m = 0; m < 4; ++m)
#pragma unroll
                for (int n = 0; n < 2; ++n) acc[a][b][m][n] = (f32x4){0.f, 0.f, 0.f, 0.f};
    bf16x8 At[4][2], B0[2][2], B1[2][2];
    const char* cA = (const char*)g.A + (size_t)cur.pm * tstep; const char* cB = (const char*)g.Bt + (size_t)cur.pn * tstep;
    S.a_ready(cur);
    if constexpr (SP2) {
        PG8_STAGE(PG8_SB(0, 0), cB, voffB); PG8_STAGE(PG8_SB(0, 1), cB + hstep, voffB); PG8_STAGE(PG8_SA(0, 0), cA, voffA); PG8_STAGE(PG8_SA(0, 1), cA + hstep, voffA);
        if (wr == 1) PG8_BAR;
        PG8_WAIT_V(2); PG8_BAR;
        PG8_STAGE(PG8_SB(1, 0), cB + kstep, voffB); PG8_STAGE(PG8_SA(1, 0), cA + kstep, voffA); PG8_STAGE(PG8_SB(1, 1), cB + hstep + kstep, voffB);
        PG8_WAIT_V(6); PG8_BAR;
    } else {
        PG8_STAGE(PG8_SB(0, 0), cB, voffB); PG8_STAGE(PG8_SA(0, 0), cA, voffA); PG8_STAGE(PG8_SB(0, 1), cB + hstep, voffB); PG8_STAGE(PG8_SA(0, 1), cA + hstep, voffA);
        if (wr == 1) PG8_BAR;
        PG8_WAIT_V(4); PG8_BAR;
        PG8_STAGE(PG8_SB(1, 0), cB + kstep, voffB); PG8_STAGE(PG8_SA(1, 0), cA + kstep, voffA); PG8_STAGE(PG8_SB(1, 1), cB + hstep + kstep, voffB);
        PG8_WAIT_V(6); PG8_BAR;
    }
    for (;;) {
        const bool has_next = S.next(ui + 1, nxt);
        const char* nA = has_next ? (const char*)g.A + (size_t)nxt.pm * tstep : cA; const char* nB = has_next ? (const char*)g.Bt + (size_t)nxt.pn * tstep : cB;
        for (int t = 0; t < nt; t += 2) {
            const bool last = (t == nt - 2);
            const char* a1 = cA + (size_t)(t + 1) * kstep;
            const char* a2 = last ? nA : cA + (size_t)(t + 2) * kstep; const char* b2 = last ? nB : cB + (size_t)(t + 2) * kstep;
            const char* a3 = a2 + kstep; const char* b3 = b2 + kstep;
            if (last && has_next) S.a_ready(nxt);
            if constexpr (SP2) {
            PG8_LDB(B0, 0, 0); PG8_LDB(B1, 0, 1); PG8_SCHED; PG8_LDA(At, 0, 0); PG8_STAGE(PG8_SA(1, 1), a1 + hstep, voffA);
            PG8_WAIT_V(8); PG8_WAIT_L(0); PG8_BAR; PG8_MMA(0, 0, At, B0); PG8_MMA(0, 1, At, B1); PG8_BAR; PG8_SCHED;
            PG8_LDA(At, 0, 1); PG8_STAGE(PG8_SB(0, 0), b2, voffB); PG8_STAGE(PG8_SB(0, 1), b2 + hstep, voffB); PG8_STAGE(PG8_SA(0, 0), a2, voffA);
            PG8_WAIT_V(8); PG8_WAIT_L(0); PG8_BAR; PG8_MMA(1, 0, At, B0); PG8_MMA(1, 1, At, B1); PG8_BAR; PG8_SCHED;
            PG8_LDB(B0, 1, 0); PG8_LDB(B1, 1, 1); PG8_SCHED; PG8_LDA(At, 1, 0); PG8_STAGE(PG8_SA(0, 1), a2 + hstep, voffA);
            PG8_WAIT_V(8); PG8_WAIT_L(0); PG8_BAR; PG8_MMA(0, 0, At, B0); PG8_MMA(0, 1, At, B1); PG8_BAR; PG8_SCHED;
            PG8_LDA(At, 1, 1); PG8_STAGE(PG8_SB(1, 0), b3, voffB); PG8_STAGE(PG8_SB(1, 1), b3 + hstep, voffB); PG8_STAGE(PG8_SA(1, 0), a3, voffA);
            PG8_WAIT_V(8); PG8_WAIT_L(0); PG8_BAR; PG8_MMA(1, 0, At, B0); PG8_MMA(1, 1, At, B1); PG8_BAR; PG8_SCHED;
            } else {
            PG8_LDB(B0, 0, 0); PG8_SCHED; PG8_LDA(At, 0, 0); PG8_STAGE(PG8_SA(1, 1), a1 + hstep, voffA);
            PG8_WAIT_L(8); PG8_BAR; PG8_WAIT_L(0); PG8_MMA(0, 0, At, B0); PG8_BAR; PG8_SCHED;
            PG8_LDB(B1, 0, 1); PG8_STAGE(PG8_SB(0, 0), b2, voffB);
            PG8_BAR; PG8_WAIT_L(0); PG8_MMA(0, 1, At, B1); PG8_BAR;
            PG8_LDA(At, 0, 1); PG8_STAGE(PG8_SA(0, 0), a2, voffA);
            PG8_BAR; PG8_WAIT_L(0); PG8_MMA(1, 0, At, B0); PG8_BAR; PG8_SCHED;
            PG8_STAGE(PG8_SB(0, 1), b2 + hstep, voffB);
            PG8_WAIT_V(6); PG8_BAR; PG8_MMA(1, 1, At, B1); PG8_BAR;
            PG8_LDB(B0, 1, 0); PG8_SCHED; PG8_LDA(At, 1, 0); PG8_STAGE(PG8_SA(0, 1), a2 + hstep, voffA);
            PG8_WAIT_L(8); PG8_BAR; PG8_WAIT_L(0); PG8_MMA(0, 0, At, B0); PG8_BAR; PG8_SCHED;
            PG8_LDB(B1, 1, 1); PG8_STAGE(PG8_SB(1, 0), b3, voffB);
            PG8_BAR; PG8_WAIT_L(0); PG8_MMA(0, 1, At, B1); PG8_BAR;
            PG8_LDA(At, 1, 1); PG8_STAGE(PG8_SA(1, 0), a3, voffA);
            PG8_BAR; PG8_WAIT_L(0); PG8_MMA(1, 0, At, B0); PG8_BAR; PG8_SCHED;
            PG8_STAGE(PG8_SB(1, 1), b3 + hstep, voffB);
            PG8_WAIT_V(6); PG8_BAR; PG8_MMA(1, 1, At, B1); PG8_BAR;
            }
        }
        if constexpr (ALIGN_EPI) { if (wr == 0) PG8_BAR; }
        if constexpr (!Epi::AFTER_DRAIN) { E(acc, cur, wr, wc, fr, fq); S.done(cur); }
        if (!has_next) break;
#pragma unroll
        for (int a = 0; a < 2; ++a)
#pragma unroll
            for (int b = 0; b < 2; ++b)
#pragma unroll
                for (int m = 0; m < 4; ++m)
#pragma unroll
                    for (int n = 0; n < 2; ++n) acc[a][b][m][n] = (f32x4){0.f, 0.f, 0.f, 0.f};
        cur = nxt; cA = nA; cB = nB; ++ui;
        if constexpr (ALIGN_EPI) { if (wr == 1) PG8_BAR; }
    }
    PG8_WAIT_V(0);
    if constexpr (!ALIGN_EPI) { if (wr == 0) PG8_BAR; }
    PG8_BAR;
    if constexpr (Epi::AFTER_DRAIN) { E.fused(acc, cur, wr, wc, fr, fq, lds, wid, lane); S.done(cur); }
#undef PG8_SA
#undef PG8_SB
#undef PG8_STAGE
#undef PG8_LDA
#undef PG8_LDB
#undef PG8_MMA
#undef PG8_WAIT_V
#undef PG8_WAIT_L
#undef PG8_BAR
#undef PG8_SCHED
}
}

#ifndef MK_N_LAUNCHES
#define MK_N_LAUNCHES 1
#endif
#ifndef ATT_EARLY_EXIT
#define ATT_EARLY_EXIT 1
#endif
constexpr int NWAVES = 8;
constexpr int M = 16384, DM = 1024, SEQ = 2048, DEPTH = 4, NIN = 2816, DFF = 4096, PLE = 256;
constexpr float EPS = 1e-6f;
constexpr float C2 = 0.125f * 1.4426950408889634f;
constexpr int NPHASE = 1 + 6 * DEPTH;
#ifndef PROBE_B
#define PROBE_B 1
#endif
#ifndef PROBE_ATT
#define PROBE_ATT 1
#endif
#ifndef PROBE_SYNC
#define PROBE_SYNC 1
#endif
#ifndef PROBE_P
#define PROBE_P 1
#endif
#ifndef PROBE_A
#define PROBE_A 1
#endif
#ifndef PROBE_D
#define PROBE_D 1
#endif

typedef unsigned short bf16;
#define LAS __attribute__((address_space(3)))
typedef unsigned v4u __attribute__((ext_vector_type(4)));
typedef unsigned v2u __attribute__((ext_vector_type(2)));
typedef float f32x4 __attribute__((ext_vector_type(4)));
typedef float f32x2 __attribute__((ext_vector_type(2)));
typedef float f32x16 __attribute__((ext_vector_type(16)));
typedef short bf16x8 __attribute__((ext_vector_type(8)));
typedef short s16x4 __attribute__((ext_vector_type(4)));
#define LDS_WAIT() asm volatile("s_waitcnt lgkmcnt(0)" ::: "memory")

constexpr size_t E_WIN = 0, E_WOUT = (size_t)NIN * DM, E_W1 = E_WOUT + (size_t)DM * DM, E_W2 = E_W1 + (size_t)DFF * DM, E_WG = E_W2 + (size_t)DFF * DM, E_WP = E_WG + (size_t)DM * DM,
                 E_WLAYER = E_WP + (size_t)PLE * DM;
constexpr size_t WS_W = 0, WS_WSB = WS_W + (size_t)DEPTH * E_WLAYER * 2, WS_SS = WS_WSB + (size_t)DEPTH * 4 * 128 * 128 * 2, WS_HB = WS_SS + (size_t)3 * M * 16 * 4,
                 WS_LO = WS_HB + (size_t)M * DM * 2, WS_XB = WS_LO + (size_t)M * DM * 2, WS_BIG = WS_XB + (size_t)M * DM * 2, WS_END = WS_BIG + (size_t)M * DFF * 2;
constexpr size_t SLAB_E = (size_t)SEQ * DFF, O_CONV = 0, O_Q = O_CONV + (size_t)3 * SEQ * 256, O_K = O_Q + (size_t)SEQ * 512, O_VT = O_K + (size_t)SEQ * 512, O_CU = O_VT + (size_t)SEQ * 512,
                 O_VNT = O_CU + (size_t)SEQ * 256, O_Y = O_VNT + (size_t)SEQ * 256, O_PB = O_Y + (size_t)SEQ * DM, O_END = O_PB + (size_t)SEQ * PLE;
static_assert(O_END <= SLAB_E, "a batch element's mixer tensors + its bf16 p rows fit under its F rows");
constexpr size_t WS_CTL = WS_END, CTL_BYTES = 32768, WS_TOTAL = WS_CTL + CTL_BYTES;
constexpr int RING_BYTES = 131072, RS_OFF = RING_BYTES + 64, LDS_BYTES = RS_OFF + 1024 + 960;

__device__ __forceinline__ unsigned f2bf(float f) { unsigned u = __builtin_bit_cast(unsigned, f); return (u + 0x7fffu + ((u >> 16) & 1u)) >> 16; }
typedef __bf16 bf16x2_t __attribute__((ext_vector_type(2)));
__device__ __forceinline__ unsigned pk2(float lo, float hi) { f32x2 v = {lo, hi}; bf16x2_t b = __builtin_convertvector(v, bf16x2_t); return __builtin_bit_cast(unsigned, b); }
__device__ __forceinline__ float bflo(unsigned u) { return __builtin_bit_cast(float, u << 16); }
__device__ __forceinline__ float bfhi(unsigned u) { return __builtin_bit_cast(float, u & 0xffff0000u); }
__device__ __forceinline__ float wave_sum(float v) {
#pragma unroll
    for (int o = 1; o < 64; o <<= 1) v += __shfl_xor(v, o);
    return v;
}

__device__ __forceinline__ float row_rs(const float* ssp, int r) {
    const f32x4* q = (const f32x4*)(ssp + (size_t)r * 16); const f32x4 a = q[0], b = q[1], c = q[2], d = q[3];
    const float s = ((a[0] + a[1]) + (a[2] + a[3])) + ((b[0] + b[1]) + (b[2] + b[3])) + ((c[0] + c[1]) + (c[2] + c[3])) + ((d[0] + d[1]) + (d[2] + d[3]));
    return rsqrtf(s * (1.f / 1024.f) + EPS);
}
__device__ __forceinline__ void fill_rs_table(LAS float* tab, const float* ssp, int pm, float mul, int tid) {
    asm volatile("" : "+v"(tid));
    if (tid < 256) tab[tid] = row_rs(ssp, pm * 256 + tid) * mul;
    asm volatile("s_waitcnt vmcnt(0) lgkmcnt(0)" ::: "memory"); __syncthreads();
}
struct EpiInProj {
    static constexpr bool PERM = true, AFTER_DRAIN = false;
    const LAS float* rst; bf16* conv; bf16* q; bf16* k; bf16* vt; bf16* cu; bf16* vnt; const float* qg; const float* kg; const float* sg;
    __device__ __forceinline__ void operator()(const pg8::f32x4 (&acc)[2][2][4][2], const pg8::Unit& u, int wr, int wc, int fr, int fq) const {
        const int sec = u.pn;
        const int row0 = u.pm * 256 + wr * 64 + fr;
        const int cw = 64 * wc + 8 * fq;
        const bool normed = (sec >= 3 && sec < 7) || sec == 10;
        float rsv[8];
#pragma unroll
        for (int g = 0; g < 8; ++g) { rsv[g] = rst[(g >> 2) * 128 + wr * 64 + (g & 3) * 16 + fr]; }
        f32x4 gv[2][2];
#pragma unroll
        for (int bj = 0; bj < 2; ++bj)
#pragma unroll
            for (int n = 0; n < 2; ++n) {
                if (sec >= 3 && sec < 7) { const float* g = sec < 5 ? qg : kg; const float sc = sec < 5 ? C2 : 1.f; gv[bj][n] = *(const f32x4*)(g + 32 * bj + 8 * fq + 4 * n) * sc; }
                else if (sec == 10) gv[bj][n] = *(const f32x4*)(sg + cw + 32 * bj + 4 * n);
                else gv[bj][n] = (f32x4){1.f, 1.f, 1.f, 1.f};
            }
#pragma unroll
        for (int ai = 0; ai < 2; ++ai)
#pragma unroll
            for (int m = 0; m < 4; ++m) {
                const int r = row0 + ai * 128 + m * 16;
                const float rs = rsv[ai * 4 + m];
                f32x4 v[2][2];
#pragma unroll
                for (int bj = 0; bj < 2; ++bj)
#pragma unroll
                    for (int n = 0; n < 2; ++n) v[bj][n] = acc[ai][bj][m][n] * rs;
                if (sec >= 9) {
#pragma unroll
                    for (int bj = 0; bj < 2; ++bj)
#pragma unroll
                        for (int n = 0; n < 2; ++n) { const pg8::f32x2 a = pg8::gelu_pk((pg8::f32x2){v[bj][n][0], v[bj][n][1]}), b = pg8::gelu_pk((pg8::f32x2){v[bj][n][2], v[bj][n][3]}); v[bj][n] = (f32x4){a.x, a.y, b.x, b.y}; }
                }
                if (normed) {
                    float s2 = 0.f;
#pragma unroll
                    for (int bj = 0; bj < 2; ++bj)
#pragma unroll
                        for (int n = 0; n < 2; ++n) { const f32x4 x = v[bj][n]; s2 += (x[0] * x[0] + x[1] * x[1]) + (x[2] * x[2] + x[3] * x[3]); }
                    s2 += __shfl_xor(s2, 16); s2 += __shfl_xor(s2, 32);
                    const float rn = rsqrtf(s2 * (1.f / 64.f) + EPS);
#pragma unroll
                    for (int bj = 0; bj < 2; ++bj)
#pragma unroll
                        for (int n = 0; n < 2; ++n) v[bj][n] = v[bj][n] * rn * gv[bj][n];
                }
                const int s = r & 2047; const size_t bo = (size_t)(r >> 11) * SLAB_E;
                if (sec == 10) {
                    const int sl = s & 127;
                    bf16* base = vnt + bo + ((((size_t)(wc * 16 + (s >> 7)) * 2) * 8 + (sl >> 4)) * 64 + ((sl >> 3) & 1) * 32 + 8 * fq) * 8 + (sl & 7);
#pragma unroll
                    for (int bj = 0; bj < 2; ++bj)
#pragma unroll
                        for (int n = 0; n < 2; ++n)
#pragma unroll
                            for (int j = 0; j < 4; ++j) base[(size_t)bj * 8 * 64 * 8 + (4 * n + j) * 8] = (bf16)f2bf(v[bj][n][j]);
                } else if (sec == 7 || sec == 8) {
                    const int kk_ = s & 31;
                    bf16* base = vt + bo + (((size_t)((4 * (sec - 7) + wc) * 64 + (s >> 5)) * 4 + (kk_ >> 4)) * 64 + ((kk_ >> 3) & 1) * 32 + 8 * fq) * 8 + (kk_ & 7);
#pragma unroll
                    for (int bj = 0; bj < 2; ++bj)
#pragma unroll
                        for (int n = 0; n < 2; ++n)
#pragma unroll
                            for (int j = 0; j < 4; ++j) base[(size_t)bj * 2 * 64 * 8 + (4 * n + j) * 8] = (bf16)f2bf(v[bj][n][j]);
                } else if (sec >= 3 && sec < 7) {
                    const bool isq = sec < 5;
                    const int sl = s & 31, pos = isq ? sl : ((sl & 0x13) | ((sl & 4) << 1) | ((sl & 8) >> 1));
                    bf16* base = (isq ? q : k) + bo + (((size_t)((4 * ((sec - 3) & 1) + wc) * 64 + (s >> 5)) * 4 + (fq >> 1)) * 64 + (fq & 1) * 32 + pos) * 8;
#pragma unroll
                    for (int bj = 0; bj < 2; ++bj) { v4u w; w.x = pk2(v[bj][0][0], v[bj][0][1]); w.y = pk2(v[bj][0][2], v[bj][0][3]); w.z = pk2(v[bj][1][0], v[bj][1][1]); w.w = pk2(v[bj][1][2], v[bj][1][3]);
                        *(v4u*)(base + (size_t)bj * 2 * 64 * 8) = w; }
                } else {
                    bf16* dst; int ld;
                    if (sec < 3) { dst = conv + bo + (size_t)sec * SEQ * 256 + cw; ld = 256; }
                    else { dst = cu + bo + cw; ld = 256; }
                    dst += (size_t)s * ld;
#pragma unroll
                    for (int bj = 0; bj < 2; ++bj) { v4u w; w.x = pk2(v[bj][0][0], v[bj][0][1]); w.y = pk2(v[bj][0][2], v[bj][0][3]); w.z = pk2(v[bj][1][0], v[bj][1][1]); w.w = pk2(v[bj][1][2], v[bj][1][3]);
                        *(v4u*)(dst + 32 * bj) = w; }
                }
            }
    }
};

__device__ __forceinline__ void unpk(const v4u w, f32x4& a, f32x4& b) { a = (f32x4){bflo(w.x), bfhi(w.x), bflo(w.y), bfhi(w.y)}; b = (f32x4){bflo(w.z), bfhi(w.z), bflo(w.w), bfhi(w.w)}; }
__device__ __forceinline__ void split_store(const f32x4 h0, const f32x4 h1, bf16* hi, bf16* lo) {
    v4u w; w.x = pk2(h0[0], h0[1]); w.y = pk2(h0[2], h0[3]); w.z = pk2(h1[0], h1[1]); w.w = pk2(h1[2], h1[3]); *(v4u*)hi = w;
    f32x4 a, b; unpk(w, a, b); const f32x4 d0 = h0 - a, d1 = h1 - b;
    v4u l; l.x = pk2(d0[0], d0[1]); l.y = pk2(d0[2], d0[3]); l.z = pk2(d1[0], d1[1]); l.w = pk2(d1[2], d1[3]); *(v4u*)lo = l;
}
struct EpiRes {
    static constexpr bool PERM = true, AFTER_DRAIN = false;
    bf16* hi; bf16* lo; float* ssout; int use_lo, write_lo;
    __device__ __forceinline__ void operator()(const pg8::f32x4 (&acc)[2][2][4][2], const pg8::Unit& u, int wr, int wc, int fr, int fq) const {
        const int row0 = u.pm * 256 + wr * 64 + fr, col0 = u.pn * 256 + wc * 32 + 8 * fq;
        constexpr int LA = 2;
        v4u bq[8][4];
#pragma unroll
        for (int g = 0; g < LA; ++g) { const size_t off = (size_t)(row0 + (g >> 2) * 128 + (g & 3) * 16) * DM + col0;
#pragma unroll
            for (int bj = 0; bj < 2; ++bj) { bq[g][2 * bj] = *(const v4u*)(hi + off + bj * 128); bq[g][2 * bj + 1] = use_lo ? *(const v4u*)(lo + off + bj * 128) : (v4u){0u, 0u, 0u, 0u}; } }
#pragma unroll
        for (int g = 0; g < 8; ++g) {
            if (g + LA < 8) { const int gn = g + LA; const size_t off = (size_t)(row0 + (gn >> 2) * 128 + (gn & 3) * 16) * DM + col0;
#pragma unroll
                for (int bj = 0; bj < 2; ++bj) { bq[gn][2 * bj] = *(const v4u*)(hi + off + bj * 128); bq[gn][2 * bj + 1] = use_lo ? *(const v4u*)(lo + off + bj * 128) : (v4u){0u, 0u, 0u, 0u}; } }
            const int ai = g >> 2, m = g & 3;
            const int r = row0 + ai * 128 + m * 16; const size_t off = (size_t)r * DM + col0; float s2 = 0.f;
#pragma unroll
            for (int bj = 0; bj < 2; ++bj) {
                f32x4 a0, a1, l0, l1; unpk(bq[g][2 * bj], a0, a1); unpk(bq[g][2 * bj + 1], l0, l1);
                const f32x4 h0 = (a0 + l0) + acc[ai][bj][m][0], h1 = (a1 + l1) + acc[ai][bj][m][1];
                if (write_lo) split_store(h0, h1, hi + off + bj * 128, lo + off + bj * 128);
                else { v4u w; w.x = pk2(h0[0], h0[1]); w.y = pk2(h0[2], h0[3]); w.z = pk2(h1[0], h1[1]); w.w = pk2(h1[2], h1[3]); *(v4u*)(hi + off + bj * 128) = w; }
                s2 += (h0[0] * h0[0] + h0[1] * h0[1]) + (h0[2] * h0[2] + h0[3] * h0[3]) + (h1[0] * h1[0] + h1[1] * h1[1]) + (h1[2] * h1[2] + h1[3] * h1[3]);
            }
            s2 += __shfl_xor(s2, 16); s2 += __shfl_xor(s2, 32);
            if (fq == 0) ssout[(size_t)r * 16 + u.pn * 4 + wc] = s2;
            asm volatile("" ::: "memory");
        }
    }
};
struct EpiFF1 {
    static constexpr bool PERM = true, AFTER_DRAIN = false;
    const LAS float* rst; bf16* f;
    __device__ __forceinline__ void operator()(const pg8::f32x4 (&acc)[2][2][4][2], const pg8::Unit& u, int wr, int wc, int fr, int fq) const {
        const int row0 = u.pm * 256 + wr * 64 + fr, col0 = u.pn * 256 + wc * 32 + 8 * fq;
        float rsv[8];
#pragma unroll
        for (int g = 0; g < 8; ++g) { rsv[g] = rst[(g >> 2) * 128 + wr * 64 + (g & 3) * 16 + fr]; }
#pragma unroll
        for (int ai = 0; ai < 2; ++ai)
#pragma unroll
            for (int m = 0; m < 4; ++m) {
                const int r = row0 + ai * 128 + m * 16; const float rs = rsv[ai * 4 + m]; bf16* dst = f + (size_t)r * DFF + col0;
#pragma unroll
                for (int bj = 0; bj < 2; ++bj) {
                    f32x4 a = acc[ai][bj][m][0] * rs, b = acc[ai][bj][m][1] * rs;
#pragma unroll
                    for (int j = 0; j < 4; ++j) { a[j] = fmaxf(a[j], 0.f); a[j] *= a[j]; b[j] = fmaxf(b[j], 0.f); b[j] *= b[j]; }
                    v4u w; w.x = pk2(a[0], a[1]); w.y = pk2(a[2], a[3]); w.z = pk2(b[0], b[1]); w.w = pk2(b[2], b[3]); *(v4u*)(dst + bj * 128) = w;
                }
            }
    }
};
struct EpiT {
    static constexpr bool PERM = true, AFTER_DRAIN = false;
    bf16* t;
    __device__ __forceinline__ void operator()(const pg8::f32x4 (&acc)[2][2][4][2], const pg8::Unit& u, int wr, int wc, int fr, int fq) const {
        const int row0 = u.pm * 256 + wr * 64 + fr, col0 = u.pn * 256 + wc * 32 + 8 * fq;
#pragma unroll
        for (int ai = 0; ai < 2; ++ai)
#pragma unroll
            for (int m = 0; m < 4; ++m) {
                bf16* dst = t + (size_t)(row0 + ai * 128 + m * 16) * DM + col0;
#pragma unroll
                for (int bj = 0; bj < 2; ++bj) { const f32x4 a = acc[ai][bj][m][0], b = acc[ai][bj][m][1];
                    v4u w; w.x = pk2(a[0], a[1]); w.y = pk2(a[2], a[3]); w.z = pk2(b[0], b[1]); w.w = pk2(b[2], b[3]); *(v4u*)(dst + bj * 128) = w; }
            }
    }
};
struct EpiGate {
    static constexpr bool PERM = true, AFTER_DRAIN = false;
    const LAS float* rst; const bf16* hi; bf16* lo; bf16* tx; float* ssout; float* fout; int use_lo;
    __device__ __forceinline__ void operator()(const pg8::f32x4 (&acc)[2][2][4][2], const pg8::Unit& u, int wr, int wc, int fr, int fq) const {
        const int row0 = u.pm * 256 + wr * 64 + fr, col0 = u.pn * 256 + wc * 32 + 8 * fq;
        float rsv[8];
#pragma unroll
        for (int g = 0; g < 8; ++g) { rsv[g] = rst[(g >> 2) * 128 + wr * 64 + (g & 3) * 16 + fr]; }
        v4u hq[16], lq[16], tq[16];
        { const size_t off = (size_t)row0 * DM + col0; tq[0] = *(const v4u*)(tx + off); hq[0] = *(const v4u*)(hi + off); lq[0] = use_lo ? *(const v4u*)(lo + off) : (v4u){0u, 0u, 0u, 0u}; }
        float s2 = 0.f;
#pragma unroll
        for (int q = 0; q < 16; ++q) {
            if (q + 1 < 16) { const int gn = (q + 1) >> 1, bn = (q + 1) & 1; const size_t off = (size_t)(row0 + (gn >> 2) * 128 + (gn & 3) * 16) * DM + col0 + bn * 128;
                tq[q + 1] = *(const v4u*)(tx + off); hq[q + 1] = *(const v4u*)(hi + off); lq[q + 1] = use_lo ? *(const v4u*)(lo + off) : (v4u){0u, 0u, 0u, 0u}; }
            const int g = q >> 1, bj = q & 1, ai = g >> 2, m = g & 3;
            const int r = row0 + ai * 128 + m * 16; const float rs = rsv[g]; const size_t off = (size_t)r * DM + col0 + bj * 128;
            f32x4 t0, t1, a0, a1, l0, l1; unpk(tq[q], t0, t1); unpk(hq[q], a0, a1); unpk(lq[q], l0, l1);
            f32x4 g0 = acc[ai][bj][m][0] * rs, g1 = acc[ai][bj][m][1] * rs;
#pragma unroll
            for (int j = 0; j < 4; ++j) { g0[j] = __builtin_amdgcn_rcpf(1.f + __builtin_amdgcn_exp2f(g0[j])); g1[j] = __builtin_amdgcn_rcpf(1.f + __builtin_amdgcn_exp2f(g1[j])); }
            const f32x4 h0 = (a0 + l0) + g0 * t0, h1 = (a1 + l1) + g1 * t1;
            if (!fout) { v4u w; w.x = pk2(h0[0], h0[1]); w.y = pk2(h0[2], h0[3]); w.z = pk2(h1[0], h1[1]); w.w = pk2(h1[2], h1[3]); *(v4u*)(tx + off) = w; }
            if (fout) { *(f32x4*)(fout + off) = h0; *(f32x4*)(fout + off + 4) = h1; }
            s2 += (h0[0] * h0[0] + h0[1] * h0[1]) + (h0[2] * h0[2] + h0[3] * h0[3]) + (h1[0] * h1[0] + h1[1] * h1[1]) + (h1[2] * h1[2] + h1[3] * h1[3]);
            if (bj == 1) {
                s2 += __shfl_xor(s2, 16); s2 += __shfl_xor(s2, 32);
                if (fq == 0 && !fout) ssout[(size_t)r * 16 + u.pn * 4 + wc] = s2;
                s2 = 0.f;
            }
            asm volatile("" ::: "memory");
        }
    }
};

struct TSched {
    int c, c0, G;
    __device__ __forceinline__ bool next(int i, pg8::Unit& u) const {
        if (c < c0) return false;
        if (G == 256 && c0 == 192) { if (i >= 4) return false; u.pm = 8 * (c & 7) + ((c - c0) >> 3); u.pn = i; return true; }
        const int un = (c - c0) + i * (G - c0); if (un >= 256) return false; u.pm = un >> 2; u.pn = un & 3; return true; }
    __device__ __forceinline__ void a_ready(const pg8::Unit&) const {}
    __device__ __forceinline__ void done(const pg8::Unit&) const {}
};
struct TrJob { const float* W; bf16* WT; const float* g; int K, N, item, hperm; };
__device__ __forceinline__ void tr_load(const TrJob& j, int lane, f32x4 (&v)[8]) {
    const int nblk = j.N / 32, kb = j.item / nblk, nb = j.item % nblk, k0 = 64 * kb, n0 = 32 * nb;
    const int kr = lane >> 3, nq = (lane & 7) * 4;
#pragma unroll
    for (int i = 0; i < 8; ++i) v[i] = *(const f32x4*)(j.W + (size_t)(k0 + 8 * i + kr) * j.N + n0 + nq);
    if (j.g) {
#pragma unroll
        for (int i = 0; i < 8; ++i) v[i] = v[i] * j.g[k0 + 8 * i + kr];
    }
}
__device__ __forceinline__ void tr_finish(const TrJob& j, int lane, const f32x4 (&v)[8], LAS float* scr) {
    const int nblk = j.N / 32, kb = j.item / nblk, nb = j.item % nblk, k0 = 64 * kb, n0 = 32 * nb;
    const int kr = lane >> 3, nq = (lane & 7) * 4;
#pragma unroll
    for (int i = 0; i < 8; ++i) { LAS float* d = scr + (8 * i + kr) * 33 + nq; d[0] = v[i][0]; d[1] = v[i][1]; d[2] = v[i][2]; d[3] = v[i][3]; }
    LDS_WAIT(); asm volatile("" ::: "memory");
    int d0 = n0; if (j.hperm) { const int gi = (n0 >> 5) & 7; d0 = (n0 & ~255) + 32 * (4 * (gi & 1) + (gi >> 1)); }
    const int c = lane & 7;
#pragma unroll
    for (int q = 0; q < 4; ++q) { const int n = (lane >> 3) + 8 * q; const LAS float* sp = scr + (8 * c) * 33 + n;
        v4u o; o.x = pk2(sp[0 * 33], sp[1 * 33]); o.y = pk2(sp[2 * 33], sp[3 * 33]); o.z = pk2(sp[4 * 33], sp[5 * 33]); o.w = pk2(sp[6 * 33], sp[7 * 33]);
        *(v4u*)(j.WT + (size_t)(d0 + n) * j.K + k0 + 8 * c) = o; }
    LDS_WAIT(); asm volatile("" ::: "memory");
}

__device__ __forceinline__ int crow(int r, int hf) { return (r & 3) + 8 * (r >> 2) + 4 * hf; }
__device__ __forceinline__ bool attn_tile(const bf16x8 (&kf)[4], const bf16x8 (&vf)[4], const bf16x8 (&qr)[4], f32x16& o0, f32x16& o1, float& carry, bool diag, int t, int hf) {
    f32x16 z;
#pragma unroll
    for (int r = 0; r < 16; ++r) z[r] = 0.f;
#pragma unroll
    for (int kk = 0; kk < 4; ++kk) z = __builtin_amdgcn_mfma_f32_32x32x16_bf16(kf[kk], qr[kk], z, 0, 0, 0);
    float e[16], w[16];
#pragma unroll
    for (int r = 0; r < 16; ++r) {
        float ev = __builtin_amdgcn_exp2f(__builtin_amdgcn_fmed3f(z[r], -3.0e38f, 31.f));
        if (diag) { const bool valid = (16 * (r >> 3) + 8 * hf + (r & 7)) < t; ev = valid ? ev : 0.f; }
        e[r] = ev;
    }
    float R[2], fb[2], ia_[2];
#pragma unroll
    for (int ks = 0; ks < 2; ++ks) {
        const int a = 8 * ks, b = 8 * ks + 4;
        const float da0 = 1.f + e[a], da1 = 1.f + e[a + 1], da2 = 1.f + e[a + 2], da3 = 1.f + e[a + 3];
        const float db0 = 1.f + e[b], db1 = 1.f + e[b + 1], db2 = 1.f + e[b + 2], db3 = 1.f + e[b + 3];
        const float pa2 = da0 * da1, pa3 = pa2 * da2, Pa = pa3 * da3;
        const float pb2 = db0 * db1, pb3 = pb2 * db2, Pb = pb3 * db3;
        const float ia = __builtin_amdgcn_rcpf(Pa), ib = __builtin_amdgcn_rcpf(Pb);
        w[a] = e[a]; w[a + 1] = e[a + 1] * da0; w[a + 2] = e[a + 2] * pa2; w[a + 3] = e[a + 3] * pa3;
        w[b] = e[b]; w[b + 1] = e[b + 1] * db0; w[b + 2] = e[b + 2] * pb2; w[b + 3] = e[b + 3] * pb3;
        ia_[ks] = ia; fb[ks] = ib; R[ks] = ia * ib;
        __builtin_amdgcn_sched_barrier(0);
    }
    const float Rp0 = __shfl_xor(R[0], 32), Rp1 = __shfl_xor(R[1], 32);
    const float T1 = R[1] * Rp1, T0 = R[0] * Rp0;
    const float L1 = hf ? carry : carry * Rp1;
    const float c0 = carry * T1, L0 = hf ? c0 : c0 * Rp0;
    carry = c0 * T0;
    { const float f0b = fb[0] * L0, f0a = ia_[0] * f0b, f1b = fb[1] * L1, f1a = ia_[1] * f1b;
#pragma unroll
      for (int jj = 0; jj < 4; ++jj) { w[jj] *= f0a; w[4 + jj] *= f0b; w[8 + jj] *= f1a; w[12 + jj] *= f1b; } }
#pragma unroll
    for (int ks = 0; ks < 2; ++ks) {
        v4u pw; pw.x = pk2(w[8 * ks], w[8 * ks + 1]); pw.y = pk2(w[8 * ks + 2], w[8 * ks + 3]); pw.z = pk2(w[8 * ks + 4], w[8 * ks + 5]); pw.w = pk2(w[8 * ks + 6], w[8 * ks + 7]);
        const bf16x8 pf = __builtin_bit_cast(bf16x8, pw);
        o0 = __builtin_amdgcn_mfma_f32_32x32x16_bf16(vf[ks], pf, o0, 0, 0, 0);
        o1 = __builtin_amdgcn_mfma_f32_32x32x16_bf16(vf[2 + ks], pf, o1, 0, 0, 0);
    }
#if ATT_EARLY_EXIT
    return __all(carry == 0.f);
#else
    return false;
#endif
}
#define ATT_LOAD(KD, VD, TJ) do { const size_t o_ = (size_t)(TJ) * 2048; _Pragma("unroll") for (int i_ = 0; i_ < 4; ++i_) { KD[i_] = *(const bf16x8*)(kbase + o_ + i_ * 512); VD[i_] = *(const bf16x8*)(vbase + o_ + i_ * 512); } \
        __builtin_amdgcn_sched_barrier(0); } while (0)
__device__ __forceinline__ void attn_task(const bf16* Q, const bf16* K, const bf16* VT, bf16* Y, int b, int h, int qb, int lane) {
    const int t = lane & 31, hf = lane >> 5, q0 = qb * 32;
    const size_t hb = (size_t)(b * 8 + h) * 64;
    const bf16* qp = Q + ((hb + qb) * 4 * 64 + lane) * 8;
    bf16x8 qr[4];
#pragma unroll
    for (int kk = 0; kk < 4; ++kk) qr[kk] = *(const bf16x8*)(qp + kk * 512);
    const bf16* kbase = K + (hb * 4 * 64 + lane) * 8;
    const bf16* vbase = VT + (hb * 4 * 64 + lane) * 8;
    f32x16 o0, o1;
#pragma unroll
    for (int r = 0; r < 16; ++r) { o0[r] = 0.f; o1[r] = 0.f; }
    float carry = 1.f;
    bf16x8 ka[4], va[4], kb[4], vb[4];
    ATT_LOAD(ka, va, qb);
    ATT_LOAD(kb, vb, qb > 0 ? qb - 1 : 0);
    __builtin_amdgcn_s_waitcnt(0x0F78);
    bool done = attn_tile(ka, va, qr, o0, o1, carry, true, t, hf);
    int j = qb - 1;
    while (!done && j >= 0) {
        __builtin_amdgcn_s_waitcnt(0x0F70);
        ATT_LOAD(ka, va, j > 0 ? j - 1 : 0);
        done = attn_tile(kb, vb, qr, o0, o1, carry, false, t, hf); --j;
        if (done || j < 0) break;
        ATT_LOAD(kb, vb, j > 0 ? j - 1 : 0);
        __builtin_amdgcn_s_waitcnt(0x0F78);
        done = attn_tile(ka, va, qr, o0, o1, carry, false, t, hf); --j;
    }
    bf16* yp = Y + (size_t)(b * SEQ + q0 + t) * DM + 256 + h * 64 + 4 * hf;
#pragma unroll
    for (int g = 0; g < 4; ++g) {
        v2u a; a.x = pk2(o0[4 * g], o0[4 * g + 1]); a.y = pk2(o0[4 * g + 2], o0[4 * g + 3]); *(v2u*)(yp + 8 * g) = a;
        v2u c; c.x = pk2(o1[4 * g], o1[4 * g + 1]); c.y = pk2(o1[4 * g + 2], o1[4 * g + 3]); *(v2u*)(yp + 32 + 8 * g) = c;
    }
}
__device__ __forceinline__ void sgu_task(const bf16* VNT, const bf16* WSB, const bf16* CU, const float* bias, bf16* Y, int task, int lane) {
    const int tb = task & 3, g = (task >> 2) & 3, c = (task >> 4) & 15, b = task >> 8;
    const int t = lane & 31, hf = lane >> 5;
    const bf16* ap = VNT + ((size_t)((b * 4 + g) * 16 + c) * 2 * 8 * 64 + lane) * 8;
    const bf16* bp = WSB + ((size_t)(g * 4 + tb) * 8 * 64 + lane) * 8;
    f32x16 a0, a1;
#pragma unroll
    for (int r = 0; r < 16; ++r) { a0[r] = 0.f; a1[r] = 0.f; }
    bf16x8 bfr[8], af0[8], af1[8];
#pragma unroll
    for (int ks = 0; ks < 8; ++ks) { bfr[ks] = *(const bf16x8*)(bp + 512 * ks); af0[ks] = *(const bf16x8*)(ap + 512 * ks); af1[ks] = *(const bf16x8*)(ap + 4096 + 512 * ks); }
#pragma unroll
    for (int ks = 0; ks < 8; ++ks) {
        a0 = __builtin_amdgcn_mfma_f32_32x32x16_bf16(af0[ks], bfr[ks], a0, 0, 0, 0);
        a1 = __builtin_amdgcn_mfma_f32_32x32x16_bf16(af1[ks], bfr[ks], a1, 0, 0, 0);
    }
    const int tok = b * SEQ + 128 * c + 32 * tb + t;
    const float bs = bias[g * 128 + 32 * tb + t];
    const bf16* up = CU + (size_t)tok * 256 + 64 * g + 4 * hf;
    bf16* yp = Y + (size_t)tok * DM + 768 + 64 * g + 4 * hf;
#pragma unroll
    for (int gg = 0; gg < 4; ++gg) {
        const v2u u0 = *(const v2u*)(up + 8 * gg), u1 = *(const v2u*)(up + 32 + 8 * gg);
        v2u a; a.x = pk2(bflo(u0.x) * (a0[4 * gg] + bs), bfhi(u0.x) * (a0[4 * gg + 1] + bs)); a.y = pk2(bflo(u0.y) * (a0[4 * gg + 2] + bs), bfhi(u0.y) * (a0[4 * gg + 3] + bs)); *(v2u*)(yp + 8 * gg) = a;
        v2u d; d.x = pk2(bflo(u1.x) * (a1[4 * gg] + bs), bfhi(u1.x) * (a1[4 * gg + 1] + bs)); d.y = pk2(bflo(u1.y) * (a1[4 * gg + 2] + bs), bfhi(u1.y) * (a1[4 * gg + 3] + bs)); *(v2u*)(yp + 32 + 8 * gg) = d;
    }
}
__device__ __forceinline__ void unpack8(const v4u w, float (&f)[8]) { f[0] = bflo(w.x); f[1] = bfhi(w.x); f[2] = bflo(w.y); f[3] = bfhi(w.y); f[4] = bflo(w.z); f[5] = bfhi(w.z); f[6] = bflo(w.w); f[7] = bfhi(w.w); }
__device__ __forceinline__ void conv_task(const bf16* CONV, const float* cwt, bf16* Y, int task, int lane) {
    const int ch = (lane & 31) * 8;
    float w0[8], w1[8], w2[8];
#pragma unroll
    for (int e = 0; e < 8; ++e) { w0[e] = cwt[ch + e]; w1[e] = cwt[256 + ch + e]; w2[e] = cwt[512 + ch + e]; }
    const bf16* ab = CONV; const bf16* ac = CONV + (size_t)SEQ * 256; const bf16* ah = CONV + (size_t)2 * SEQ * 256;
#pragma unroll
    for (int it = 0; it < 4; ++it) {
        const int tok = task * 8 + it * 2 + (lane >> 5), s = tok & (SEQ - 1);
        const size_t o = (size_t)tok * 256 + ch;
        float fb[8], c0[8], h0[8], c1[8], h1[8], c2[8], h2[8];
        unpack8(*(const v4u*)(ab + o), fb); unpack8(*(const v4u*)(ac + o), c0); unpack8(*(const v4u*)(ah + o), h0);
        const v4u zz = (v4u){0u, 0u, 0u, 0u};
        unpack8(s >= 1 ? *(const v4u*)(ac + o - 256) : zz, c1); unpack8(s >= 1 ? *(const v4u*)(ah + o - 256) : zz, h1);
        unpack8(s >= 2 ? *(const v4u*)(ac + o - 512) : zz, c2); unpack8(s >= 2 ? *(const v4u*)(ah + o - 512) : zz, h2);
        float y[8];
#pragma unroll
        for (int e = 0; e < 8; ++e) y[e] = fb[e] * (w2[e] * (c0[e] * h0[e]) + w1[e] * (c1[e] * h1[e]) + w0[e] * (c2[e] * h2[e]));
        v4u w; w.x = pk2(y[0], y[1]); w.y = pk2(y[2], y[3]); w.z = pk2(y[4], y[5]); w.w = pk2(y[6], y[7]);
        *(v4u*)(Y + (size_t)tok * DM + ch) = w;
    }
}

#define RLX_AGENT __ATOMIC_RELAXED, __HIP_MEMORY_SCOPE_AGENT
#define XB_TMO      128
#define XB_XCNT(j)  (256  + 64 * (j))
#define XB_XSUB(j)  (1280 + 64 * (j))
#define XB_XGEN(j)  (2304 + 64 * (j))
#define XB_TOP      3328
#define XB_TOPGEN   3392
#define XCD_BAR_WORDS 3456
#define XB_SPIN_CAP (1u << 18)

__device__ __forceinline__ unsigned xb_ld(unsigned* p)              { return __hip_atomic_load(p, __ATOMIC_RELAXED, __HIP_MEMORY_SCOPE_AGENT); }
__device__ __forceinline__ unsigned xb_add(unsigned* p, unsigned v) { return __hip_atomic_fetch_add(p, v, __ATOMIC_RELAXED, __HIP_MEMORY_SCOPE_AGENT); }
__device__ __forceinline__ unsigned xb_xcc_id() { return (unsigned)__builtin_amdgcn_s_getreg((3 << 11) | 20) & 0xFu; }
#define XB_SPIN(cond, bar) do { unsigned _sp = 0; while (cond) { __builtin_amdgcn_s_sleep(1); \
    if ((++_sp & 255u) == 0u) { if (xb_ld(&(bar)[XB_TMO])) break; if (_sp > XB_SPIN_CAP) { atomicAdd(&(bar)[XB_TMO], 1u); break; } } } } while (0)

struct XcdBarrier {
    int wave;
    unsigned* bar; unsigned x;
    volatile LAS unsigned* st;
};

__device__ __forceinline__ XcdBarrier xcd_barrier_post(unsigned* bar, volatile LAS unsigned* st) {
    XcdBarrier b; b.bar = bar; b.x = xb_xcc_id(); b.st = st;
    if (threadIdx.x == 0) (void)xb_add(&bar[XB_XCNT(b.x)], 1u);
    return b;
}
__device__ __forceinline__ void xcd_barrier_complete(unsigned* bar, unsigned x, unsigned& nloc, unsigned& nx) {
    const unsigned G = gridDim.x * gridDim.y * gridDim.z;
    unsigned sum, cnt, mine, sp = 0u;
    for (;;) {
        sum = 0u; cnt = 0u; mine = 0u;
#pragma unroll
        for (unsigned j = 0; j < 16; ++j) { const unsigned c = xb_ld(&bar[XB_XCNT(j)]); sum += c; cnt += (c > 0u) ? 1u : 0u; mine = (j == x) ? c : mine; }
        if (sum == G) break;
        __builtin_amdgcn_s_sleep(1);
        if ((++sp & 255u) == 0u) { if (xb_ld(&bar[XB_TMO])) break; if (sp > XB_SPIN_CAP) { atomicAdd(&bar[XB_TMO], 1u); break; } }
    }
    nloc = mine > 0u ? mine : 1u; nx = cnt > 0u ? cnt : 1u;
}

__device__ __forceinline__ void xcd_barrier(const XcdBarrier& b, bool local_seam) {
    asm volatile("s_waitcnt vmcnt(0)" ::: "memory");
    __syncthreads();
    if (b.wave == 0 && __builtin_amdgcn_mbcnt_hi(~0u, __builtin_amdgcn_mbcnt_lo(~0u, 0u)) == 0u) {
        unsigned* bar = b.bar;
        __builtin_amdgcn_s_waitcnt(0);
        unsigned nloc = b.st[0], nx = b.st[1];
        if (nloc == 0u) { xcd_barrier_complete(bar, b.x, nloc, nx); b.st[0] = nloc; b.st[1] = nx; }
        const unsigned old = xb_add(&bar[XB_XSUB(b.x)], 1u);
        const unsigned gen = old / nloc;
        const bool local = local_seam && (b.st[2] != 0u);
        if (old + 1u == (gen + 1u) * nloc) {
            if (!local) {
            __builtin_amdgcn_fence(__ATOMIC_RELEASE, "agent");
            asm volatile("s_waitcnt vmcnt(0)" ::: "memory");
            const unsigned og = xb_add(&bar[XB_TOP], 1u);
            const unsigned tg = og / nx;
            if (og + 1u == (tg + 1u) * nx) xb_add(&bar[XB_TOPGEN], 1u);
            else XB_SPIN(xb_ld(&bar[XB_TOPGEN]) == tg, bar);
            }
            __builtin_amdgcn_fence(__ATOMIC_ACQUIRE, "agent");
            xb_add(&bar[XB_XGEN(b.x)], 1u);
            asm volatile("s_waitcnt vmcnt(0)" ::: "memory");
        } else {
            XB_SPIN(xb_ld(&bar[XB_XGEN(b.x)]) == gen, bar);
            __builtin_amdgcn_fence(__ATOMIC_ACQUIRE, "agent");
            asm volatile("s_waitcnt vmcnt(0)" ::: "memory");
        }
    }
    __syncthreads();
}

struct Args { const float* in[17]; float* out; unsigned char* ws; int ph_lo, ph_hi; };
__global__ void __launch_bounds__(NWAVES * 64, 2) mk_fwd(Args a) {
    extern __shared__ __attribute__((aligned(16))) unsigned char lds_raw[];
    LAS unsigned char* lds = (LAS unsigned char*)lds_raw;
    const int tid = threadIdx.x, lane = tid & 63, wave = __builtin_amdgcn_readfirstlane(tid >> 6);
    const int G = gridDim.x; const int bx = blockIdx.x; const int vcu = (G % 8 == 0) ? (bx % 8) * (G / 8) + bx / 8 : bx;
    const int gw = vcu * NWAVES + wave, NGW = G * NWAVES;
    const int lo = a.ph_lo, hi = a.ph_hi;
    volatile LAS unsigned* bst = (volatile LAS unsigned*)(lds + RING_BYTES);
    if (tid < 4) bst[tid] = 0u;
    __syncthreads();
    XcdBarrier bar = xcd_barrier_post((unsigned*)(a.ws + WS_CTL), bst);
    bar.wave = wave;
    unsigned* xcctab = (unsigned*)(a.ws + WS_CTL) + XCD_BAR_WORDS;
    if (tid == 0) __hip_atomic_store(xcctab + bx, bar.x + 1u, __ATOMIC_RELAXED, __HIP_MEMORY_SCOPE_AGENT);
    unsigned char* ws = a.ws;
    const float* x = a.in[0]; const float* p = a.in[1];
    bf16* Wb = (bf16*)(ws + WS_W); bf16* WSBb = (bf16*)(ws + WS_WSB); float* SS = (float*)(ws + WS_SS);
    bf16* HB = (bf16*)(ws + WS_HB); bf16* LO = (bf16*)(ws + WS_LO); bf16* XB = (bf16*)(ws + WS_XB);
    unsigned char* big = ws + WS_BIG;
    bf16* BG = (bf16*)big;
    bf16* CONV = BG + O_CONV; bf16* Qb = BG + O_Q; bf16* Kb = BG + O_K; bf16* VTb = BG + O_VT; bf16* CUb = BG + O_CU; bf16* VNTb = BG + O_VNT; bf16* Yb = BG + O_Y; bf16* PBb = BG + O_PB; bf16* Fb = BG;
    LAS float* rstab = (LAS float*)(lds + RS_OFF);
    const int pm_blk = 8 * (bx & 7) + ((bx >> 3) & 7);
#define tid_now() (wave * 64 + (int)__builtin_amdgcn_mbcnt_hi(~0u, __builtin_amdgcn_mbcnt_lo(~0u, 0u)))
    const size_t bo_blk = (size_t)(bx & 7) * SLAB_E;
    float* H = a.out;
#define IN(k) (lo <= (k) && (k) < hi)
#define SEAM(k, loc) do { if (IN(k) && IN((k) + 1)) { if (a.ph_lo < 0) cg::this_grid().sync(); for (int sr_ = 0; sr_ < PROBE_SYNC; ++sr_) xcd_barrier(bar, loc); } } while (0)

    if (IN(0)) for (int rep_ = 0; rep_ < PROBE_P; ++rep_) {
        LAS float* scr = (LAS float*)(lds + wave * 16384);
        constexpr int I_IN = (DM / 64) * (NIN / 32), I_OUT = (DM / 64) * (DM / 32), I_1 = (DM / 64) * (DFF / 32), I_2 = (DFF / 64) * (DM / 32), I_G = I_OUT, I_P = (PLE / 64) * (DM / 32);
        constexpr int I_LAYER = I_IN + I_OUT + I_1 + I_2 + I_G + I_P;
#define TR_DECODE(J, IT) do { const int l_ = (IT) / I_LAYER; int r_ = (IT) % I_LAYER; bf16* wl_ = Wb + (size_t)l_ * E_WLAYER; \
            if (r_ < I_IN) { J = TrJob{a.in[3] + (size_t)l_ * DM * NIN, wl_ + E_WIN, a.in[2] + l_ * DM, DM, NIN, r_, 1}; } \
            else if ((r_ -= I_IN) < I_OUT) { J = TrJob{a.in[10] + (size_t)l_ * DM * DM, wl_ + E_WOUT, nullptr, DM, DM, r_, 0}; } \
            else if ((r_ -= I_OUT) < I_1) { J = TrJob{a.in[12] + (size_t)l_ * DM * DFF, wl_ + E_W1, a.in[11] + l_ * DM, DM, DFF, r_, 0}; } \
            else if ((r_ -= I_1) < I_2) { J = TrJob{a.in[13] + (size_t)l_ * DFF * DM, wl_ + E_W2, nullptr, DFF, DM, r_, 0}; } \
            else if ((r_ -= I_2) < I_G) { J = TrJob{a.in[15] + (size_t)l_ * DM * DM, wl_ + E_WG, a.in[14] + l_ * DM, DM, DM, r_, 0}; } \
            else { r_ -= I_G; J = TrJob{a.in[16] + (size_t)l_ * PLE * DM, wl_ + E_WP, nullptr, PLE, DM, r_, 0}; } } while (0)
        for (int it = gw; it < DEPTH * I_LAYER; it += 2 * NGW) {
            const int it2 = it + NGW; const bool has2 = it2 < DEPTH * I_LAYER;
            TrJob j1, j2; f32x4 v1[8], v2[8];
            TR_DECODE(j1, it); tr_load(j1, lane, v1);
            if (has2) { TR_DECODE(j2, it2); tr_load(j2, lane, v2); }
            tr_finish(j1, lane, v1, scr);
            if (has2) tr_finish(j2, lane, v2, scr);
        }
#undef TR_DECODE
        for (int i = gw * 64 + lane; i < DEPTH * 4 * 128 * 128; i += NGW * 64) {
            const int e8 = i & 7, ln = (i >> 3) & 63, ks = (i >> 9) & 7, tb = (i >> 12) & 3, lg = i >> 14; const int t = 32 * tb + (ln & 31), sk = 16 * ks + 8 * (ln >> 5) + e8;
            WSBb[i] = (bf16)f2bf(sk <= t ? a.in[8][((size_t)lg * 128 + t) * 128 + sk] : 0.f); }
        for (int m0 = gw; m0 < M; m0 += 2 * NGW) {
            f32x4 v[2][4]; float sq[2];
#pragma unroll
            for (int q = 0; q < 2; ++q) { const int m = m0 + q * NGW; sq[q] = 0.f; if (m < M) { const f32x4* xr = (const f32x4*)(x + (size_t)m * DM) + lane;
#pragma unroll
                for (int j = 0; j < 4; ++j) v[q][j] = xr[64 * j]; } }
#pragma unroll
            for (int q = 0; q < 2; ++q) { const int m = m0 + q * NGW; if (m < M) {
                float sacc = 0.f;
#pragma unroll
                for (int j = 0; j < 4; ++j) sacc += (v[q][j].x * v[q][j].x + v[q][j].y * v[q][j].y) + (v[q][j].z * v[q][j].z + v[q][j].w * v[q][j].w);
                sq[q] = wave_sum(sacc);
                v2u* o8 = (v2u*)(XB + (size_t)m * DM) + lane; v2u* l8 = (v2u*)(LO + (size_t)m * DM) + lane;
#pragma unroll
                for (int j = 0; j < 4; ++j) { v2u w; w.x = pk2(v[q][j].x, v[q][j].y); w.y = pk2(v[q][j].z, v[q][j].w); o8[64 * j] = w;
                    v2u d; d.x = pk2(v[q][j].x - bflo(w.x), v[q][j].y - bfhi(w.x)); d.y = pk2(v[q][j].z - bflo(w.y), v[q][j].w - bfhi(w.y)); l8[64 * j] = d; }
                if (lane < 16) SS[(size_t)m * 16 + lane] = lane == 0 ? sq[q] : 0.f; } }
        }
        for (int it = gw; it < M * PLE / 512; it += NGW) { const size_t o = (size_t)it * 512 + lane * 8; const f32x4 u0 = *(const f32x4*)(p + o), u1 = *(const f32x4*)(p + o + 4);
            v4u w; w.x = pk2(u0.x, u0.y); w.y = pk2(u0.z, u0.w); w.z = pk2(u1.x, u1.y); w.w = pk2(u1.z, u1.w); *(v4u*)(PBb + (size_t)(it >> 10) * SLAB_E + (o & (size_t)(SEQ * PLE - 1))) = w; }
        asm volatile("s_waitcnt vmcnt(0) lgkmcnt(0)" ::: "memory"); __syncthreads();
    }
    SEAM(0, false);
    if (lo == 0 && hi == NPHASE) {
        if (wave == 0) {
            bool ok = (G == 256);
            for (int i = lane; i < G; i += 64) { const unsigned me = __hip_atomic_load(xcctab + i, __ATOMIC_RELAXED, __HIP_MEMORY_SCOPE_AGENT), first = __hip_atomic_load(xcctab + (i & 7), __ATOMIC_RELAXED, __HIP_MEMORY_SCOPE_AGENT);
                ok = ok && (me != 0u) && (me == first); }
            const bool all_ok = __all(ok);
            if (lane == 0) bst[2] = all_ok ? 1u : 0u;
        }
        __syncthreads();
#ifdef PROBE_FAST
        if (bst[2] == 0u) { if (tid == 0) { const unsigned long long t0 = __builtin_amdgcn_s_memrealtime(); while (__builtin_amdgcn_s_memrealtime() - t0 < 40000ull) __builtin_amdgcn_s_sleep(8); } __syncthreads(); }
#endif
    }

    for (int l = 0; l < DEPTH; ++l) {
        const int pb = 1 + 6 * l;
        const bf16* wl = Wb + (size_t)l * E_WLAYER;
        bf16* bufX = (l & 1) ? HB : XB; bf16* bufT = (l & 1) ? XB : HB;
        float* ss1 = SS; float* ss2 = SS + (size_t)M * 16; float* ss3 = SS + (size_t)2 * M * 16; float* ss1n = ss1;
        if (IN(pb)) for (int rep_ = 0; rep_ < PROBE_A; ++rep_) {
#ifndef NO_A
            { pg8::Gemm g{bufX, wl + E_WIN, M, NIN, DM}; pg8::StaticOrder S; S.init(M, NIN, G, bx);
              fill_rs_table(rstab, ss1, pm_blk, 1.f, tid_now());
              EpiInProj E{rstab, CONV, Qb, Kb, VTb, CUb, VNTb, a.in[5] + l * 64, a.in[6] + l * 64, a.in[7] + l * 256};
              pg8::gemm_phase<EpiInProj, pg8::StaticOrder, true, true>(lds, g, S, E, wave); }
            { int kp = PLE; asm volatile("" : "+s"(kp)); pg8::Gemm g{PBb + bo_blk - (size_t)(8 * (bx & 7)) * 256 * PLE, wl + E_WP, M, DM, kp};     TSched S{bx, (M / 256 * (NIN / 256)) % G, G};
              EpiT E{bufT};
              pg8::gemm_phase<EpiT, TSched, true, true>(lds, g, S, E, wave); }
#endif
        }
        SEAM(pb, true);
        if (IN(pb + 1)) for (int rep_ = 0; rep_ < PROBE_B; ++rep_) {
            int lane_ = (int)__builtin_amdgcn_mbcnt_hi(~0u, __builtin_amdgcn_mbcnt_lo(~0u, 0u)); asm volatile("" : "+v"(lane_));
#pragma unroll 1
            for (int part = 0; part < 2; ++part) {
            if ((part == 0) == (wave < 4)) {
#ifndef NO_ATT
            for (int ra_ = 0; ra_ < PROBE_ATT; ++ra_)
            for (int pr = gw; pr < 2048; pr += NGW) { const int bh = pr >> 5, i = pr & 31;
                const size_t bo = (size_t)(bh >> 3) * SLAB_E;
                attn_task(Qb + bo, Kb + bo, VTb + bo, Yb + bo, 0, bh & 7, 63 - i, lane_);
                attn_task(Qb + bo, Kb + bo, VTb + bo, Yb + bo, 0, bh & 7, i, lane_); }
#endif
            } else {
#ifndef NO_SGU
            for (int tk = gw; tk < 2048; tk += NGW) { const size_t bo = (size_t)(tk >> 8) * SLAB_E; sgu_task(VNTb + bo, WSBb + (size_t)l * 4 * 128 * 128, CUb + bo, a.in[9] + l * 512, Yb + bo, tk & 255, lane_); }
#endif
#ifndef NO_CONV
            for (int tk = gw; tk < 2048; tk += NGW) { const size_t bo = (size_t)(tk >> 8) * SLAB_E; conv_task(CONV + bo, a.in[4] + l * 768, Yb + bo, tk & 255, lane_); }
#endif
            }
            }
            asm volatile("s_waitcnt vmcnt(0) lgkmcnt(0)" ::: "memory"); __syncthreads();
        }
        SEAM(pb + 1, true);
        if (IN(pb + 2)) {
#ifndef NO_C
#ifndef NO_O
            { pg8::Gemm g{Yb + bo_blk - (size_t)(8 * (bx & 7)) * 256 * DM, wl + E_WOUT, M, DM, DM}; pg8::StaticOrder S; S.init(M, DM, G, bx);
              EpiRes E{bufX, LO, ss2, l == 0 ? 1 : 0, 0};
              pg8::gemm_phase<EpiRes, pg8::StaticOrder, true, true>(lds, g, S, E, wave); }
#endif
#endif
        }
        SEAM(pb + 2, true);
        if (IN(pb + 3)) for (int rep_ = 0; rep_ < PROBE_D; ++rep_) {
#ifndef NO_D
            pg8::Gemm g{bufX, wl + E_W1, M, DFF, DM}; pg8::StaticOrder S; S.init(M, DFF, G, bx);
            fill_rs_table(rstab, ss2, pm_blk, 1.f, tid_now());
            EpiFF1 E{rstab, Fb};
            pg8::gemm_phase<EpiFF1, pg8::StaticOrder, true, true>(lds, g, S, E, wave);
#endif
        }
        SEAM(pb + 3, true);
        if (IN(pb + 4)) {
#ifndef NO_E
            pg8::Gemm g{Fb, wl + E_W2, M, DM, DFF}; pg8::StaticOrder S; S.init(M, DM, G, bx);
            EpiRes E{bufX, LO, ss3, 0, l == DEPTH - 1 ? 1 : 0};
            pg8::gemm_phase<EpiRes, pg8::StaticOrder, true, true>(lds, g, S, E, wave);
#endif
        }
        SEAM(pb + 4, true);
        if (IN(pb + 5)) {
            if (l + 1 < DEPTH) {
                const float* pl = p + (size_t)(l + 1) * M * PLE;
#pragma unroll 4
                for (int t_ = gw; t_ < M * PLE / 512; t_ += NGW) { const int it = ((t_ >> 8) & 7) * 1024 + (t_ >> 11) * 256 + (t_ & 255);
                    const size_t o = (size_t)it * 512 + lane * 8; const f32x4 u0 = *(const f32x4*)(pl + o), u1 = *(const f32x4*)(pl + o + 4);
                    v4u w; w.x = pk2(u0.x, u0.y); w.y = pk2(u0.z, u0.w); w.z = pk2(u1.x, u1.y); w.w = pk2(u1.z, u1.w); *(v4u*)(PBb + (size_t)(it >> 10) * SLAB_E + (o & (size_t)(SEQ * PLE - 1))) = w; }
            }
#ifndef NO_F
            pg8::Gemm g{bufX, wl + E_WG, M, DM, DM}; pg8::StaticOrder S; S.init(M, DM, G, bx);
            fill_rs_table(rstab, ss3, pm_blk, -1.4426950408889634f, tid_now());
            EpiGate E{rstab, bufX, LO, bufT, ss1n, l == DEPTH - 1 ? H : (float*)nullptr, l == DEPTH - 1 ? 1 : 0};
            pg8::gemm_phase<EpiGate, pg8::StaticOrder, true, true>(lds, g, S, E, wave);
#endif
        }
        SEAM(pb + 5, true);
    }
#undef IN
#undef SEAM
}

extern "C" void kernel_launch(void* const* d_in, const int* in_sizes, int n_in, void* d_out, int out_size, void* d_ws, size_t ws_size, hipStream_t stream) {
    static int grid = 0;
    if (grid == 0) {
        if (n_in != 17 || in_sizes[0] != M * DM || out_size != M * DM || ws_size < WS_TOTAL) { fprintf(stderr, "kernel_launch: unexpected shapes (n_in %d, in0 %d, out %d, ws %zu, need %zu)\n", n_in, n_in > 0 ? in_sizes[0] : -1, out_size, ws_size, (size_t)WS_TOTAL); grid = -1; return; }
        int dev = 0, cus = 0, per_cu = 0;
        hipGetDevice(&dev); hipDeviceGetAttribute(&cus, hipDeviceAttributeMultiprocessorCount, dev);
        if (hipFuncSetAttribute((const void*)mk_fwd, hipFuncAttributeMaxDynamicSharedMemorySize, LDS_BYTES) != hipSuccess) { fprintf(stderr, "kernel_launch: hipFuncSetAttribute failed\n"); grid = -1; return; }
        if (hipOccupancyMaxActiveBlocksPerMultiprocessor(&per_cu, (const void*)mk_fwd, NWAVES * 64, LDS_BYTES) != hipSuccess || per_cu < 1) { fprintf(stderr, "kernel_launch: occupancy query says %d\n", per_cu); per_cu = 1; }
        (void)hipGetLastError();
        grid = cus * 1;
        if (grid != 256) { fprintf(stderr, "kernel_launch: this kernel's per-batch-element workspace layout needs a 256-workgroup grid (256 CUs); found %d CUs\n", cus); grid = -1; return; }
    }
    if (grid < 0) return;
#ifdef DBG_MEMSET
    (void)hipMemsetAsync(d_ws, 0xAA, WS_END, stream); (void)hipMemsetAsync(d_out, 0xAA, (size_t)M * DM * 4, stream);
#endif
    if (hipMemsetAsync((char*)d_ws + WS_CTL, 0, CTL_BYTES, stream) != hipSuccess) { fprintf(stderr, "kernel_launch: memset of the barrier words failed\n"); return; }
    Args a{};
    for (int i = 0; i < 17; ++i) a.in[i] = (const float*)d_in[i];
    a.out = (float*)d_out; a.ws = (unsigned char*)d_ws;
#if MK_N_LAUNCHES == 1
    a.ph_lo = 0; a.ph_hi = NPHASE;
    void* args[] = {&a};
    hipError_t e = hipLaunchCooperativeKernel((const void*)mk_fwd, dim3(grid), dim3(NWAVES * 64), args, LDS_BYTES, stream);
    if (e != hipSuccess) fprintf(stderr, "cooperative launch failed: %s (grid %d)\n", hipGetErrorString(e), grid);
#else
    for (int ph = 0; ph < NPHASE; ++ph) { a.ph_lo = ph; a.ph_hi = ph + 1; hipLaunchKernelGGL(mk_fwd, dim3(grid), dim3(NWAVES * 64), LDS_BYTES, stream, a); }
#endif
}
```

```cpp
#include <hip/hip_runtime.h>
#include <hip/hip_cooperative_groups.h>
#include <cstdio>
#include <cstdint>
namespace cg = cooperative_groups;
namespace pg8 {
#define PG8_LAS __attribute__((address_space(3)))
typedef unsigned short bf16_t;
typedef short bf16x8 __attribute__((ext_vector_type(8)));
typedef float f32x4 __attribute__((ext_vector_type(4)));
typedef unsigned u32x4 __attribute__((ext_vector_type(4)));
constexpr int BM = 256, BK = 64, HALF = 128, HTB = HALF * BK * 2  , STAGE_BYTES = 8 * HTB, NXCD = 8, WGM = 8;

__host__ __device__ __forceinline__ int lds_byte(int r, int c) { const int st = (r >> 4) * 2 + (c >> 5), rr = r & 15, cc = c & 31, ob = rr * 64 + cc * 2; return st * 1024 + (ob ^ (((ob >> 9) & 1) << 5)); }
__host__ __device__ __forceinline__ void stage_rc(int b, int& R, int& C) { const int st = b / 1024, sb = b % 1024, swz = sb ^ (((sb >> 9) & 1) << 5); R = (st >> 1) * 16 + swz / 64; C = (st & 1) * 32 + (swz % 64) / 2; }
__host__ __device__ __forceinline__ int perm32(int rho) { const int n = rho >> 4, i = rho & 15; return 8 * (i >> 2) + 4 * n + (i & 3); }

struct Unit { int pm, pn; };
struct Gemm { const bf16_t* A; const bf16_t* Bt; int M, N, K; };

struct StaticOrder {
    int nM, nN, nwg, G, c;
    __host__ __device__ void init(int M, int N, int G_, int c_) { nM = M / BM; nN = N / BM; nwg = nM * nN; G = G_; c = c_; }
    __host__ __device__ bool next(int i, Unit& u) const {
        const long L = (long)i * G + c; if (L >= nwg) return false;
        int wgid = (int)L; { const int q = nwg / NXCD, r = nwg % NXCD, xcd = wgid % NXCD, off = wgid / NXCD; wgid = (xcd < r ? xcd * (q + 1) : r * (q + 1) + (xcd - r) * q) + off; }
        const int nig = WGM * nN, gid = wgid / nig, fm = gid * WGM, gsz = (nM - fm) < WGM ? (nM - fm) : WGM;
        u.pm = fm + ((wgid % nig) % gsz); u.pn = (wgid % nig) / gsz; return true;
    }
    __device__ __forceinline__ void a_ready(const Unit&) const {}
    __device__ __forceinline__ void done(const Unit&) const {}
};

__device__ __forceinline__ unsigned cvt_pk_bf16(float lo, float hi) { unsigned r; asm volatile("v_cvt_pk_bf16_f32 %0, %1, %2" : "=v"(r) : "v"(lo), "v"(hi)); return r; }
typedef float f32x2 __attribute__((ext_vector_type(2)));
__device__ __forceinline__ f32x2 gelu_pk(f32x2 v) {
    const f32x2 av = __builtin_elementwise_abs(v), d = av * 0.2316418882f + 1.0f;
    f32x2 t; t.x = __builtin_amdgcn_rcpf(d.x); t.y = __builtin_amdgcn_rcpf(d.y);
    f32x2 q = t * 0.5307027145f + (-0.7265760135f); q = q * t + 0.7107068705f; q = q * t + (-0.142248368f); q = q * t + 0.127414796f; q = q * t;
    const f32x2 s = (v * v) * (-0.72134752044f);
    f32x2 e; e.x = __builtin_amdgcn_exp2f(s.x); e.y = __builtin_amdgcn_exp2f(s.y);
    const f32x2 m = v * (q * e), r = v - m;
    f32x2 o; o.x = v.x < 0.f ? m.x : r.x; o.y = v.y < 0.f ? m.y : r.y; return o;
}

template <int ACT  > struct EpiBf16 {
    static constexpr bool PERM = true, AFTER_DRAIN = false; static_assert(ACT == 0 || ACT == 1, "EpiBf16: ACT is 0 (none) or 1 (gelu_pk)");
    bf16_t* O; int ldc; const float* bias; int split_cols; size_t split_stride; float scale0;
    __device__ __forceinline__ void operator()(const f32x4 (&acc)[2][2][4][2], const Unit& u, int wr, int wc, int fr, int fq) const {
        const int row0 = u.pm * BM + wr * 64 + fr; int colt = u.pn * BM; bf16_t* base = O;
        float sc = 1.f; if (split_cols) { const int t = colt / split_cols; base += (size_t)t * split_stride; colt -= t * split_cols; if (t == 0) sc = scale0; }
        const int col0 = colt + wc * 32 + 8 * fq, bcol0 = u.pn * BM + wc * 32 + 8 * fq;
        f32x4 bv[2][2];
#pragma unroll
        for (int bj = 0; bj < 2; ++bj)
#pragma unroll
            for (int n = 0; n < 2; ++n) bv[bj][n] = bias ? *(const f32x4*)(bias + bcol0 + bj * HALF + 4 * n) : (f32x4){0.f, 0.f, 0.f, 0.f};
#pragma unroll
        for (int ai = 0; ai < 2; ++ai)
#pragma unroll
            for (int m = 0; m < 4; ++m) { bf16_t* rowp = base + (size_t)(row0 + ai * HALF + m * 16) * ldc + col0;
#pragma unroll
                for (int bj = 0; bj < 2; ++bj) { f32x4 v0 = acc[ai][bj][m][0] + bv[bj][0], v1 = acc[ai][bj][m][1] + bv[bj][1];
                    if (ACT == 1) { f32x2 a = gelu_pk((f32x2){v0[0], v0[1]}), b = gelu_pk((f32x2){v0[2], v0[3]}), c = gelu_pk((f32x2){v1[0], v1[1]}), d = gelu_pk((f32x2){v1[2], v1[3]});
                        v0 = (f32x4){a.x, a.y, b.x, b.y}; v1 = (f32x4){c.x, c.y, d.x, d.y}; }
                    v0 = v0 * sc; v1 = v1 * sc; u32x4 w; w.x = cvt_pk_bf16(v0[0], v0[1]); w.y = cvt_pk_bf16(v0[2], v0[3]); w.z = cvt_pk_bf16(v1[0], v1[1]); w.w = cvt_pk_bf16(v1[2], v1[3]);
                    *(u32x4*)(rowp + bj * HALF) = w; } }
    }
};
template <class Epi, class Sched, bool ALIGN_EPI = false, bool SP2 = false>
__device__ __forceinline__ void gemm_phase(PG8_LAS unsigned char* lds, const Gemm g, const Sched& S, const Epi& E, const int wave_id  ) {
    int tid_ = wave_id * 64 + (int)__builtin_amdgcn_mbcnt_hi(~0u, __builtin_amdgcn_mbcnt_lo(~0u, 0u)); asm volatile("" : "+v"(tid_));
    const int tid = tid_, wid = __builtin_amdgcn_readfirstlane(tid >> 6), lane = tid & 63, wr = wid >> 2, wc = wid & 3, fr = lane & 15, fq = lane >> 4;
    const int K = g.K, nt = K / BK;
    unsigned voffA[2], voffB[2];
#pragma unroll
    for (int i = 0; i < 2; ++i) { int R, C; stage_rc(tid * 16 + i * 8192, R, C); const int Rb = Epi::PERM ? ((R & ~31) + perm32(R & 31)) : R;
        voffA[i] = (unsigned)(R * K + C) * 2u; voffB[i] = (unsigned)(Rb * K + C) * 2u; }
    const size_t kstep = (size_t)(BK * 2);
    const size_t hstep = (size_t)HALF * K * 2;
    const size_t tstep = 2 * hstep;
    const unsigned ldsw = (unsigned)wid * 1024u;
    const int aoff = lds_byte(wr * 64 + fr, fq * 8), boff = lds_byte(wc * 32 + fr, fq * 8);
#define PG8_SA(b, h) (((b) * 2 + (h)) * HTB)
#define PG8_SB(b, h) ((4 + (b) * 2 + (h)) * HTB)
#define PG8_STAGE(bufoff, gbase, voff) do { _Pragma("unroll") for (int _i = 0; _i < 2; ++_i) \
        __builtin_amdgcn_global_load_lds((const unsigned*)((const char*)(gbase) + (voff)[_i]), (PG8_LAS unsigned*)(lds + (bufoff) + ldsw + _i * 8192), 16, 0, 0); } while (0)
#define PG8_LDA(dst, b, h) do { _Pragma("unroll") for (int m = 0; m < 4; ++m) _Pragma("unroll") for (int k = 0; k < 2; ++k) dst[m][k] = *(const PG8_LAS bf16x8*)(lds + PG8_SA(b, h) + aoff + m * 2048 + k * 1024); } while (0)
#define PG8_LDB(dst, b, h) do { _Pragma("unroll") for (int n = 0; n < 2; ++n) _Pragma("unroll") for (int k = 0; k < 2; ++k) dst[n][k] = *(const PG8_LAS bf16x8*)(lds + PG8_SB(b, h) + boff + n * 2048 + k * 1024); } while (0)
#define PG8_MMA(ai, bj, At, Bt) do { __builtin_amdgcn_s_setprio(1); _Pragma("unroll") for (int m = 0; m < 4; ++m) _Pragma("unroll") for (int n = 0; n < 2; ++n) _Pragma("unroll") for (int k = 0; k < 2; ++k) \
        acc[ai][bj][m][n] = __builtin_amdgcn_mfma_f32_16x16x32_bf16(Bt[n][k], At[m][k], acc[ai][bj][m][n], 0, 0, 0); __builtin_amdgcn_s_setprio(0); } while (0)
#define PG8_WAIT_V(n) asm volatile("s_waitcnt vmcnt(" #n ")" ::: "memory")
#define PG8_WAIT_L(n) asm volatile("s_waitcnt lgkmcnt(" #n ")" ::: "memory")
#define PG8_BAR __builtin_amdgcn_s_barrier()
#define PG8_SCHED __builtin_amdgcn_sched_barrier(0)
    Unit cur, nxt; int ui = 0;
    if (!S.next(0, cur)) return;
    f32x4 acc[2][2][4][2];
#pragma unroll
    for (int a = 0; a < 2; ++a)
#pragma unroll
        for (int b = 0; b < 2; ++b)
#pragma unroll
            for (int m = 0; m < 4; ++m)
#pragma unroll
                for (int n = 0; n < 2; ++n) acc[a][b][m][n] = (f32x4){0.f, 0.f, 0.f, 0.f};
    bf16x8 At[4][2], B0[2][2], B1[2][2];
    const char* cA = (const char*)g.A + (size_t)cur.pm * tstep; const char* cB = (const char*)g.Bt + (size_t)cur.pn * tstep;
    S.a_ready(cur);
    if constexpr (SP2) {
        PG8_STAGE(PG8_SB(0, 0), cB, voffB); PG8_STAGE(PG8_SB(0, 1), cB + hstep, voffB); PG8_STAGE(PG8_SA(0, 0), cA, voffA); PG8_STAGE(PG8_SA(0, 1), cA + hstep, voffA);
        if (wr == 1) PG8_BAR;
        PG8_WAIT_V(2); PG8_BAR;
        PG8_STAGE(PG8_SB(1, 0), cB + kstep, voffB); PG8_STAGE(PG8_SA(1, 0), cA + kstep, voffA); PG8_STAGE(PG8_SB(1, 1), cB + hstep + kstep, voffB);
        PG8_WAIT_V(6); PG8_BAR;
    } else {
        PG8_STAGE(PG8_SB(0, 0), cB, voffB); PG8_STAGE(PG8_SA(0, 0), cA, voffA); PG8_STAGE(PG8_SB(0, 1), cB + hstep, voffB); PG8_STAGE(PG8_SA(0, 1), cA + hstep, voffA);
        if (wr == 1) PG8_BAR;
        PG8_WAIT_V(4); PG8_BAR;
        PG8_STAGE(PG8_SB(1, 0), cB + kstep, voffB); PG8_STAGE(PG8_SA(1, 0), cA + kstep, voffA); PG8_STAGE(PG8_SB(1, 1), cB + hstep + kstep, voffB);
        PG8_WAIT_V(6); PG8_BAR;
    }
    for (;;) {
        const bool has_next = S.next(ui + 1, nxt);
        const char* nA = has_next ? (const char*)g.A + (size_t)nxt.pm * tstep : cA; const char* nB = has_next ? (const char*)g.Bt + (size_t)nxt.pn * tstep : cB;
        for (int t = 0; t < nt; t += 2) {
            const bool last = (t == nt - 2);
            const char* a1 = cA + (size_t)(t + 1) * kstep;
            const char* a2 = last ? nA : cA + (size_t)(t + 2) * kstep; const char* b2 = last ? nB : cB + (size_t)(t + 2) * kstep;
            const char* a3 = a2 + kstep; const char* b3 = b2 + kstep;
            if (last && has_next) S.a_ready(nxt);
            if constexpr (SP2) {
            PG8_LDB(B0, 0, 0); PG8_LDB(B1, 0, 1); PG8_SCHED; PG8_LDA(At, 0, 0); PG8_STAGE(PG8_SA(1, 1), a1 + hstep, voffA);
            PG8_WAIT_V(8); PG8_WAIT_L(0); PG8_BAR; PG8_MMA(0, 0, At, B0); PG8_MMA(0, 1, At, B1); PG8_BAR; PG8_SCHED;
            PG8_LDA(At, 0, 1); PG8_STAGE(PG8_SB(0, 0), b2, voffB); PG8_STAGE(PG8_SB(0, 1), b2 + hstep, voffB); PG8_STAGE(PG8_SA(0, 0), a2, voffA);
            PG8_WAIT_V(8); PG8_WAIT_L(0); PG8_BAR; PG8_MMA(1, 0, At, B0); PG8_MMA(1, 1, At, B1); PG8_BAR; PG8_SCHED;
            PG8_LDB(B0, 1, 0); PG8_LDB(B1, 1, 1); PG8_SCHED; PG8_LDA(At, 1, 0); PG8_STAGE(PG8_SA(0, 1), a2 + hstep, voffA);
            PG8_WAIT_V(8); PG8_WAIT_L(0); PG8_BAR; PG8_MMA(0, 0, At, B0); PG8_MMA(0, 1, At, B1); PG8_BAR; PG8_SCHED;
            PG8_LDA(At, 1, 1); PG8_STAGE(PG8_SB(1, 0), b3, voffB); PG8_STAGE(PG8_SB(1, 1), b3 + hstep, voffB); PG8_STAGE(PG8_SA(1, 0), a3, voffA);
            PG8_WAIT_V(8); PG8_WAIT_L(0); PG8_BAR; PG8_MMA(1, 0, At, B0); PG8_MMA(1, 1, At, B1); PG8_BAR; PG8_SCHED;
            } else {
            PG8_LDB(B0, 0, 0); PG8_SCHED; PG8_LDA(At, 0, 0); PG8_STAGE(PG8_SA(1, 1), a1 + hstep, voffA);
            PG8_WAIT_L(8); PG8_BAR; PG8_WAIT_L(0); PG8_MMA(0, 0, At, B0); PG8_BAR; PG8_SCHED;
            PG8_LDB(B1, 0, 1); PG8_STAGE(PG8_SB(0, 0), b2, voffB);
            PG8_BAR; PG8_WAIT_L(0); PG8_MMA(0, 1, At, B1); PG8_BAR;
            PG8_LDA(At, 0, 1); PG8_STAGE(PG8_SA(0, 0), a2, voffA);
            PG8_BAR; PG8_WAIT_L(0); PG8_MMA(1, 0, At, B0); PG8_BAR; PG8_SCHED;
            PG8_STAGE(PG8_SB(0, 1), b2 + hstep, voffB);
            PG8_WAIT_V(6); PG8_BAR; PG8_MMA(1, 1, At, B1); PG8_BAR;
            PG8_LDB(B0, 1, 0); PG8_SCHED; PG8_LDA(At, 1, 0); PG8_STAGE(PG8_SA(0, 1), a2 + hstep, voffA);
            PG8_WAIT_L(8); PG8_BAR; PG8_WAIT_L(0); PG8_MMA(0, 0, At, B0); PG8_BAR; PG8_SCHED;
            PG8_LDB(B1, 1, 1); PG8_STAGE(PG8_SB(1, 0), b3, voffB);
            PG8_BAR; PG8_WAIT_L(0); PG8_MMA(0, 1, At, B1); PG8_BAR;
            PG8_LDA(At, 1, 1); PG8_STAGE(PG8_SA(1, 0), a3, voffA);
            PG8_BAR; PG8_WAIT_L(0); PG8_MMA(1, 0, At, B0); PG8_BAR; PG8_SCHED;
            PG8_STAGE(PG8_SB(1, 1), b3 + hstep, voffB);
            PG8_WAIT_V(6); PG8_BAR; PG8_MMA(1, 1, At, B1); PG8_BAR;
            }
        }
        if constexpr (ALIGN_EPI) { if (wr == 0) PG8_BAR; }
        if constexpr (!Epi::AFTER_DRAIN) { E(acc, cur, wr, wc, fr, fq); S.done(cur); }
        if (!has_next) break;
#pragma unroll
        for (int a = 0; a < 2; ++a)
#pragma unroll
            for (int b = 0; b < 2; ++b)
#pragma unroll
                for (int m = 0; m < 4; ++m)
#pragma unroll
                    for (int n = 0; n < 2; ++n) acc[a][b][m][n] = (f32x4){0.f, 0.f, 0.f, 0.f};
        cur = nxt; cA = nA; cB = nB; ++ui;
        if constexpr (ALIGN_EPI) { if (wr == 1) PG8_BAR; }
    }
    PG8_WAIT_V(0);
    if constexpr (!ALIGN_EPI) { if (wr == 0) PG8_BAR; }
    PG8_BAR;
    if constexpr (Epi::AFTER_DRAIN) { E.fused(acc, cur, wr, wc, fr, fq, lds, wid, lane); S.done(cur); }
#undef PG8_SA
#undef PG8_SB
#undef PG8_STAGE
#undef PG8_LDA
#undef PG8_LDB
#undef PG8_MMA
#undef PG8_WAIT_V
#undef PG8_WAIT_L
#undef PG8_BAR
#undef PG8_SCHED
}
}

#ifndef MK_N_LAUNCHES
#define MK_N_LAUNCHES 1
#endif
#ifndef ATT_EARLY_EXIT
#define ATT_EARLY_EXIT 1
#endif
constexpr int NWAVES = 8;
constexpr int M = 16384, DM = 1024, SEQ = 2048, DEPTH = 4, NIN = 2816, DFF = 4096, PLE = 256;
constexpr float EPS = 1e-6f;
constexpr float C2 = 0.125f * 1.4426950408889634f;
constexpr int NPHASE = 1 + 6 * DEPTH;
#ifndef GATE_LAQ
#define GATE_LAQ 2
#endif
#ifndef RES_LA
#define RES_LA 3
#endif
#ifndef PROBE_B
#define PROBE_B 1
#endif
#ifndef PROBE_ATT
#define PROBE_ATT 1
#endif
#ifndef PROBE_SYNC
#define PROBE_SYNC 1
#endif
#ifndef PROBE_P
#define PROBE_P 1
#endif
#ifndef PROBE_A
#define PROBE_A 1
#endif
#ifndef PROBE_D
#define PROBE_D 1
#endif

typedef unsigned short bf16;
#define LAS __attribute__((address_space(3)))
typedef unsigned v4u __attribute__((ext_vector_type(4)));
typedef unsigned v2u __attribute__((ext_vector_type(2)));
typedef float f32x4 __attribute__((ext_vector_type(4)));
typedef float f32x2 __attribute__((ext_vector_type(2)));
typedef float f32x16 __attribute__((ext_vector_type(16)));
typedef short bf16x8 __attribute__((ext_vector_type(8)));
typedef short s16x4 __attribute__((ext_vector_type(4)));
#define LDS_WAIT() asm volatile("s_waitcnt lgkmcnt(0)" ::: "memory")

constexpr size_t E_WIN = 0, E_WOUT = (size_t)NIN * DM, E_W1 = E_WOUT + (size_t)DM * DM, E_W2 = E_W1 + (size_t)DFF * DM, E_WG = E_W2 + (size_t)DFF * DM, E_WP = E_WG + (size_t)DM * DM,
                 E_WLAYER = E_WP + (size_t)PLE * DM;
constexpr size_t WS_W = 0, WS_WSB = WS_W + (size_t)DEPTH * E_WLAYER * 2, WS_SS = WS_WSB + (size_t)DEPTH * 4 * 128 * 128 * 2, WS_HB = WS_SS + (size_t)3 * M * 16 * 4,
                 WS_LO = WS_HB + (size_t)M * DM * 2, WS_XB = WS_LO + (size_t)M * DM * 2, WS_BIG = WS_XB + (size_t)M * DM * 2, WS_END = WS_BIG + (size_t)M * DFF * 2;
constexpr size_t SLAB_E = (size_t)SEQ * DFF, O_CONV = 0, O_Q = O_CONV + (size_t)3 * SEQ * 256, O_K = O_Q + (size_t)SEQ * 512, O_VT = O_K + (size_t)SEQ * 512, O_CU = O_VT + (size_t)SEQ * 512,
                 O_VNT = O_CU + (size_t)SEQ * 256, O_Y = O_VNT + (size_t)SEQ * 256, O_PB = O_Y + (size_t)SEQ * DM, O_END = O_PB + (size_t)SEQ * PLE;
static_assert(O_END <= SLAB_E, "a batch element's mixer tensors + its bf16 p rows fit under its F rows");
constexpr size_t WS_CTL = WS_END, CTL_BYTES = 32768, WS_TOTAL = WS_CTL + CTL_BYTES;
constexpr int RING_BYTES = 131072, RS_OFF = RING_BYTES + 64, LDS_BYTES = RS_OFF + 1024 + 960;

__device__ __forceinline__ unsigned f2bf(float f) { unsigned u = __builtin_bit_cast(unsigned, f); return (u + 0x7fffu + ((u >> 16) & 1u)) >> 16; }
typedef __bf16 bf16x2_t __attribute__((ext_vector_type(2)));
__device__ __forceinline__ unsigned pk2(float lo, float hi) { f32x2 v = {lo, hi}; bf16x2_t b = __builtin_convertvector(v, bf16x2_t); return __builtin_bit_cast(unsigned, b); }
__device__ __forceinline__ float bflo(unsigned u) { return __builtin_bit_cast(float, u << 16); }
__device__ __forceinline__ float bfhi(unsigned u) { return __builtin_bit_cast(float, u & 0xffff0000u); }
__device__ __forceinline__ float wave_sum(float v) {
#pragma unroll
    for (int o = 1; o < 64; o <<= 1) v += __shfl_xor(v, o);
    return v;
}

__device__ __forceinline__ float row_rs(const float* ssp, int r) {
    const f32x4* q = (const f32x4*)(ssp + (size_t)r * 16); const f32x4 a = q[0], b = q[1], c = q[2], d = q[3];
    const float s = ((a[0] + a[1]) + (a[2] + a[3])) + ((b[0] + b[1]) + (b[2] + b[3])) + ((c[0] + c[1]) + (c[2] + c[3])) + ((d[0] + d[1]) + (d[2] + d[3]));
    return rsqrtf(s * (1.f / 1024.f) + EPS);
}
__device__ __forceinline__ void fill_rs_table(LAS float* tab, const float* ssp, int pm, float mul, int tid) {
    asm volatile("" : "+v"(tid));
    if (tid < 256) tab[tid] = row_rs(ssp, pm * 256 + tid) * mul;
    asm volatile("s_waitcnt vmcnt(0) lgkmcnt(0)" ::: "memory"); __syncthreads();
}
struct EpiInProj {
    static constexpr bool PERM = true, AFTER_DRAIN = false;
    const LAS float* rst; bf16* conv; bf16* q; bf16* k; bf16* vt; bf16* cu; bf16* vnt; const float* qg; const float* kg; const float* sg;
    __device__ __forceinline__ void operator()(const pg8::f32x4 (&acc)[2][2][4][2], const pg8::Unit& u, int wr, int wc, int fr, int fq) const {
        const int sec = u.pn;
        const int row0 = u.pm * 256 + wr * 64 + fr;
        const int cw = 64 * wc + 8 * fq;
        const bool normed = (sec >= 3 && sec < 7) || sec == 10;
        float rsv[8];
#pragma unroll
        for (int g = 0; g < 8; ++g) { rsv[g] = rst[(g >> 2) * 128 + wr * 64 + (g & 3) * 16 + fr]; }
        f32x4 gv[2][2];
#pragma unroll
        for (int bj = 0; bj < 2; ++bj)
#pragma unroll
            for (int n = 0; n < 2; ++n) {
                if (sec >= 3 && sec < 7) { const float* g = sec < 5 ? qg : kg; const float sc = sec < 5 ? C2 : 1.f; gv[bj][n] = *(const f32x4*)(g + 32 * bj + 8 * fq + 4 * n) * sc; }
                else if (sec == 10) gv[bj][n] = *(const f32x4*)(sg + cw + 32 * bj + 4 * n);
                else gv[bj][n] = (f32x4){1.f, 1.f, 1.f, 1.f};
            }
#pragma unroll
        for (int ai = 0; ai < 2; ++ai)
#pragma unroll
            for (int m = 0; m < 4; ++m) {
                const int r = row0 + ai * 128 + m * 16;
                const float rs = rsv[ai * 4 + m];
                f32x4 v[2][2];
#pragma unroll
                for (int bj = 0; bj < 2; ++bj)
#pragma unroll
                    for (int n = 0; n < 2; ++n) v[bj][n] = acc[ai][bj][m][n] * rs;
                if (sec >= 9) {
#pragma unroll
                    for (int bj = 0; bj < 2; ++bj)
#pragma unroll
                        for (int n = 0; n < 2; ++n) { const pg8::f32x2 a = pg8::gelu_pk((pg8::f32x2){v[bj][n][0], v[bj][n][1]}), b = pg8::gelu_pk((pg8::f32x2){v[bj][n][2], v[bj][n][3]}); v[bj][n] = (f32x4){a.x, a.y, b.x, b.y}; }
                }
                if (normed) {
                    float s2 = 0.f;
#pragma unroll
                    for (int bj = 0; bj < 2; ++bj)
#pragma unroll
                        for (int n = 0; n < 2; ++n) { const f32x4 x = v[bj][n]; s2 += (x[0] * x[0] + x[1] * x[1]) + (x[2] * x[2] + x[3] * x[3]); }
                    s2 += __shfl_xor(s2, 16); s2 += __shfl_xor(s2, 32);
                    const float rn = rsqrtf(s2 * (1.f / 64.f) + EPS);
#pragma unroll
                    for (int bj = 0; bj < 2; ++bj)
#pragma unroll
                        for (int n = 0; n < 2; ++n) v[bj][n] = v[bj][n] * rn * gv[bj][n];
                }
                const int s = r & 2047; const size_t bo = (size_t)(r >> 11) * SLAB_E;
                if (sec == 10) {
                    const int sl = s & 127;
                    bf16* base = vnt + bo + ((((size_t)(wc * 16 + (s >> 7)) * 2) * 8 + (sl >> 4)) * 64 + ((sl >> 3) & 1) * 32 + 8 * fq) * 8 + (sl & 7);
#pragma unroll
                    for (int bj = 0; bj < 2; ++bj)
#pragma unroll
                        for (int n = 0; n < 2; ++n)
#pragma unroll
                            for (int j = 0; j < 4; ++j) base[(size_t)bj * 8 * 64 * 8 + (4 * n + j) * 8] = (bf16)f2bf(v[bj][n][j]);
                } else if (sec == 7 || sec == 8) {
                    const int kk_ = s & 31;
                    bf16* base = vt + bo + (((size_t)((4 * (sec - 7) + wc) * 64 + (s >> 5)) * 4 + (kk_ >> 4)) * 64 + ((kk_ >> 3) & 1) * 32 + 8 * fq) * 8 + (kk_ & 7);
#pragma unroll
                    for (int bj = 0; bj < 2; ++bj)
#pragma unroll
                        for (int n = 0; n < 2; ++n)
#pragma unroll
                            for (int j = 0; j < 4; ++j) base[(size_t)bj * 2 * 64 * 8 + (4 * n + j) * 8] = (bf16)f2bf(v[bj][n][j]);
                } else if (sec >= 3 && sec < 7) {
                    const bool isq = sec < 5;
                    const int sl = s & 31, pos = isq ? sl : ((sl & 0x13) | ((sl & 4) << 1) | ((sl & 8) >> 1));
                    bf16* base = (isq ? q : k) + bo + (((size_t)((4 * ((sec - 3) & 1) + wc) * 64 + (s >> 5)) * 4 + (fq >> 1)) * 64 + (fq & 1) * 32 + pos) * 8;
#pragma unroll
                    for (int bj = 0; bj < 2; ++bj) { v4u w; w.x = pk2(v[bj][0][0], v[bj][0][1]); w.y = pk2(v[bj][0][2], v[bj][0][3]); w.z = pk2(v[bj][1][0], v[bj][1][1]); w.w = pk2(v[bj][1][2], v[bj][1][3]);
                        *(v4u*)(base + (size_t)bj * 2 * 64 * 8) = w; }
                } else {
                    bf16* dst; int ld;
                    if (sec < 3) { dst = conv + bo + (size_t)sec * SEQ * 256 + cw; ld = 256; }
                    else { dst = cu + bo + cw; ld = 256; }
                    dst += (size_t)s * ld;
#pragma unroll
                    for (int bj = 0; bj < 2; ++bj) { v4u w; w.x = pk2(v[bj][0][0], v[bj][0][1]); w.y = pk2(v[bj][0][2], v[bj][0][3]); w.z = pk2(v[bj][1][0], v[bj][1][1]); w.w = pk2(v[bj][1][2], v[bj][1][3]);
                        *(v4u*)(dst + 32 * bj) = w; }
                }
            }
    }
};

__device__ __forceinline__ void unpk(const v4u w, f32x4& a, f32x4& b) { a = (f32x4){bflo(w.x), bfhi(w.x), bflo(w.y), bfhi(w.y)}; b = (f32x4){bflo(w.z), bfhi(w.z), bflo(w.w), bfhi(w.w)}; }
__device__ __forceinline__ void split_store(const f32x4 h0, const f32x4 h1, bf16* hi, bf16* lo) {
    v4u w; w.x = pk2(h0[0], h0[1]); w.y = pk2(h0[2], h0[3]); w.z = pk2(h1[0], h1[1]); w.w = pk2(h1[2], h1[3]); *(v4u*)hi = w;
    f32x4 a, b; unpk(w, a, b); const f32x4 d0 = h0 - a, d1 = h1 - b;
    v4u l; l.x = pk2(d0[0], d0[1]); l.y = pk2(d0[2], d0[3]); l.z = pk2(d1[0], d1[1]); l.w = pk2(d1[2], d1[3]); *(v4u*)lo = l;
}
struct EpiRes {
    static constexpr bool PERM = true, AFTER_DRAIN = false;
    bf16* hi; bf16* lo; float* ssout; int use_lo, write_lo;
    __device__ __forceinline__ void operator()(const pg8::f32x4 (&acc)[2][2][4][2], const pg8::Unit& u, int wr, int wc, int fr, int fq) const {
        const int row0 = u.pm * 256 + wr * 64 + fr, col0 = u.pn * 256 + wc * 32 + 8 * fq;
        constexpr int LA = RES_LA;
        v4u bq[8][4];
#pragma unroll
        for (int g = 0; g < LA; ++g) { const size_t off = (size_t)(row0 + (g >> 2) * 128 + (g & 3) * 16) * DM + col0;
#pragma unroll
            for (int bj = 0; bj < 2; ++bj) { bq[g][2 * bj] = *(const v4u*)(hi + off + bj * 128); bq[g][2 * bj + 1] = use_lo ? *(const v4u*)(lo + off + bj * 128) : (v4u){0u, 0u, 0u, 0u}; } }
#pragma unroll
        for (int g = 0; g < 8; ++g) {
            if (g + LA < 8) { const int gn = g + LA; const size_t off = (size_t)(row0 + (gn >> 2) * 128 + (gn & 3) * 16) * DM + col0;
#pragma unroll
                for (int bj = 0; bj < 2; ++bj) { bq[gn][2 * bj] = *(const v4u*)(hi + off + bj * 128); bq[gn][2 * bj + 1] = use_lo ? *(const v4u*)(lo + off + bj * 128) : (v4u){0u, 0u, 0u, 0u}; } }
            const int ai = g >> 2, m = g & 3;
            const int r = row0 + ai * 128 + m * 16; const size_t off = (size_t)r * DM + col0; float s2 = 0.f;
#pragma unroll
            for (int bj = 0; bj < 2; ++bj) {
                f32x4 a0, a1, l0, l1; unpk(bq[g][2 * bj], a0, a1); unpk(bq[g][2 * bj + 1], l0, l1);
                const f32x4 h0 = (a0 + l0) + acc[ai][bj][m][0], h1 = (a1 + l1) + acc[ai][bj][m][1];
                if (write_lo) split_store(h0, h1, hi + off + bj * 128, lo + off + bj * 128);
                else { v4u w; w.x = pk2(h0[0], h0[1]); w.y = pk2(h0[2], h0[3]); w.z = pk2(h1[0], h1[1]); w.w = pk2(h1[2], h1[3]); *(v4u*)(hi + off + bj * 128) = w; }
                s2 += (h0[0] * h0[0] + h0[1] * h0[1]) + (h0[2] * h0[2] + h0[3] * h0[3]) + (h1[0] * h1[0] + h1[1] * h1[1]) + (h1[2] * h1[2] + h1[3] * h1[3]);
            }
            s2 += __shfl_xor(s2, 16); s2 += __shfl_xor(s2, 32);
            if (fq == 0) ssout[(size_t)r * 16 + u.pn * 4 + wc] = s2;
            asm volatile("" ::: "memory");
        }
    }
};
struct EpiFF1 {
    static constexpr bool PERM = true, AFTER_DRAIN = false;
    const LAS float* rst; bf16* f;
    __device__ __forceinline__ void operator()(const pg8::f32x4 (&acc)[2][2][4][2], const pg8::Unit& u, int wr, int wc, int fr, int fq) const {
        const int row0 = u.pm * 256 + wr * 64 + fr, col0 = u.pn * 256 + wc * 32 + 8 * fq;
        float rsv[8];
#pragma unroll
        for (int g = 0; g < 8; ++g) { rsv[g] = rst[(g >> 2) * 128 + wr * 64 + (g & 3) * 16 + fr]; }
#pragma unroll
        for (int ai = 0; ai < 2; ++ai)
#pragma unroll
            for (int m = 0; m < 4; ++m) {
                const int r = row0 + ai * 128 + m * 16; const float rs = rsv[ai * 4 + m]; bf16* dst = f + (size_t)r * DFF + col0;
#pragma unroll
                for (int bj = 0; bj < 2; ++bj) {
                    f32x4 a = acc[ai][bj][m][0] * rs, b = acc[ai][bj][m][1] * rs;
#pragma unroll
                    for (int j = 0; j < 4; ++j) { a[j] = fmaxf(a[j], 0.f); a[j] *= a[j]; b[j] = fmaxf(b[j], 0.f); b[j] *= b[j]; }
                    v4u w; w.x = pk2(a[0], a[1]); w.y = pk2(a[2], a[3]); w.z = pk2(b[0], b[1]); w.w = pk2(b[2], b[3]); *(v4u*)(dst + bj * 128) = w;
                }
            }
    }
};
struct EpiT {
    static constexpr bool PERM = true, AFTER_DRAIN = false;
    bf16* t;
    __device__ __forceinline__ void operator()(const pg8::f32x4 (&acc)[2][2][4][2], const pg8::Unit& u, int wr, int wc, int fr, int fq) const {
        const int row0 = u.pm * 256 + wr * 64 + fr, col0 = u.pn * 256 + wc * 32 + 8 * fq;
#pragma unroll
        for (int ai = 0; ai < 2; ++ai)
#pragma unroll
            for (int m = 0; m < 4; ++m) {
                bf16* dst = t + (size_t)(row0 + ai * 128 + m * 16) * DM + col0;
#pragma unroll
                for (int bj = 0; bj < 2; ++bj) { const f32x4 a = acc[ai][bj][m][0], b = acc[ai][bj][m][1];
                    v4u w; w.x = pk2(a[0], a[1]); w.y = pk2(a[2], a[3]); w.z = pk2(b[0], b[1]); w.w = pk2(b[2], b[3]); *(v4u*)(dst + bj * 128) = w; }
            }
    }
};
struct EpiGate {
    static constexpr bool PERM = true, AFTER_DRAIN = false;
    const LAS float* rst; const bf16* hi; bf16* lo; bf16* tx; float* ssout; float* fout; int use_lo;
    __device__ __forceinline__ void operator()(const pg8::f32x4 (&acc)[2][2][4][2], const pg8::Unit& u, int wr, int wc, int fr, int fq) const {
        const int row0 = u.pm * 256 + wr * 64 + fr, col0 = u.pn * 256 + wc * 32 + 8 * fq;
        float rsv[8];
#pragma unroll
        for (int g = 0; g < 8; ++g) { rsv[g] = rst[(g >> 2) * 128 + wr * 64 + (g & 3) * 16 + fr]; }
        constexpr int LAQ = GATE_LAQ;
        v4u hq[16], lq[16], tq[16];
#pragma unroll
        for (int q = 0; q < LAQ; ++q) { const int gn = q >> 1, bn = q & 1; const size_t off = (size_t)(row0 + (gn >> 2) * 128 + (gn & 3) * 16) * DM + col0 + bn * 128;
            tq[q] = *(const v4u*)(tx + off); hq[q] = *(const v4u*)(hi + off); lq[q] = use_lo ? *(const v4u*)(lo + off) : (v4u){0u, 0u, 0u, 0u}; }
        float s2 = 0.f;
#pragma unroll
        for (int q = 0; q < 16; ++q) {
            if (q + LAQ < 16) { const int gn = (q + LAQ) >> 1, bn = (q + LAQ) & 1; const size_t off = (size_t)(row0 + (gn >> 2) * 128 + (gn & 3) * 16) * DM + col0 + bn * 128;
                tq[q + LAQ] = *(const v4u*)(tx + off); hq[q + LAQ] = *(const v4u*)(hi + off); lq[q + LAQ] = use_lo ? *(const v4u*)(lo + off) : (v4u){0u, 0u, 0u, 0u}; }
            const int g = q >> 1, bj = q & 1, ai = g >> 2, m = g & 3;
            const int r = row0 + ai * 128 + m * 16; const float rs = rsv[g]; const size_t off = (size_t)r * DM + col0 + bj * 128;
            f32x4 t0, t1, a0, a1, l0, l1; unpk(tq[q], t0, t1); unpk(hq[q], a0, a1); unpk(lq[q], l0, l1);
            f32x4 g0 = acc[ai][bj][m][0] * rs, g1 = acc[ai][bj][m][1] * rs;
#pragma unroll
            for (int j = 0; j < 4; ++j) { g0[j] = __builtin_amdgcn_rcpf(1.f + __builtin_amdgcn_exp2f(g0[j])); g1[j] = __builtin_amdgcn_rcpf(1.f + __builtin_amdgcn_exp2f(g1[j])); }
            const f32x4 h0 = (a0 + l0) + g0 * t0, h1 = (a1 + l1) + g1 * t1;
            if (!fout) { v4u w; w.x = pk2(h0[0], h0[1]); w.y = pk2(h0[2], h0[3]); w.z = pk2(h1[0], h1[1]); w.w = pk2(h1[2], h1[3]); *(v4u*)(tx + off) = w; }
            if (fout) { *(f32x4*)(fout + off) = h0; *(f32x4*)(fout + off + 4) = h1; }
            s2 += (h0[0] * h0[0] + h0[1] * h0[1]) + (h0[2] * h0[2] + h0[3] * h0[3]) + (h1[0] * h1[0] + h1[1] * h1[1]) + (h1[2] * h1[2] + h1[3] * h1[3]);
            if (bj == 1) {
                s2 += __shfl_xor(s2, 16); s2 += __shfl_xor(s2, 32);
                if (fq == 0 && !fout) ssout[(size_t)r * 16 + u.pn * 4 + wc] = s2;
                s2 = 0.f;
            }
            asm volatile("" ::: "memory");
        }
    }
};

struct TSched {
    int c, c0, G;
    __device__ __forceinline__ bool next(int i, pg8::Unit& u) const {
        if (c < c0) return false;
        if (G == 256 && c0 == 192) { if (i >= 4) return false; u.pm = 8 * (c & 7) + ((c - c0) >> 3); u.pn = i; return true; }
        const int un = (c - c0) + i * (G - c0); if (un >= 256) return false; u.pm = un >> 2; u.pn = un & 3; return true; }
    __device__ __forceinline__ void a_ready(const pg8::Unit&) const {}
    __device__ __forceinline__ void done(const pg8::Unit&) const {}
};
struct TrJob { const float* W; bf16* WT; const float* g; int K, N, item, hperm; };
__device__ __forceinline__ void tr_load(const TrJob& j, int lane, f32x4 (&v)[8]) {
    const int nblk = j.N / 32, kb = j.item / nblk, nb = j.item % nblk, k0 = 64 * kb, n0 = 32 * nb;
    const int kr = lane >> 3, nq = (lane & 7) * 4;
#pragma unroll
    for (int i = 0; i < 8; ++i) v[i] = *(const f32x4*)(j.W + (size_t)(k0 + 8 * i + kr) * j.N + n0 + nq);
    if (j.g) {
#pragma unroll
        for (int i = 0; i < 8; ++i) v[i] = v[i] * j.g[k0 + 8 * i + kr];
    }
}
__device__ __forceinline__ void tr_finish(const TrJob& j, int lane, const f32x4 (&v)[8], LAS float* scr) {
    const int nblk = j.N / 32, kb = j.item / nblk, nb = j.item % nblk, k0 = 64 * kb, n0 = 32 * nb;
    const int kr = lane >> 3, nq = (lane & 7) * 4;
#pragma unroll
    for (int i = 0; i < 8; ++i) { LAS float* d = scr + (8 * i + kr) * 33 + nq; d[0] = v[i][0]; d[1] = v[i][1]; d[2] = v[i][2]; d[3] = v[i][3]; }
    LDS_WAIT(); asm volatile("" ::: "memory");
    int d0 = n0; if (j.hperm) { const int gi = (n0 >> 5) & 7; d0 = (n0 & ~255) + 32 * (4 * (gi & 1) + (gi >> 1)); }
    const int c = lane & 7;
#pragma unroll
    for (int q = 0; q < 4; ++q) { const int n = (lane >> 3) + 8 * q; const LAS float* sp = scr + (8 * c) * 33 + n;
        v4u o; o.x = pk2(sp[0 * 33], sp[1 * 33]); o.y = pk2(sp[2 * 33], sp[3 * 33]); o.z = pk2(sp[4 * 33], sp[5 * 33]); o.w = pk2(sp[6 * 33], sp[7 * 33]);
        *(v4u*)(j.WT + (size_t)(d0 + n) * j.K + k0 + 8 * c) = o; }
    LDS_WAIT(); asm volatile("" ::: "memory");
}

__device__ __forceinline__ int crow(int r, int hf) { return (r & 3) + 8 * (r >> 2) + 4 * hf; }
__device__ __forceinline__ bool attn_tile(const bf16x8 (&kf)[4], const bf16x8 (&vf)[4], const bf16x8 (&qr)[4], f32x16& o0, f32x16& o1, float& carry, bool diag, int t, int hf) {
    f32x16 z;
#pragma unroll
    for (int r = 0; r < 16; ++r) z[r] = 0.f;
#pragma unroll
    for (int kk = 0; kk < 4; ++kk) z = __builtin_amdgcn_mfma_f32_32x32x16_bf16(kf[kk], qr[kk], z, 0, 0, 0);
    float e[16], w[16];
#pragma unroll
    for (int r = 0; r < 16; ++r) {
        float ev = __builtin_amdgcn_exp2f(__builtin_amdgcn_fmed3f(z[r], -3.0e38f, 31.f));
        if (diag) { const bool valid = (16 * (r >> 3) + 8 * hf + (r & 7)) < t; ev = valid ? ev : 0.f; }
        e[r] = ev;
    }
    float R[2], fb[2], ia_[2];
#pragma unroll
    for (int ks = 0; ks < 2; ++ks) {
        const int a = 8 * ks, b = 8 * ks + 4;
        const float da0 = 1.f + e[a], da1 = 1.f + e[a + 1], da2 = 1.f + e[a + 2], da3 = 1.f + e[a + 3];
        const float db0 = 1.f + e[b], db1 = 1.f + e[b + 1], db2 = 1.f + e[b + 2], db3 = 1.f + e[b + 3];
        const float pa2 = da0 * da1, pa3 = pa2 * da2, Pa = pa3 * da3;
        const float pb2 = db0 * db1, pb3 = pb2 * db2, Pb = pb3 * db3;
        const float ia = __builtin_amdgcn_rcpf(Pa), ib = __builtin_amdgcn_rcpf(Pb);
        w[a] = e[a]; w[a + 1] = e[a + 1] * da0; w[a + 2] = e[a + 2] * pa2; w[a + 3] = e[a + 3] * pa3;
        w[b] = e[b]; w[b + 1] = e[b + 1] * db0; w[b + 2] = e[b + 2] * pb2; w[b + 3] = e[b + 3] * pb3;
        ia_[ks] = ia; fb[ks] = ib; R[ks] = ia * ib;
        __builtin_amdgcn_sched_barrier(0);
    }
    const float Rp0 = __shfl_xor(R[0], 32), Rp1 = __shfl_xor(R[1], 32);
    const float T1 = R[1] * Rp1, T0 = R[0] * Rp0;
    const float L1 = hf ? carry : carry * Rp1;
    const float c0 = carry * T1, L0 = hf ? c0 : c0 * Rp0;
    carry = c0 * T0;
    { const float f0b = fb[0] * L0, f0a = ia_[0] * f0b, f1b = fb[1] * L1, f1a = ia_[1] * f1b;
#pragma unroll
      for (int jj = 0; jj < 4; ++jj) { w[jj] *= f0a; w[4 + jj] *= f0b; w[8 + jj] *= f1a; w[12 + jj] *= f1b; } }
#pragma unroll
    for (int ks = 0; ks < 2; ++ks) {
        v4u pw; pw.x = pk2(w[8 * ks], w[8 * ks + 1]); pw.y = pk2(w[8 * ks + 2], w[8 * ks + 3]); pw.z = pk2(w[8 * ks + 4], w[8 * ks + 5]); pw.w = pk2(w[8 * ks + 6], w[8 * ks + 7]);
        const bf16x8 pf = __builtin_bit_cast(bf16x8, pw);
        o0 = __builtin_amdgcn_mfma_f32_32x32x16_bf16(vf[ks], pf, o0, 0, 0, 0);
        o1 = __builtin_amdgcn_mfma_f32_32x32x16_bf16(vf[2 + ks], pf, o1, 0, 0, 0);
    }
#if ATT_EARLY_EXIT
    return __all(carry == 0.f);
#else
    return false;
#endif
}
#define ATT_LOAD(KD, VD, TJ) do { const size_t o_ = (size_t)(TJ) * 2048; _Pragma("unroll") for (int i_ = 0; i_ < 4; ++i_) { KD[i_] = *(const bf16x8*)(kbase + o_ + i_ * 512); VD[i_] = *(const bf16x8*)(vbase + o_ + i_ * 512); } \
        __builtin_amdgcn_sched_barrier(0); } while (0)
__device__ __forceinline__ void attn_task(const bf16* Q, const bf16* K, const bf16* VT, bf16* Y, int b, int h, int qb, int lane) {
    const int t = lane & 31, hf = lane >> 5, q0 = qb * 32;
    const size_t hb = (size_t)(b * 8 + h) * 64;
    const bf16* qp = Q + ((hb + qb) * 4 * 64 + lane) * 8;
    bf16x8 qr[4];
#pragma unroll
    for (int kk = 0; kk < 4; ++kk) qr[kk] = *(const bf16x8*)(qp + kk * 512);
    const bf16* kbase = K + (hb * 4 * 64 + lane) * 8;
    const bf16* vbase = VT + (hb * 4 * 64 + lane) * 8;
    f32x16 o0, o1;
#pragma unroll
    for (int r = 0; r < 16; ++r) { o0[r] = 0.f; o1[r] = 0.f; }
    float carry = 1.f;
    bf16x8 ka[4], va[4], kb[4], vb[4];
    ATT_LOAD(ka, va, qb);
    ATT_LOAD(kb, vb, qb > 0 ? qb - 1 : 0);
    __builtin_amdgcn_s_waitcnt(0x0F78);
    bool done = attn_tile(ka, va, qr, o0, o1, carry, true, t, hf);
    int j = qb - 1;
    while (!done && j >= 0) {
        __builtin_amdgcn_s_waitcnt(0x0F70);
        ATT_LOAD(ka, va, j > 0 ? j - 1 : 0);
        done = attn_tile(kb, vb, qr, o0, o1, carry, false, t, hf); --j;
        if (done || j < 0) break;
        ATT_LOAD(kb, vb, j > 0 ? j - 1 : 0);
        __builtin_amdgcn_s_waitcnt(0x0F78);
        done = attn_tile(ka, va, qr, o0, o1, carry, false, t, hf); --j;
    }
    bf16* yp = Y + (size_t)(b * SEQ + q0 + t) * DM + 256 + h * 64 + 4 * hf;
#pragma unroll
    for (int g = 0; g < 4; ++g) {
        v2u a; a.x = pk2(o0[4 * g], o0[4 * g + 1]); a.y = pk2(o0[4 * g + 2], o0[4 * g + 3]); *(v2u*)(yp + 8 * g) = a;
        v2u c; c.x = pk2(o1[4 * g], o1[4 * g + 1]); c.y = pk2(o1[4 * g + 2], o1[4 * g + 3]); *(v2u*)(yp + 32 + 8 * g) = c;
    }
}
__device__ __forceinline__ void sgu_task(const bf16* VNT, const bf16* WSB, const bf16* CU, const float* bias, bf16* Y, int task, int lane) {
    const int tb = task & 3, g = (task >> 2) & 3, c = (task >> 4) & 15, b = task >> 8;
    const int t = lane & 31, hf = lane >> 5;
    const bf16* ap = VNT + ((size_t)((b * 4 + g) * 16 + c) * 2 * 8 * 64 + lane) * 8;
    const bf16* bp = WSB + ((size_t)(g * 4 + tb) * 8 * 64 + lane) * 8;
    f32x16 a0, a1;
#pragma unroll
    for (int r = 0; r < 16; ++r) { a0[r] = 0.f; a1[r] = 0.f; }
    bf16x8 bfr[8], af0[8], af1[8];
#pragma unroll
    for (int ks = 0; ks < 8; ++ks) { bfr[ks] = *(const bf16x8*)(bp + 512 * ks); af0[ks] = *(const bf16x8*)(ap + 512 * ks); af1[ks] = *(const bf16x8*)(ap + 4096 + 512 * ks); }
#pragma unroll
    for (int ks = 0; ks < 8; ++ks) {
        a0 = __builtin_amdgcn_mfma_f32_32x32x16_bf16(af0[ks], bfr[ks], a0, 0, 0, 0);
        a1 = __builtin_amdgcn_mfma_f32_32x32x16_bf16(af1[ks], bfr[ks], a1, 0, 0, 0);
    }
    const int tok = b * SEQ + 128 * c + 32 * tb + t;
    const float bs = bias[g * 128 + 32 * tb + t];
    const bf16* up = CU + (size_t)tok * 256 + 64 * g + 4 * hf;
    bf16* yp = Y + (size_t)tok * DM + 768 + 64 * g + 4 * hf;
#pragma unroll
    for (int gg = 0; gg < 4; ++gg) {
        const v2u u0 = *(const v2u*)(up + 8 * gg), u1 = *(const v2u*)(up + 32 + 8 * gg);
        v2u a; a.x = pk2(bflo(u0.x) * (a0[4 * gg] + bs), bfhi(u0.x) * (a0[4 * gg + 1] + bs)); a.y = pk2(bflo(u0.y) * (a0[4 * gg + 2] + bs), bfhi(u0.y) * (a0[4 * gg + 3] + bs)); *(v2u*)(yp + 8 * gg) = a;
        v2u d; d.x = pk2(bflo(u1.x) * (a1[4 * gg] + bs), bfhi(u1.x) * (a1[4 * gg + 1] + bs)); d.y = pk2(bflo(u1.y) * (a1[4 * gg + 2] + bs), bfhi(u1.y) * (a1[4 * gg + 3] + bs)); *(v2u*)(yp + 32 + 8 * gg) = d;
    }
}
__device__ __forceinline__ void unpack8(const v4u w, float (&f)[8]) { f[0] = bflo(w.x); f[1] = bfhi(w.x); f[2] = bflo(w.y); f[3] = bfhi(w.y); f[4] = bflo(w.z); f[5] = bfhi(w.z); f[6] = bflo(w.w); f[7] = bfhi(w.w); }
__device__ __forceinline__ void conv_task(const bf16* CONV, const float* cwt, bf16* Y, int task, int lane) {
    const int ch = (lane & 31) * 8;
    float w0[8], w1[8], w2[8];
#pragma unroll
    for (int e = 0; e < 8; ++e) { w0[e] = cwt[ch + e]; w1[e] = cwt[256 + ch + e]; w2[e] = cwt[512 + ch + e]; }
    const bf16* ab = CONV; const bf16* ac = CONV + (size_t)SEQ * 256; const bf16* ah = CONV + (size_t)2 * SEQ * 256;
#pragma unroll
    for (int it = 0; it < 4; ++it) {
        const int tok = task * 8 + it * 2 + (lane >> 5), s = tok & (SEQ - 1);
        const size_t o = (size_t)tok * 256 + ch;
        float fb[8], c0[8], h0[8], c1[8], h1[8], c2[8], h2[8];
        unpack8(*(const v4u*)(ab + o), fb); unpack8(*(const v4u*)(ac + o), c0); unpack8(*(const v4u*)(ah + o), h0);
        const v4u zz = (v4u){0u, 0u, 0u, 0u};
        unpack8(s >= 1 ? *(const v4u*)(ac + o - 256) : zz, c1); unpack8(s >= 1 ? *(const v4u*)(ah + o - 256) : zz, h1);
        unpack8(s >= 2 ? *(const v4u*)(ac + o - 512) : zz, c2); unpack8(s >= 2 ? *(const v4u*)(ah + o - 512) : zz, h2);
        float y[8];
#pragma unroll
        for (int e = 0; e < 8; ++e) y[e] = fb[e] * (w2[e] * (c0[e] * h0[e]) + w1[e] * (c1[e] * h1[e]) + w0[e] * (c2[e] * h2[e]));
        v4u w; w.x = pk2(y[0], y[1]); w.y = pk2(y[2], y[3]); w.z = pk2(y[4], y[5]); w.w = pk2(y[6], y[7]);
        *(v4u*)(Y + (size_t)tok * DM + ch) = w;
    }
}

#define RLX_AGENT __ATOMIC_RELAXED, __HIP_MEMORY_SCOPE_AGENT
#define XB_TMO      128
#define XB_XCNT(j)  (256  + 64 * (j))
#define XB_XSUB(j)  (1280 + 64 * (j))
#define XB_XGEN(j)  (2304 + 64 * (j))
#define XB_TOP      3328
#define XB_TOPGEN   3392
#define XCD_BAR_WORDS 3456
#define XB_SPIN_CAP (1u << 18)

__device__ __forceinline__ unsigned xb_ld(unsigned* p)              { return __hip_atomic_load(p, __ATOMIC_RELAXED, __HIP_MEMORY_SCOPE_AGENT); }
__device__ __forceinline__ unsigned xb_add(unsigned* p, unsigned v) { return __hip_atomic_fetch_add(p, v, __ATOMIC_RELAXED, __HIP_MEMORY_SCOPE_AGENT); }
__device__ __forceinline__ unsigned xb_xcc_id() { return (unsigned)__builtin_amdgcn_s_getreg((3 << 11) | 20) & 0xFu; }
#define XB_SPIN(cond, bar) do { unsigned _sp = 0; while (cond) { __builtin_amdgcn_s_sleep(1); \
    if ((++_sp & 255u) == 0u) { if (xb_ld(&(bar)[XB_TMO])) break; if (_sp > XB_SPIN_CAP) { atomicAdd(&(bar)[XB_TMO], 1u); break; } } } } while (0)

struct XcdBarrier {
    int wave;
    unsigned* bar; unsigned x;
    volatile LAS unsigned* st;
};

__device__ __forceinline__ XcdBarrier xcd_barrier_post(unsigned* bar, volatile LAS unsigned* st) {
    XcdBarrier b; b.bar = bar; b.x = xb_xcc_id(); b.st = st;
    if (threadIdx.x == 0) (void)xb_add(&bar[XB_XCNT(b.x)], 1u);
    return b;
}
__device__ __forceinline__ void xcd_barrier_complete(unsigned* bar, unsigned x, unsigned& nloc, unsigned& nx) {
    const unsigned G = gridDim.x * gridDim.y * gridDim.z;
    unsigned sum, cnt, mine, sp = 0u;
    for (;;) {
        sum = 0u; cnt = 0u; mine = 0u;
#pragma unroll
        for (unsigned j = 0; j < 16; ++j) { const unsigned c = xb_ld(&bar[XB_XCNT(j)]); sum += c; cnt += (c > 0u) ? 1u : 0u; mine = (j == x) ? c : mine; }
        if (sum == G) break;
        __builtin_amdgcn_s_sleep(1);
        if ((++sp & 255u) == 0u) { if (xb_ld(&bar[XB_TMO])) break; if (sp > XB_SPIN_CAP) { atomicAdd(&bar[XB_TMO], 1u); break; } }
    }
    nloc = mine > 0u ? mine : 1u; nx = cnt > 0u ? cnt : 1u;
}

__device__ __forceinline__ void xcd_barrier(const XcdBarrier& b, bool local_seam) {
    asm volatile("s_waitcnt vmcnt(0)" ::: "memory");
    __syncthreads();
    if (b.wave == 0 && __builtin_amdgcn_mbcnt_hi(~0u, __builtin_amdgcn_mbcnt_lo(~0u, 0u)) == 0u) {
        unsigned* bar = b.bar;
        __builtin_amdgcn_s_waitcnt(0);
        unsigned nloc = b.st[0], nx = b.st[1];
        if (nloc == 0u) { xcd_barrier_complete(bar, b.x, nloc, nx); b.st[0] = nloc; b.st[1] = nx; }
        const unsigned old = xb_add(&bar[XB_XSUB(b.x)], 1u);
        const unsigned gen = old / nloc;
        const bool local = local_seam && (b.st[2] != 0u);
        if (old + 1u == (gen + 1u) * nloc) {
            if (!local) {
            __builtin_amdgcn_fence(__ATOMIC_RELEASE, "agent");
            asm volatile("s_waitcnt vmcnt(0)" ::: "memory");
            const unsigned og = xb_add(&bar[XB_TOP], 1u);
            const unsigned tg = og / nx;
            if (og + 1u == (tg + 1u) * nx) xb_add(&bar[XB_TOPGEN], 1u);
            else XB_SPIN(xb_ld(&bar[XB_TOPGEN]) == tg, bar);
            }
            __builtin_amdgcn_fence(__ATOMIC_ACQUIRE, "agent");
            xb_add(&bar[XB_XGEN(b.x)], 1u);
            asm volatile("s_waitcnt vmcnt(0)" ::: "memory");
        } else {
            XB_SPIN(xb_ld(&bar[XB_XGEN(b.x)]) == gen, bar);
            __builtin_amdgcn_fence(__ATOMIC_ACQUIRE, "agent");
            asm volatile("s_waitcnt vmcnt(0)" ::: "memory");
        }
    }
    __syncthreads();
}

struct Args { const float* in[17]; float* out; unsigned char* ws; int ph_lo, ph_hi; };
__global__ void __launch_bounds__(NWAVES * 64, 2) mk_fwd(Args a) {
    extern __shared__ __attribute__((aligned(16))) unsigned char lds_raw[];
    LAS unsigned char* lds = (LAS unsigned char*)lds_raw;
    const int tid = threadIdx.x, lane = tid & 63, wave = __builtin_amdgcn_readfirstlane(tid >> 6);
    const int G = gridDim.x; const int bx = blockIdx.x; const int vcu = (G % 8 == 0) ? (bx % 8) * (G / 8) + bx / 8 : bx;
    const int gw = vcu * NWAVES + wave, NGW = G * NWAVES;
    const int lo = a.ph_lo, hi = a.ph_hi;
    volatile LAS unsigned* bst = (volatile LAS unsigned*)(lds + RING_BYTES);
    if (tid < 4) bst[tid] = 0u;
    __syncthreads();
    XcdBarrier bar = xcd_barrier_post((unsigned*)(a.ws + WS_CTL), bst);
    bar.wave = wave;
    unsigned* xcctab = (unsigned*)(a.ws + WS_CTL) + XCD_BAR_WORDS;
    if (tid == 0) __hip_atomic_store(xcctab + bx, bar.x + 1u, __ATOMIC_RELAXED, __HIP_MEMORY_SCOPE_AGENT);
    unsigned char* ws = a.ws;
    const float* x = a.in[0]; const float* p = a.in[1];
    bf16* Wb = (bf16*)(ws + WS_W); bf16* WSBb = (bf16*)(ws + WS_WSB); float* SS = (float*)(ws + WS_SS);
    bf16* HB = (bf16*)(ws + WS_HB); bf16* LO = (bf16*)(ws + WS_LO); bf16* XB = (bf16*)(ws + WS_XB);
    unsigned char* big = ws + WS_BIG;
    bf16* BG = (bf16*)big;
    bf16* CONV = BG + O_CONV; bf16* Qb = BG + O_Q; bf16* Kb = BG + O_K; bf16* VTb = BG + O_VT; bf16* CUb = BG + O_CU; bf16* VNTb = BG + O_VNT; bf16* Yb = BG + O_Y; bf16* PBb = BG + O_PB; bf16* Fb = BG;
    LAS float* rstab = (LAS float*)(lds + RS_OFF);
    const int pm_blk = 8 * (bx & 7) + ((bx >> 3) & 7);
#define tid_now() (wave * 64 + (int)__builtin_amdgcn_mbcnt_hi(~0u, __builtin_amdgcn_mbcnt_lo(~0u, 0u)))
    const size_t bo_blk = (size_t)(bx & 7) * SLAB_E;
    float* H = a.out;
#define IN(k) (lo <= (k) && (k) < hi)
#define SEAM(k, loc) do { if (IN(k) && IN((k) + 1)) { if (a.ph_lo < 0) cg::this_grid().sync(); for (int sr_ = 0; sr_ < PROBE_SYNC; ++sr_) xcd_barrier(bar, loc); } } while (0)

    if (IN(0)) for (int rep_ = 0; rep_ < PROBE_P; ++rep_) {
        LAS float* scr = (LAS float*)(lds + wave * 16384);
        constexpr int I_IN = (DM / 64) * (NIN / 32), I_OUT = (DM / 64) * (DM / 32), I_1 = (DM / 64) * (DFF / 32), I_2 = (DFF / 64) * (DM / 32), I_G = I_OUT, I_P = (PLE / 64) * (DM / 32);
        constexpr int I_LAYER = I_IN + I_OUT + I_1 + I_2 + I_G + I_P;
#define TR_DECODE(J, IT) do { const int l_ = (IT) / I_LAYER; int r_ = (IT) % I_LAYER; bf16* wl_ = Wb + (size_t)l_ * E_WLAYER; \
            if (r_ < I_IN) { J = TrJob{a.in[3] + (size_t)l_ * DM * NIN, wl_ + E_WIN, a.in[2] + l_ * DM, DM, NIN, r_, 1}; } \
            else if ((r_ -= I_IN) < I_OUT) { J = TrJob{a.in[10] + (size_t)l_ * DM * DM, wl_ + E_WOUT, nullptr, DM, DM, r_, 0}; } \
            else if ((r_ -= I_OUT) < I_1) { J = TrJob{a.in[12] + (size_t)l_ * DM * DFF, wl_ + E_W1, a.in[11] + l_ * DM, DM, DFF, r_, 0}; } \
            else if ((r_ -= I_1) < I_2) { J = TrJob{a.in[13] + (size_t)l_ * DFF * DM, wl_ + E_W2, nullptr, DFF, DM, r_, 0}; } \
            else if ((r_ -= I_2) < I_G) { J = TrJob{a.in[15] + (size_t)l_ * DM * DM, wl_ + E_WG, a.in[14] + l_ * DM, DM, DM, r_, 0}; } \
            else { r_ -= I_G; J = TrJob{a.in[16] + (size_t)l_ * PLE * DM, wl_ + E_WP, nullptr, PLE, DM, r_, 0}; } } while (0)
        for (int it = gw; it < DEPTH * I_LAYER; it += 2 * NGW) {
            const int it2 = it + NGW; const bool has2 = it2 < DEPTH * I_LAYER;
            TrJob j1, j2; f32x4 v1[8], v2[8];
            TR_DECODE(j1, it); tr_load(j1, lane, v1);
            if (has2) { TR_DECODE(j2, it2); tr_load(j2, lane, v2); }
            tr_finish(j1, lane, v1, scr);
            if (has2) tr_finish(j2, lane, v2, scr);
        }
#undef TR_DECODE
        for (int i = gw * 64 + lane; i < DEPTH * 4 * 128 * 128; i += NGW * 64) {
            const int e8 = i & 7, ln = (i >> 3) & 63, ks = (i >> 9) & 7, tb = (i >> 12) & 3, lg = i >> 14; const int t = 32 * tb + (ln & 31), sk = 16 * ks + 8 * (ln >> 5) + e8;
            WSBb[i] = (bf16)f2bf(sk <= t ? a.in[8][((size_t)lg * 128 + t) * 128 + sk] : 0.f); }
        for (int m0 = gw; m0 < M; m0 += 2 * NGW) {
            f32x4 v[2][4]; float sq[2];
#pragma unroll
            for (int q = 0; q < 2; ++q) { const int m = m0 + q * NGW; sq[q] = 0.f; if (m < M) { const f32x4* xr = (const f32x4*)(x + (size_t)m * DM) + lane;
#pragma unroll
                for (int j = 0; j < 4; ++j) v[q][j] = xr[64 * j]; } }
#pragma unroll
            for (int q = 0; q < 2; ++q) { const int m = m0 + q * NGW; if (m < M) {
                float sacc = 0.f;
#pragma unroll
                for (int j = 0; j < 4; ++j) sacc += (v[q][j].x * v[q][j].x + v[q][j].y * v[q][j].y) + (v[q][j].z * v[q][j].z + v[q][j].w * v[q][j].w);
                sq[q] = wave_sum(sacc);
                v2u* o8 = (v2u*)(XB + (size_t)m * DM) + lane; v2u* l8 = (v2u*)(LO + (size_t)m * DM) + lane;
#pragma unroll
                for (int j = 0; j < 4; ++j) { v2u w; w.x = pk2(v[q][j].x, v[q][j].y); w.y = pk2(v[q][j].z, v[q][j].w); o8[64 * j] = w;
                    v2u d; d.x = pk2(v[q][j].x - bflo(w.x), v[q][j].y - bfhi(w.x)); d.y = pk2(v[q][j].z - bflo(w.y), v[q][j].w - bfhi(w.y)); l8[64 * j] = d; }
                if (lane < 16) SS[(size_t)m * 16 + lane] = lane == 0 ? sq[q] : 0.f; } }
        }
        for (int it = gw; it < M * PLE / 512; it += NGW) { const size_t o = (size_t)it * 512 + lane * 8; const f32x4 u0 = *(const f32x4*)(p + o), u1 = *(const f32x4*)(p + o + 4);
            v4u w; w.x = pk2(u0.x, u0.y); w.y = pk2(u0.z, u0.w); w.z = pk2(u1.x, u1.y); w.w = pk2(u1.z, u1.w); *(v4u*)(PBb + (size_t)(it >> 10) * SLAB_E + (o & (size_t)(SEQ * PLE - 1))) = w; }
        asm volatile("s_waitcnt vmcnt(0) lgkmcnt(0)" ::: "memory"); __syncthreads();
    }
    SEAM(0, false);
    if (lo == 0 && hi == NPHASE) {
        if (wave == 0) {
            bool ok = (G == 256);
            for (int i = lane; i < G; i += 64) { const unsigned me = __hip_atomic_load(xcctab + i, __ATOMIC_RELAXED, __HIP_MEMORY_SCOPE_AGENT), first = __hip_atomic_load(xcctab + (i & 7), __ATOMIC_RELAXED, __HIP_MEMORY_SCOPE_AGENT);
                ok = ok && (me != 0u) && (me == first); }
            const bool all_ok = __all(ok);
            if (lane == 0) bst[2] = all_ok ? 1u : 0u;
        }
        __syncthreads();
#ifdef PROBE_FAST
        if (bst[2] == 0u) { if (tid == 0) { const unsigned long long t0 = __builtin_amdgcn_s_memrealtime(); while (__builtin_amdgcn_s_memrealtime() - t0 < 40000ull) __builtin_amdgcn_s_sleep(8); } __syncthreads(); }
#endif
    }

    for (int l = 0; l < DEPTH; ++l) {
        const int pb = 1 + 6 * l;
        const bf16* wl = Wb + (size_t)l * E_WLAYER;
        bf16* bufX = (l & 1) ? HB : XB; bf16* bufT = (l & 1) ? XB : HB;
        float* ss1 = SS; float* ss2 = SS + (size_t)M * 16; float* ss3 = SS + (size_t)2 * M * 16; float* ss1n = ss1;
        if (IN(pb)) for (int rep_ = 0; rep_ < PROBE_A; ++rep_) {
#ifndef NO_A
            { pg8::Gemm g{bufX, wl + E_WIN, M, NIN, DM}; pg8::StaticOrder S; S.init(M, NIN, G, bx);
              fill_rs_table(rstab, ss1, pm_blk, 1.f, tid_now());
              EpiInProj E{rstab, CONV, Qb, Kb, VTb, CUb, VNTb, a.in[5] + l * 64, a.in[6] + l * 64, a.in[7] + l * 256};
              pg8::gemm_phase<EpiInProj, pg8::StaticOrder, true, true>(lds, g, S, E, wave); }
            { int kp = PLE; asm volatile("" : "+s"(kp)); pg8::Gemm g{PBb + bo_blk - (size_t)(8 * (bx & 7)) * 256 * PLE, wl + E_WP, M, DM, kp};     TSched S{bx, (M / 256 * (NIN / 256)) % G, G};
              EpiT E{bufT};
              pg8::gemm_phase<EpiT, TSched, true, true>(lds, g, S, E, wave); }
#endif
        }
        SEAM(pb, true);
        if (IN(pb + 1)) for (int rep_ = 0; rep_ < PROBE_B; ++rep_) {
            int lane_ = (int)__builtin_amdgcn_mbcnt_hi(~0u, __builtin_amdgcn_mbcnt_lo(~0u, 0u)); asm volatile("" : "+v"(lane_));
#pragma unroll 1
            for (int part = 0; part < 2; ++part) {
            if ((part == 0) == (wave < 4)) {
#ifndef NO_ATT
            for (int ra_ = 0; ra_ < PROBE_ATT; ++ra_)
            for (int pr = gw; pr < 2048; pr += NGW) { const int bh = pr >> 5, i = pr & 31;
                const size_t bo = (size_t)(bh >> 3) * SLAB_E;
                attn_task(Qb + bo, Kb + bo, VTb + bo, Yb + bo, 0, bh & 7, 63 - i, lane_);
                attn_task(Qb + bo, Kb + bo, VTb + bo, Yb + bo, 0, bh & 7, i, lane_); }
#endif
            } else {
#ifndef NO_SGU
            for (int tk = gw; tk < 2048; tk += NGW) { const size_t bo = (size_t)(tk >> 8) * SLAB_E; sgu_task(VNTb + bo, WSBb + (size_t)l * 4 * 128 * 128, CUb + bo, a.in[9] + l * 512, Yb + bo, tk & 255, lane_); }
#endif
#ifndef NO_CONV
            for (int tk = gw; tk < 2048; tk += NGW) { const size_t bo = (size_t)(tk >> 8) * SLAB_E; conv_task(CONV + bo, a.in[4] + l * 768, Yb + bo, tk & 255, lane_); }
#endif
            }
            }
            asm volatile("s_waitcnt vmcnt(0) lgkmcnt(0)" ::: "memory"); __syncthreads();
        }
        SEAM(pb + 1, true);
        if (IN(pb + 2)) {
#ifndef NO_C
#ifndef NO_O
            { pg8::Gemm g{Yb + bo_blk - (size_t)(8 * (bx & 7)) * 256 * DM, wl + E_WOUT, M, DM, DM}; pg8::StaticOrder S; S.init(M, DM, G, bx);
              EpiRes E{bufX, LO, ss2, l == 0 ? 1 : 0, 0};
              pg8::gemm_phase<EpiRes, pg8::StaticOrder, true, true>(lds, g, S, E, wave); }
#endif
#endif
        }
        SEAM(pb + 2, true);
        if (IN(pb + 3)) for (int rep_ = 0; rep_ < PROBE_D; ++rep_) {
#ifndef NO_D
            pg8::Gemm g{bufX, wl + E_W1, M, DFF, DM}; pg8::StaticOrder S; S.init(M, DFF, G, bx);
            fill_rs_table(rstab, ss2, pm_blk, 1.f, tid_now());
            EpiFF1 E{rstab, Fb};
            pg8::gemm_phase<EpiFF1, pg8::StaticOrder, true, true>(lds, g, S, E, wave);
#endif
        }
        SEAM(pb + 3, true);
        if (IN(pb + 4)) {
#ifndef NO_E
            pg8::Gemm g{Fb, wl + E_W2, M, DM, DFF}; pg8::StaticOrder S; S.init(M, DM, G, bx);
            EpiRes E{bufX, LO, ss3, 0, l == DEPTH - 1 ? 1 : 0};
            pg8::gemm_phase<EpiRes, pg8::StaticOrder, true, true>(lds, g, S, E, wave);
#endif
        }
        SEAM(pb + 4, true);
        if (IN(pb + 5)) {
            if (l + 1 < DEPTH) {
                const float* pl = p + (size_t)(l + 1) * M * PLE;
#pragma unroll 4
                for (int t_ = gw; t_ < M * PLE / 512; t_ += NGW) { const int it = ((t_ >> 8) & 7) * 1024 + (t_ >> 11) * 256 + (t_ & 255);
                    const size_t o = (size_t)it * 512 + lane * 8; const f32x4 u0 = *(const f32x4*)(pl + o), u1 = *(const f32x4*)(pl + o + 4);
                    v4u w; w.x = pk2(u0.x, u0.y); w.y = pk2(u0.z, u0.w); w.z = pk2(u1.x, u1.y); w.w = pk2(u1.z, u1.w); *(v4u*)(PBb + (size_t)(it >> 10) * SLAB_E + (o & (size_t)(SEQ * PLE - 1))) = w; }
            }
#ifndef NO_F
            pg8::Gemm g{bufX, wl + E_WG, M, DM, DM}; pg8::StaticOrder S; S.init(M, DM, G, bx);
            fill_rs_table(rstab, ss3, pm_blk, -1.4426950408889634f, tid_now());
            EpiGate E{rstab, bufX, LO, bufT, ss1n, l == DEPTH - 1 ? H : (float*)nullptr, l == DEPTH - 1 ? 1 : 0};
            pg8::gemm_phase<EpiGate, pg8::StaticOrder, true, true>(lds, g, S, E, wave);
#endif
        }
        SEAM(pb + 5, true);
    }
#undef IN
#undef SEAM
}

extern "C" void kernel_launch(void* const* d_in, const int* in_sizes, int n_in, void* d_out, int out_size, void* d_ws, size_t ws_size, hipStream_t stream) {
    static int grid = 0;
    if (grid == 0) {
        if (n_in != 17 || in_sizes[0] != M * DM || out_size != M * DM || ws_size < WS_TOTAL) { fprintf(stderr, "kernel_launch: unexpected shapes (n_in %d, in0 %d, out %d, ws %zu, need %zu)\n", n_in, n_in > 0 ? in_sizes[0] : -1, out_size, ws_size, (size_t)WS_TOTAL); grid = -1; return; }
        int dev = 0, cus = 0, per_cu = 0;
        hipGetDevice(&dev); hipDeviceGetAttribute(&cus, hipDeviceAttributeMultiprocessorCount, dev);
        if (hipFuncSetAttribute((const void*)mk_fwd, hipFuncAttributeMaxDynamicSharedMemorySize, LDS_BYTES) != hipSuccess) { fprintf(stderr, "kernel_launch: hipFuncSetAttribute failed\n"); grid = -1; return; }
        if (hipOccupancyMaxActiveBlocksPerMultiprocessor(&per_cu, (const void*)mk_fwd, NWAVES * 64, LDS_BYTES) != hipSuccess || per_cu < 1) { fprintf(stderr, "kernel_launch: occupancy query says %d\n", per_cu); per_cu = 1; }
        (void)hipGetLastError();
        grid = cus * 1;
        if (grid != 256) { fprintf(stderr, "kernel_launch: this kernel's per-batch-element workspace layout needs a 256-workgroup grid (256 CUs); found %d CUs\n", cus); grid = -1; return; }
    }
    if (grid < 0) return;
#ifdef DBG_MEMSET
    (void)hipMemsetAsync(d_ws, 0xAA, WS_END, stream); (void)hipMemsetAsync(d_out, 0xAA, (size_t)M * DM * 4, stream);
#endif
    if (hipMemsetAsync((char*)d_ws + WS_CTL, 0, CTL_BYTES, stream) != hipSuccess) { fprintf(stderr, "kernel_launch: memset of the barrier words failed\n"); return; }
    Args a{};
    for (int i = 0; i < 17; ++i) a.in[i] = (const float*)d_in[i];
    a.out = (float*)d_out; a.ws = (unsigned char*)d_ws;
#if MK_N_LAUNCHES == 1
    a.ph_lo = 0; a.ph_hi = NPHASE;
    void* args[] = {&a};
    hipError_t e = hipLaunchCooperativeKernel((const void*)mk_fwd, dim3(grid), dim3(NWAVES * 64), args, LDS_BYTES, stream);
    if (e != hipSuccess) fprintf(stderr, "cooperative launch failed: %s (grid %d)\n", hipGetErrorString(e), grid);
#else
    for (int ph = 0; ph < NPHASE; ++ph) { a.ph_lo = ph; a.ph_hi = ph + 1; hipLaunchKernelGGL(mk_fwd, dim3(grid), dim3(NWAVES * 64), LDS_BYTES, stream, a); }
#endif
}
```

```cpp
#include <hip/hip_runtime.h>
#include <hip/hip_cooperative_groups.h>
#include <cstdio>
#include <cstdint>
namespace cg = cooperative_groups;
namespace pg8 {
#define PG8_LAS __attribute__((address_space(3)))
typedef unsigned short bf16_t;
typedef short bf16x8 __attribute__((ext_vector_type(8)));
typedef float f32x4 __attribute__((ext_vector_type(4)));
typedef unsigned u32x4 __attribute__((ext_vector_type(4)));
constexpr int BM = 256, BK = 64, HALF = 128, HTB = HALF * BK * 2  , STAGE_BYTES = 8 * HTB, NXCD = 8, WGM = 8;

__host__ __device__ __forceinline__ int lds_byte(int r, int c) { const int st = (r >> 4) * 2 + (c >> 5), rr = r & 15, cc = c & 31, ob = rr * 64 + cc * 2; return st * 1024 + (ob ^ (((ob >> 9) & 1) << 5)); }
__host__ __device__ __forceinline__ void stage_rc(int b, int& R, int& C) { const int st = b / 1024, sb = b % 1024, swz = sb ^ (((sb >> 9) & 1) << 5); R = (st >> 1) * 16 + swz / 64; C = (st & 1) * 32 + (swz % 64) / 2; }
__host__ __device__ __forceinline__ int perm32(int rho) { const int n = rho >> 4, i = rho & 15; return 8 * (i >> 2) + 4 * n + (i & 3); }

struct Unit { int pm, pn; };
struct Gemm { const bf16_t* A; const bf16_t* Bt; int M, N, K; };

struct StaticOrder {
    int nM, nN, nwg, G, c;
    __host__ __device__ void init(int M, int N, int G_, int c_) { nM = M / BM; nN = N / BM; nwg = nM * nN; G = G_; c = c_; }
    __host__ __device__ bool next(int i, Unit& u) const {
        const long L = (long)i * G + c; if (L >= nwg) return false;
        int wgid = (int)L; { const int q = nwg / NXCD, r = nwg % NXCD, xcd = wgid % NXCD, off = wgid / NXCD; wgid = (xcd < r ? xcd * (q + 1) : r * (q + 1) + (xcd - r) * q) + off; }
        const int nig = WGM * nN, gid = wgid / nig, fm = gid * WGM, gsz = (nM - fm) < WGM ? (nM - fm) : WGM;
        u.pm = fm + ((wgid % nig) % gsz); u.pn = (wgid % nig) / gsz; return true;
    }
    __device__ __forceinline__ void a_ready(const Unit&) const {}
    __device__ __forceinline__ void done(const Unit&) const {}
};

__device__ __forceinline__ unsigned cvt_pk_bf16(float lo, float hi) { unsigned r; asm volatile("v_cvt_pk_bf16_f32 %0, %1, %2" : "=v"(r) : "v"(lo), "v"(hi)); return r; }
typedef float f32x2 __attribute__((ext_vector_type(2)));
__device__ __forceinline__ f32x2 gelu_pk(f32x2 v) {
    const f32x2 av = __builtin_elementwise_abs(v), d = av * 0.2316418882f + 1.0f;
    f32x2 t; t.x = __builtin_amdgcn_rcpf(d.x); t.y = __builtin_amdgcn_rcpf(d.y);
    f32x2 q = t * 0.5307027145f + (-0.7265760135f); q = q * t + 0.7107068705f; q = q * t + (-0.142248368f); q = q * t + 0.127414796f; q = q * t;
    const f32x2 s = (v * v) * (-0.72134752044f);
    f32x2 e; e.x = __builtin_amdgcn_exp2f(s.x); e.y = __builtin_amdgcn_exp2f(s.y);
    const f32x2 m = v * (q * e), r = v - m;
    f32x2 o; o.x = v.x < 0.f ? m.x : r.x; o.y = v.y < 0.f ? m.y : r.y; return o;
}

template <int ACT  > struct EpiBf16 {
    static constexpr bool PERM = true, AFTER_DRAIN = false; static_assert(ACT == 0 || ACT == 1, "EpiBf16: ACT is 0 (none) or 1 (gelu_pk)");
    bf16_t* O; int ldc; const float* bias; int split_cols; size_t split_stride; float scale0;
    __device__ __forceinline__ void operator()(const f32x4 (&acc)[2][2][4][2], const Unit& u, int wr, int wc, int fr, int fq) const {
        const int row0 = u.pm * BM + wr * 64 + fr; int colt = u.pn * BM; bf16_t* base = O;
        float sc = 1.f; if (split_cols) { const int t = colt / split_cols; base += (size_t)t * split_stride; colt -= t * split_cols; if (t == 0) sc = scale0; }
        const int col0 = colt + wc * 32 + 8 * fq, bcol0 = u.pn * BM + wc * 32 + 8 * fq;
        f32x4 bv[2][2];
#pragma unroll
        for (int bj = 0; bj < 2; ++bj)
#pragma unroll
            for (int n = 0; n < 2; ++n) bv[bj][n] = bias ? *(const f32x4*)(bias + bcol0 + bj * HALF + 4 * n) : (f32x4){0.f, 0.f, 0.f, 0.f};
#pragma unroll
        for (int ai = 0; ai < 2; ++ai)
#pragma unroll
            for (int m = 0; m < 4; ++m) { bf16_t* rowp = base + (size_t)(row0 + ai * HALF + m * 16) * ldc + col0;
#pragma unroll
                for (int bj = 0; bj < 2; ++bj) { f32x4 v0 = acc[ai][bj][m][0] + bv[bj][0], v1 = acc[ai][bj][m][1] + bv[bj][1];
                    if (ACT == 1) { f32x2 a = gelu_pk((f32x2){v0[0], v0[1]}), b = gelu_pk((f32x2){v0[2], v0[3]}), c = gelu_pk((f32x2){v1[0], v1[1]}), d = gelu_pk((f32x2){v1[2], v1[3]});
                        v0 = (f32x4){a.x, a.y, b.x, b.y}; v1 = (f32x4){c.x, c.y, d.x, d.y}; }
                    v0 = v0 * sc; v1 = v1 * sc; u32x4 w; w.x = cvt_pk_bf16(v0[0], v0[1]); w.y = cvt_pk_bf16(v0[2], v0[3]); w.z = cvt_pk_bf16(v1[0], v1[1]); w.w = cvt_pk_bf16(v1[2], v1[3]);
                    *(u32x4*)(rowp + bj * HALF) = w; } }
    }
};
template <class Epi, class Sched, bool ALIGN_EPI = false, bool SP2 = false>
__device__ __forceinline__ void gemm_phase(PG8_LAS unsigned char* lds, const Gemm g, const Sched& S, const Epi& E, const int wave_id  ) {
    int tid_ = wave_id * 64 + (int)__builtin_amdgcn_mbcnt_hi(~0u, __builtin_amdgcn_mbcnt_lo(~0u, 0u)); asm volatile("" : "+v"(tid_));
    const int tid = tid_, wid = __builtin_amdgcn_readfirstlane(tid >> 6), lane = tid & 63, wr = wid >> 2, wc = wid & 3, fr = lane & 15, fq = lane >> 4;
    const int K = g.K, nt = K / BK;
    unsigned voffA[2], voffB[2];
#pragma unroll
    for (int i = 0; i < 2; ++i) { int R, C; stage_rc(tid * 16 + i * 8192, R, C); const int Rb = Epi::PERM ? ((R & ~31) + perm32(R & 31)) : R;
        voffA[i] = (unsigned)(R * K + C) * 2u; voffB[i] = (unsigned)(Rb * K + C) * 2u; }
    const size_t kstep = (size_t)(BK * 2);
    const size_t hstep = (size_t)HALF * K * 2;
    const size_t tstep = 2 * hstep;
    const unsigned ldsw = (unsigned)wid * 1024u;
    const int aoff = lds_byte(wr * 64 + fr, fq * 8), boff = lds_byte(wc * 32 + fr, fq * 8);
#define PG8_SA(b, h) (((b) * 2 + (h)) * HTB)
#define PG8_SB(b, h) ((4 + (b) * 2 + (h)) * HTB)
#define PG8_STAGE(bufoff, gbase, voff) do { _Pragma("unroll") for (int _i = 0; _i < 2; ++_i) \
        __builtin_amdgcn_global_load_lds((const unsigned*)((const char*)(gbase) + (voff)[_i]), (PG8_LAS unsigned*)(lds + (bufoff) + ldsw + _i * 8192), 16, 0, 0); } while (0)
#define PG8_LDA(dst, b, h) do { _Pragma("unroll") for (int m = 0; m < 4; ++m) _Pragma("unroll") for (int k = 0; k < 2; ++k) dst[m][k] = *(const PG8_LAS bf16x8*)(lds + PG8_SA(b, h) + aoff + m * 2048 + k * 1024); } while (0)
#define PG8_LDB(dst, b, h) do { _Pragma("unroll") for (int n = 0; n < 2; ++n) _Pragma("unroll") for (int k = 0; k < 2; ++k) dst[n][k] = *(const PG8_LAS bf16x8*)(lds + PG8_SB(b, h) + boff + n * 2048 + k * 1024); } while (0)
#define PG8_MMA(ai, bj, At, Bt) do { __builtin_amdgcn_s_setprio(1); _Pragma("unroll") for (int m = 0; m < 4; ++m) _Pragma("unroll") for (int n = 0; n < 2; ++n) _Pragma("unroll") for (int k = 0; k < 2; ++k) \
        acc[ai][bj][m][n] = __builtin_amdgcn_mfma_f32_16x16x32_bf16(Bt[n][k], At[m][k], acc[ai][bj][m][n], 0, 0, 0); __builtin_amdgcn_s_setprio(0); } while (0)
#define PG8_WAIT_V(n) asm volatile("s_waitcnt vmcnt(" #n ")" ::: "memory")
#define PG8_WAIT_L(n) asm volatile("s_waitcnt lgkmcnt(" #n ")" ::: "memory")
#define PG8_BAR __builtin_amdgcn_s_barrier()
#define PG8_SCHED __builtin_amdgcn_sched_barrier(0)
    Unit cur, nxt; int ui = 0;
    if (!S.next(0, cur)) return;
    f32x4 acc[2][2][4][2];
#pragma unroll
    for (int a = 0; a < 2; ++a)
#pragma unroll
        for (int b = 0; b < 2; ++b)
#pragma unroll
            for (int m = 0; m < 4; ++m)
#pragma unroll
                for (int n = 0; n < 2; ++n) acc[a][b][m][n] = (f32x4){0.f, 0.f, 0.f, 0.f};
    bf16x8 At[4][2], B0[2][2], B1[2][2];
    const char* cA = (const char*)g.A + (size_t)cur.pm * tstep; const char* cB = (const char*)g.Bt + (size_t)cur.pn * tstep;
    S.a_ready(cur);
    if constexpr (SP2) {
        PG8_STAGE(PG8_SB(0, 0), cB, voffB); PG8_STAGE(PG8_SB(0, 1), cB + hstep, voffB); PG8_STAGE(PG8_SA(0, 0), cA, voffA); PG8_STAGE(PG8_SA(0, 1), cA + hstep, voffA);
        if (wr == 1) PG8_BAR;
        PG8_WAIT_V(2); PG8_BAR;
        PG8_STAGE(PG8_SB(1, 0), cB + kstep, voffB); PG8_STAGE(PG8_SA(1, 0), cA + kstep, voffA); PG8_STAGE(PG8_SB(1, 1), cB + hstep + kstep, voffB);
        PG8_WAIT_V(6); PG8_BAR;
    } else {
        PG8_STAGE(PG8_SB(0, 0), cB, voffB); PG8_STAGE(PG8_SA(0, 0), cA, voffA); PG8_STAGE(PG8_SB(0, 1), cB + hstep, voffB); PG8_STAGE(PG8_SA(0, 1), cA + hstep, voffA);
        if (wr == 1) PG8_BAR;
        PG8_WAIT_V(4); PG8_BAR;
        PG8_STAGE(PG8_SB(1, 0), cB + kstep, voffB); PG8_STAGE(PG8_SA(1, 0), cA + kstep, voffA); PG8_STAGE(PG8_SB(1, 1), cB + hstep + kstep, voffB);
        PG8_WAIT_V(6); PG8_BAR;
    }
    for (;;) {
        const bool has_next = S.next(ui + 1, nxt);
        const char* nA = has_next ? (const char*)g.A + (size_t)nxt.pm * tstep : cA; const char* nB = has_next ? (const char*)g.Bt + (size_t)nxt.pn * tstep : cB;
        for (int t = 0; t < nt; t += 2) {
            const bool last = (t == nt - 2);
            const char* a1 = cA + (size_t)(t + 1) * kstep;
            const char* a2 = last ? nA : cA + (size_t)(t + 2) * kstep; const char* b2 = last ? nB : cB + (size_t)(t + 2) * kstep;
            const char* a3 = a2 + kstep; const char* b3 = b2 + kstep;
            if (last && has_next) S.a_ready(nxt);
            if constexpr (SP2) {
            PG8_LDB(B0, 0, 0); PG8_LDB(B1, 0, 1); PG8_SCHED; PG8_LDA(At, 0, 0); PG8_STAGE(PG8_SA(1, 1), a1 + hstep, voffA);
            PG8_WAIT_V(8); PG8_WAIT_L(0); PG8_BAR; PG8_MMA(0, 0, At, B0); PG8_MMA(0, 1, At, B1); PG8_BAR; PG8_SCHED;
            PG8_LDA(At, 0, 1); PG8_STAGE(PG8_SB(0, 0), b2, voffB); PG8_STAGE(PG8_SB(0, 1), b2 + hstep, voffB); PG8_STAGE(PG8_SA(0, 0), a2, voffA);
            PG8_WAIT_V(8); PG8_WAIT_L(0); PG8_BAR; PG8_MMA(1, 0, At, B0); PG8_MMA(1, 1, At, B1); PG8_BAR; PG8_SCHED;
            PG8_LDB(B0, 1, 0); PG8_LDB(B1, 1, 1); PG8_SCHED; PG8_LDA(At, 1, 0); PG8_STAGE(PG8_SA(0, 1), a2 + hstep, voffA);
            PG8_WAIT_V(8); PG8_WAIT_L(0); PG8_BAR; PG8_MMA(0, 0, At, B0); PG8_MMA(0, 1, At, B1); PG8_BAR; PG8_SCHED;
            PG8_LDA(At, 1, 1); PG8_STAGE(PG8_SB(1, 0), b3, voffB); PG8_STAGE(PG8_SB(1, 1), b3 + hstep, voffB); PG8_STAGE(PG8_SA(1, 0), a3, voffA);
            PG8_WAIT_V(8); PG8_WAIT_L(0); PG8_BAR; PG8_MMA(1, 0, At, B0); PG8_MMA(1, 1, At, B1); PG8_BAR; PG8_SCHED;
            } else {
            PG8_LDB(B0, 0, 0); PG8_SCHED; PG8_LDA(At, 0, 0); PG8_STAGE(PG8_SA(1, 1), a1 + hstep, voffA);
            PG8_WAIT_L(8); PG8_BAR; PG8_WAIT_L(0); PG8_MMA(0, 0, At, B0); PG8_BAR; PG8_SCHED;
            PG8_LDB(B1, 0, 1); PG8_STAGE(PG8_SB(0, 0), b2, voffB);
            PG8_BAR; PG8_WAIT_L(0); PG8_MMA(0, 1, At, B1); PG8_BAR;
            PG8_LDA(At, 0, 1); PG8_STAGE(PG8_SA(0, 0), a2, voffA);
            PG8_BAR; PG8_WAIT_L(0); PG8_MMA(1, 0, At, B0); PG8_BAR; PG8_SCHED;
            PG8_STAGE(PG8_SB(0, 1), b2 + hstep, voffB);
            PG8_WAIT_V(6); PG8_BAR; PG8_MMA(1, 1, At, B1); PG8_BAR;
            PG8_LDB(B0, 1, 0); PG8_SCHED; PG8_LDA(At, 1, 0); PG8_STAGE(PG8_SA(0, 1), a2 + hstep, voffA);
            PG8_WAIT_L(8); PG8_BAR; PG8_WAIT_L(0); PG8_MMA(0, 0, At, B0); PG8_BAR; PG8_SCHED;
            PG8_LDB(B1, 1, 1); PG8_STAGE(PG8_SB(1, 0), b3, voffB);
            PG8_BAR; PG8_WAIT_L(0); PG8_MMA(0, 1, At, B1); PG8_BAR;
            PG8_LDA(At, 1, 1); PG8_STAGE(PG8_SA(1, 0), a3, voffA);
            PG8_BAR; PG8_WAIT_L(0); PG8_MMA(1, 0, At, B0); PG8_BAR; PG8_SCHED;
            PG8_STAGE(PG8_SB(1, 1), b3 + hstep, voffB);
            PG8_WAIT_V(6); PG8_BAR; PG8_MMA(1, 1, At, B1); PG8_BAR;
            }
        }
        if constexpr (ALIGN_EPI) { if (wr == 0) PG8_BAR; }
        if constexpr (!Epi::AFTER_DRAIN) { E(acc, cur, wr, wc, fr, fq); S.done(cur); }
        if (!has_next) break;
#pragma unroll
        for (int a = 0; a < 2; ++a)
#pragma unroll
            for (int b = 0; b < 2; ++b)
#pragma unroll
                for (int m = 0; m < 4; ++m)
#pragma unroll
                    for (int n = 0; n < 2; ++n) acc[a][b][m][n] = (f32x4){0.f, 0.f, 0.f, 0.f};
        cur = nxt; cA = nA; cB = nB; ++ui;
        if constexpr (ALIGN_EPI) { if (wr == 1) PG8_BAR; }
    }
    PG8_WAIT_V(0);
    if constexpr (!ALIGN_EPI) { if (wr == 0) PG8_BAR; }
    PG8_BAR;
    if constexpr (Epi::AFTER_DRAIN) { E.fused(acc, cur, wr, wc, fr, fq, lds, wid, lane); S.done(cur); }
#undef PG8_SA
#undef PG8_SB
#undef PG8_STAGE
#undef PG8_LDA
#undef PG8_LDB
#undef PG8_MMA
#undef PG8_WAIT_V
#undef PG8_WAIT_L
#undef PG8_BAR
#undef PG8_SCHED
}
}

#ifndef MK_N_LAUNCHES
#define MK_N_LAUNCHES 1
#endif
#ifndef ATT_EARLY_EXIT
#define ATT_EARLY_EXIT 1
#endif
constexpr int NWAVES = 8;
constexpr int M = 16384, DM = 1024, SEQ = 2048, DEPTH = 4, NIN = 2816, DFF = 4096, PLE = 256;
constexpr float EPS = 1e-6f;
constexpr float C2 = 0.125f * 1.4426950408889634f;
constexpr int NPHASE = 1 + 6 * DEPTH;
#ifndef RES_CH
#define RES_CH 4
#endif
#ifndef GATE_CH
#define GATE_CH 4
#endif
#ifndef PROBE_B
#define PROBE_B 1
#endif
#ifndef PROBE_ATT
#define PROBE_ATT 1
#endif
#ifndef PROBE_SYNC
#define PROBE_SYNC 1
#endif
#ifndef PROBE_P
#define PROBE_P 1
#endif
#ifndef PROBE_A
#define PROBE_A 1
#endif
#ifndef PROBE_D
#define PROBE_D 1
#endif

typedef unsigned short bf16;
#define LAS __attribute__((address_space(3)))
typedef unsigned v4u __attribute__((ext_vector_type(4)));
typedef unsigned v2u __attribute__((ext_vector_type(2)));
typedef float f32x4 __attribute__((ext_vector_type(4)));
typedef float f32x2 __attribute__((ext_vector_type(2)));
typedef float f32x16 __attribute__((ext_vector_type(16)));
typedef short bf16x8 __attribute__((ext_vector_type(8)));
typedef short s16x4 __attribute__((ext_vector_type(4)));
#define LDS_WAIT() asm volatile("s_waitcnt lgkmcnt(0)" ::: "memory")

constexpr size_t E_WIN = 0, E_WOUT = (size_t)NIN * DM, E_W1 = E_WOUT + (size_t)DM * DM, E_W2 = E_W1 + (size_t)DFF * DM, E_WG = E_W2 + (size_t)DFF * DM, E_WP = E_WG + (size_t)DM * DM,
                 E_WLAYER = E_WP + (size_t)PLE * DM;
constexpr size_t WS_W = 0, WS_WSB = WS_W + (size_t)DEPTH * E_WLAYER * 2, WS_SS = WS_WSB + (size_t)DEPTH * 4 * 128 * 128 * 2, WS_HB = WS_SS + (size_t)3 * M * 16 * 4,
                 WS_LO = WS_HB + (size_t)M * DM * 2, WS_XB = WS_LO + (size_t)M * DM * 2, WS_BIG = WS_XB + (size_t)M * DM * 2, WS_END = WS_BIG + (size_t)M * DFF * 2;
constexpr size_t SLAB_E = (size_t)SEQ * DFF, O_CONV = 0, O_Q = O_CONV + (size_t)3 * SEQ * 256, O_K = O_Q + (size_t)SEQ * 512, O_VT = O_K + (size_t)SEQ * 512, O_CU = O_VT + (size_t)SEQ * 512,
                 O_VNT = O_CU + (size_t)SEQ * 256, O_Y = O_VNT + (size_t)SEQ * 256, O_PB = O_Y + (size_t)SEQ * DM, O_END = O_PB + (size_t)SEQ * PLE;
static_assert(O_END <= SLAB_E, "a batch element's mixer tensors + its bf16 p rows fit under its F rows");
constexpr size_t WS_CTL = WS_END, CTL_BYTES = 32768, WS_TOTAL = WS_CTL + CTL_BYTES;
constexpr int RING_BYTES = 131072, RS_OFF = RING_BYTES + 64, LDS_BYTES = RS_OFF + 1024 + 960;

__device__ __forceinline__ unsigned f2bf(float f) { unsigned u = __builtin_bit_cast(unsigned, f); return (u + 0x7fffu + ((u >> 16) & 1u)) >> 16; }
typedef __bf16 bf16x2_t __attribute__((ext_vector_type(2)));
__device__ __forceinline__ unsigned pk2(float lo, float hi) { f32x2 v = {lo, hi}; bf16x2_t b = __builtin_convertvector(v, bf16x2_t); return __builtin_bit_cast(unsigned, b); }
__device__ __forceinline__ float bflo(unsigned u) { return __builtin_bit_cast(float, u << 16); }
__device__ __forceinline__ float bfhi(unsigned u) { return __builtin_bit_cast(float, u & 0xffff0000u); }
__device__ __forceinline__ float wave_sum(float v) {
#pragma unroll
    for (int o = 1; o < 64; o <<= 1) v += __shfl_xor(v, o);
    return v;
}

__device__ __forceinline__ float row_rs(const float* ssp, int r) {
    const f32x4* q = (const f32x4*)(ssp + (size_t)r * 16); const f32x4 a = q[0], b = q[1], c = q[2], d = q[3];
    const float s = ((a[0] + a[1]) + (a[2] + a[3])) + ((b[0] + b[1]) + (b[2] + b[3])) + ((c[0] + c[1]) + (c[2] + c[3])) + ((d[0] + d[1]) + (d[2] + d[3]));
    return rsqrtf(s * (1.f / 1024.f) + EPS);
}
__device__ __forceinline__ void fill_rs_table(LAS float* tab, const float* ssp, int pm, float mul, int tid) {
    asm volatile("" : "+v"(tid));
    if (tid < 256) tab[tid] = row_rs(ssp, pm * 256 + tid) * mul;
    asm volatile("s_waitcnt vmcnt(0) lgkmcnt(0)" ::: "memory"); __syncthreads();
}
struct EpiInProj {
    static constexpr bool PERM = true, AFTER_DRAIN = false;
    const LAS float* rst; bf16* conv; bf16* q; bf16* k; bf16* vt; bf16* cu; bf16* vnt; const float* qg; const float* kg; const float* sg;
    __device__ __forceinline__ void operator()(const pg8::f32x4 (&acc)[2][2][4][2], const pg8::Unit& u, int wr, int wc, int fr, int fq) const {
        const int sec = u.pn;
        const int row0 = u.pm * 256 + wr * 64 + fr;
        const int cw = 64 * wc + 8 * fq;
        const bool normed = (sec >= 3 && sec < 7) || sec == 10;
        float rsv[8];
#pragma unroll
        for (int g = 0; g < 8; ++g) { rsv[g] = rst[(g >> 2) * 128 + wr * 64 + (g & 3) * 16 + fr]; }
        f32x4 gv[2][2];
#pragma unroll
        for (int bj = 0; bj < 2; ++bj)
#pragma unroll
            for (int n = 0; n < 2; ++n) {
                if (sec >= 3 && sec < 7) { const float* g = sec < 5 ? qg : kg; const float sc = sec < 5 ? C2 : 1.f; gv[bj][n] = *(const f32x4*)(g + 32 * bj + 8 * fq + 4 * n) * sc; }
                else if (sec == 10) gv[bj][n] = *(const f32x4*)(sg + cw + 32 * bj + 4 * n);
                else gv[bj][n] = (f32x4){1.f, 1.f, 1.f, 1.f};
            }
#pragma unroll
        for (int ai = 0; ai < 2; ++ai)
#pragma unroll
            for (int m = 0; m < 4; ++m) {
                const int r = row0 + ai * 128 + m * 16;
                const float rs = rsv[ai * 4 + m];
                f32x4 v[2][2];
#pragma unroll
                for (int bj = 0; bj < 2; ++bj)
#pragma unroll
                    for (int n = 0; n < 2; ++n) v[bj][n] = acc[ai][bj][m][n] * rs;
                if (sec >= 9) {
#pragma unroll
                    for (int bj = 0; bj < 2; ++bj)
#pragma unroll
                        for (int n = 0; n < 2; ++n) { const pg8::f32x2 a = pg8::gelu_pk((pg8::f32x2){v[bj][n][0], v[bj][n][1]}), b = pg8::gelu_pk((pg8::f32x2){v[bj][n][2], v[bj][n][3]}); v[bj][n] = (f32x4){a.x, a.y, b.x, b.y}; }
                }
                if (normed) {
                    float s2 = 0.f;
#pragma unroll
                    for (int bj = 0; bj < 2; ++bj)
#pragma unroll
                        for (int n = 0; n < 2; ++n) { const f32x4 x = v[bj][n]; s2 += (x[0] * x[0] + x[1] * x[1]) + (x[2] * x[2] + x[3] * x[3]); }
                    s2 += __shfl_xor(s2, 16); s2 += __shfl_xor(s2, 32);
                    const float rn = rsqrtf(s2 * (1.f / 64.f) + EPS);
#pragma unroll
                    for (int bj = 0; bj < 2; ++bj)
#pragma unroll
                        for (int n = 0; n < 2; ++n) v[bj][n] = v[bj][n] * rn * gv[bj][n];
                }
                const int s = r & 2047; const size_t bo = (size_t)(r >> 11) * SLAB_E;
                if (sec == 10) {
                    const int sl = s & 127;
                    bf16* base = vnt + bo + ((((size_t)(wc * 16 + (s >> 7)) * 2) * 8 + (sl >> 4)) * 64 + ((sl >> 3) & 1) * 32 + 8 * fq) * 8 + (sl & 7);
#pragma unroll
                    for (int bj = 0; bj < 2; ++bj)
#pragma unroll
                        for (int n = 0; n < 2; ++n)
#pragma unroll
                            for (int j = 0; j < 4; ++j) base[(size_t)bj * 8 * 64 * 8 + (4 * n + j) * 8] = (bf16)f2bf(v[bj][n][j]);
                } else if (sec == 7 || sec == 8) {
                    const int kk_ = s & 31;
                    bf16* base = vt + bo + (((size_t)((4 * (sec - 7) + wc) * 64 + (s >> 5)) * 4 + (kk_ >> 4)) * 64 + ((kk_ >> 3) & 1) * 32 + 8 * fq) * 8 + (kk_ & 7);
#pragma unroll
                    for (int bj = 0; bj < 2; ++bj)
#pragma unroll
                        for (int n = 0; n < 2; ++n)
#pragma unroll
                            for (int j = 0; j < 4; ++j) base[(size_t)bj * 2 * 64 * 8 + (4 * n + j) * 8] = (bf16)f2bf(v[bj][n][j]);
                } else if (sec >= 3 && sec < 7) {
                    const bool isq = sec < 5;
                    const int sl = s & 31, pos = isq ? sl : ((sl & 0x13) | ((sl & 4) << 1) | ((sl & 8) >> 1));
                    bf16* base = (isq ? q : k) + bo + (((size_t)((4 * ((sec - 3) & 1) + wc) * 64 + (s >> 5)) * 4 + (fq >> 1)) * 64 + (fq & 1) * 32 + pos) * 8;
#pragma unroll
                    for (int bj = 0; bj < 2; ++bj) { v4u w; w.x = pk2(v[bj][0][0], v[bj][0][1]); w.y = pk2(v[bj][0][2], v[bj][0][3]); w.z = pk2(v[bj][1][0], v[bj][1][1]); w.w = pk2(v[bj][1][2], v[bj][1][3]);
                        *(v4u*)(base + (size_t)bj * 2 * 64 * 8) = w; }
                } else {
                    bf16* dst; int ld;
                    if (sec < 3) { dst = conv + bo + (size_t)sec * SEQ * 256 + cw; ld = 256; }
                    else { dst = cu + bo + cw; ld = 256; }
                    dst += (size_t)s * ld;
#pragma unroll
                    for (int bj = 0; bj < 2; ++bj) { v4u w; w.x = pk2(v[bj][0][0], v[bj][0][1]); w.y = pk2(v[bj][0][2], v[bj][0][3]); w.z = pk2(v[bj][1][0], v[bj][1][1]); w.w = pk2(v[bj][1][2], v[bj][1][3]);
                        *(v4u*)(dst + 32 * bj) = w; }
                }
            }
    }
};

__device__ __forceinline__ void unpk(const v4u w, f32x4& a, f32x4& b) { a = (f32x4){bflo(w.x), bfhi(w.x), bflo(w.y), bfhi(w.y)}; b = (f32x4){bflo(w.z), bfhi(w.z), bflo(w.w), bfhi(w.w)}; }
__device__ __forceinline__ void split_store(const f32x4 h0, const f32x4 h1, bf16* hi, bf16* lo) {
    v4u w; w.x = pk2(h0[0], h0[1]); w.y = pk2(h0[2], h0[3]); w.z = pk2(h1[0], h1[1]); w.w = pk2(h1[2], h1[3]); *(v4u*)hi = w;
    f32x4 a, b; unpk(w, a, b); const f32x4 d0 = h0 - a, d1 = h1 - b;
    v4u l; l.x = pk2(d0[0], d0[1]); l.y = pk2(d0[2], d0[3]); l.z = pk2(d1[0], d1[1]); l.w = pk2(d1[2], d1[3]); *(v4u*)lo = l;
}
struct EpiRes {
    static constexpr bool PERM = true, AFTER_DRAIN = false;
    bf16* hi; bf16* lo; float* ssout; int use_lo, write_lo;
    __device__ __forceinline__ void operator()(const pg8::f32x4 (&acc)[2][2][4][2], const pg8::Unit& u, int wr, int wc, int fr, int fq) const {
        const int row0 = u.pm * 256 + wr * 64 + fr, col0 = u.pn * 256 + wc * 32 + 8 * fq;
        constexpr int CH = RES_CH;
#pragma unroll
        for (int c0 = 0; c0 < 8; c0 += CH) {
            v4u bq[CH][4];
#pragma unroll
            for (int i = 0; i < CH; ++i) if (c0 + i < 8) { const int g = c0 + i; const size_t off = (size_t)(row0 + (g >> 2) * 128 + (g & 3) * 16) * DM + col0;
#pragma unroll
                for (int bj = 0; bj < 2; ++bj) { bq[i][2 * bj] = *(const v4u*)(hi + off + bj * 128); bq[i][2 * bj + 1] = use_lo ? *(const v4u*)(lo + off + bj * 128) : (v4u){0u, 0u, 0u, 0u}; } }
            asm volatile("" ::: "memory");
#pragma unroll
            for (int i = 0; i < CH; ++i) if (c0 + i < 8) { const int g = c0 + i;
                const int ai = g >> 2, m = g & 3;
                const int r = row0 + ai * 128 + m * 16; const size_t off = (size_t)r * DM + col0; float s2 = 0.f;
#pragma unroll
                for (int bj = 0; bj < 2; ++bj) {
                    f32x4 a0, a1, l0, l1; unpk(bq[i][2 * bj], a0, a1); unpk(bq[i][2 * bj + 1], l0, l1);
                    const f32x4 h0 = (a0 + l0) + acc[ai][bj][m][0], h1 = (a1 + l1) + acc[ai][bj][m][1];
                    if (write_lo) split_store(h0, h1, hi + off + bj * 128, lo + off + bj * 128);
                    else { v4u w; w.x = pk2(h0[0], h0[1]); w.y = pk2(h0[2], h0[3]); w.z = pk2(h1[0], h1[1]); w.w = pk2(h1[2], h1[3]); *(v4u*)(hi + off + bj * 128) = w; }
                    s2 += (h0[0] * h0[0] + h0[1] * h0[1]) + (h0[2] * h0[2] + h0[3] * h0[3]) + (h1[0] * h1[0] + h1[1] * h1[1]) + (h1[2] * h1[2] + h1[3] * h1[3]);
                }
                s2 += __shfl_xor(s2, 16); s2 += __shfl_xor(s2, 32);
                if (fq == 0) ssout[(size_t)r * 16 + u.pn * 4 + wc] = s2;
            }
            asm volatile("" ::: "memory");
        }
    }
};
struct EpiFF1 {
    static constexpr bool PERM = true, AFTER_DRAIN = false;
    const LAS float* rst; bf16* f;
    __device__ __forceinline__ void operator()(const pg8::f32x4 (&acc)[2][2][4][2], const pg8::Unit& u, int wr, int wc, int fr, int fq) const {
        const int row0 = u.pm * 256 + wr * 64 + fr, col0 = u.pn * 256 + wc * 32 + 8 * fq;
        float rsv[8];
#pragma unroll
        for (int g = 0; g < 8; ++g) { rsv[g] = rst[(g >> 2) * 128 + wr * 64 + (g & 3) * 16 + fr]; }
#pragma unroll
        for (int ai = 0; ai < 2; ++ai)
#pragma unroll
            for (int m = 0; m < 4; ++m) {
                const int r = row0 + ai * 128 + m * 16; const float rs = rsv[ai * 4 + m]; bf16* dst = f + (size_t)r * DFF + col0;
#pragma unroll
                for (int bj = 0; bj < 2; ++bj) {
                    f32x4 a = acc[ai][bj][m][0] * rs, b = acc[ai][bj][m][1] * rs;
#pragma unroll
                    for (int j = 0; j < 4; ++j) { a[j] = fmaxf(a[j], 0.f); a[j] *= a[j]; b[j] = fmaxf(b[j], 0.f); b[j] *= b[j]; }
                    v4u w; w.x = pk2(a[0], a[1]); w.y = pk2(a[2], a[3]); w.z = pk2(b[0], b[1]); w.w = pk2(b[2], b[3]); *(v4u*)(dst + bj * 128) = w;
                }
            }
    }
};
struct EpiT {
    static constexpr bool PERM = true, AFTER_DRAIN = false;
    bf16* t;
    __device__ __forceinline__ void operator()(const pg8::f32x4 (&acc)[2][2][4][2], const pg8::Unit& u, int wr, int wc, int fr, int fq) const {
        const int row0 = u.pm * 256 + wr * 64 + fr, col0 = u.pn * 256 + wc * 32 + 8 * fq;
#pragma unroll
        for (int ai = 0; ai < 2; ++ai)
#pragma unroll
            for (int m = 0; m < 4; ++m) {
                bf16* dst = t + (size_t)(row0 + ai * 128 + m * 16) * DM + col0;
#pragma unroll
                for (int bj = 0; bj < 2; ++bj) { const f32x4 a = acc[ai][bj][m][0], b = acc[ai][bj][m][1];
                    v4u w; w.x = pk2(a[0], a[1]); w.y = pk2(a[2], a[3]); w.z = pk2(b[0], b[1]); w.w = pk2(b[2], b[3]); *(v4u*)(dst + bj * 128) = w; }
            }
    }
};
struct EpiGate {
    static constexpr bool PERM = true, AFTER_DRAIN = false;
    const LAS float* rst; const bf16* hi; bf16* lo; bf16* tx; float* ssout; float* fout; int use_lo;
    __device__ __forceinline__ void operator()(const pg8::f32x4 (&acc)[2][2][4][2], const pg8::Unit& u, int wr, int wc, int fr, int fq) const {
        const int row0 = u.pm * 256 + wr * 64 + fr, col0 = u.pn * 256 + wc * 32 + 8 * fq;
        float rsv[8];
#pragma unroll
        for (int g = 0; g < 8; ++g) { rsv[g] = rst[(g >> 2) * 128 + wr * 64 + (g & 3) * 16 + fr]; }
        constexpr int CH = GATE_CH;
        float s2 = 0.f;
#pragma unroll
        for (int c0 = 0; c0 < 16; c0 += CH) {
            v4u hq[CH], lq[CH], tq[CH];
#pragma unroll
            for (int i = 0; i < CH; ++i) { const int q = c0 + i, gn = q >> 1, bn = q & 1; const size_t off = (size_t)(row0 + (gn >> 2) * 128 + (gn & 3) * 16) * DM + col0 + bn * 128;
                tq[i] = *(const v4u*)(tx + off); hq[i] = *(const v4u*)(hi + off); lq[i] = use_lo ? *(const v4u*)(lo + off) : (v4u){0u, 0u, 0u, 0u}; }
            asm volatile("" ::: "memory");
#pragma unroll
            for (int i = 0; i < CH; ++i) { const int q = c0 + i;
                const int g = q >> 1, bj = q & 1, ai = g >> 2, m = g & 3;
                const int r = row0 + ai * 128 + m * 16; const float rs = rsv[g]; const size_t off = (size_t)r * DM + col0 + bj * 128;
                f32x4 t0, t1, a0, a1, l0, l1; unpk(tq[i], t0, t1); unpk(hq[i], a0, a1); unpk(lq[i], l0, l1);
                f32x4 g0 = acc[ai][bj][m][0] * rs, g1 = acc[ai][bj][m][1] * rs;
#pragma unroll
                for (int j = 0; j < 4; ++j) { g0[j] = __builtin_amdgcn_rcpf(1.f + __builtin_amdgcn_exp2f(g0[j])); g1[j] = __builtin_amdgcn_rcpf(1.f + __builtin_amdgcn_exp2f(g1[j])); }
                const f32x4 h0 = (a0 + l0) + g0 * t0, h1 = (a1 + l1) + g1 * t1;
                if (!fout) { v4u w; w.x = pk2(h0[0], h0[1]); w.y = pk2(h0[2], h0[3]); w.z = pk2(h1[0], h1[1]); w.w = pk2(h1[2], h1[3]); *(v4u*)(tx + off) = w; }
                if (fout) { *(f32x4*)(fout + off) = h0; *(f32x4*)(fout + off + 4) = h1; }
                s2 += (h0[0] * h0[0] + h0[1] * h0[1]) + (h0[2] * h0[2] + h0[3] * h0[3]) + (h1[0] * h1[0] + h1[1] * h1[1]) + (h1[2] * h1[2] + h1[3] * h1[3]);
                if (bj == 1) {
                    s2 += __shfl_xor(s2, 16); s2 += __shfl_xor(s2, 32);
                    if (fq == 0 && !fout) ssout[(size_t)r * 16 + u.pn * 4 + wc] = s2;
                    s2 = 0.f;
                }
            }
            asm volatile("" ::: "memory");
        }
    }
};

struct TSched {
    int c, c0, G;
    __device__ __forceinline__ bool next(int i, pg8::Unit& u) const {
        if (c < c0) return false;
        if (G == 256 && c0 == 192) { if (i >= 4) return false; u.pm = 8 * (c & 7) + ((c - c0) >> 3); u.pn = i; return true; }
        const int un = (c - c0) + i * (G - c0); if (un >= 256) return false; u.pm = un >> 2; u.pn = un & 3; return true; }
    __device__ __forceinline__ void a_ready(const pg8::Unit&) const {}
    __device__ __forceinline__ void done(const pg8::Unit&) const {}
};
struct TrJob { const float* W; bf16* WT; const float* g; int K, N, item, hperm; };
__device__ __forceinline__ void tr_load(const TrJob& j, int lane, f32x4 (&v)[8]) {
    const int nblk = j.N / 32, kb = j.item / nblk, nb = j.item % nblk, k0 = 64 * kb, n0 = 32 * nb;
    const int kr = lane >> 3, nq = (lane & 7) * 4;
#pragma unroll
    for (int i = 0; i < 8; ++i) v[i] = *(const f32x4*)(j.W + (size_t)(k0 + 8 * i + kr) * j.N + n0 + nq);
    if (j.g) {
#pragma unroll
        for (int i = 0; i < 8; ++i) v[i] = v[i] * j.g[k0 + 8 * i + kr];
    }
}
__device__ __forceinline__ void tr_finish(const TrJob& j, int lane, const f32x4 (&v)[8], LAS float* scr) {
    const int nblk = j.N / 32, kb = j.item / nblk, nb = j.item % nblk, k0 = 64 * kb, n0 = 32 * nb;
    const int kr = lane >> 3, nq = (lane & 7) * 4;
#pragma unroll
    for (int i = 0; i < 8; ++i) { LAS float* d = scr + (8 * i + kr) * 33 + nq; d[0] = v[i][0]; d[1] = v[i][1]; d[2] = v[i][2]; d[3] = v[i][3]; }
    LDS_WAIT(); asm volatile("" ::: "memory");
    int d0 = n0; if (j.hperm) { const int gi = (n0 >> 5) & 7; d0 = (n0 & ~255) + 32 * (4 * (gi & 1) + (gi >> 1)); }
    const int c = lane & 7;
#pragma unroll
    for (int q = 0; q < 4; ++q) { const int n = (lane >> 3) + 8 * q; const LAS float* sp = scr + (8 * c) * 33 + n;
        v4u o; o.x = pk2(sp[0 * 33], sp[1 * 33]); o.y = pk2(sp[2 * 33], sp[3 * 33]); o.z = pk2(sp[4 * 33], sp[5 * 33]); o.w = pk2(sp[6 * 33], sp[7 * 33]);
        *(v4u*)(j.WT + (size_t)(d0 + n) * j.K + k0 + 8 * c) = o; }
    LDS_WAIT(); asm volatile("" ::: "memory");
}

__device__ __forceinline__ int crow(int r, int hf) { return (r & 3) + 8 * (r >> 2) + 4 * hf; }
__device__ __forceinline__ bool attn_tile(const bf16x8 (&kf)[4], const bf16x8 (&vf)[4], const bf16x8 (&qr)[4], f32x16& o0, f32x16& o1, float& carry, bool diag, int t, int hf) {
    f32x16 z;
#pragma unroll
    for (int r = 0; r < 16; ++r) z[r] = 0.f;
#pragma unroll
    for (int kk = 0; kk < 4; ++kk) z = __builtin_amdgcn_mfma_f32_32x32x16_bf16(kf[kk], qr[kk], z, 0, 0, 0);
    float e[16], w[16];
#pragma unroll
    for (int r = 0; r < 16; ++r) {
        float ev = __builtin_amdgcn_exp2f(__builtin_amdgcn_fmed3f(z[r], -3.0e38f, 31.f));
        if (diag) { const bool valid = (16 * (r >> 3) + 8 * hf + (r & 7)) < t; ev = valid ? ev : 0.f; }
        e[r] = ev;
    }
    float R[2], fb[2], ia_[2];
#pragma unroll
    for (int ks = 0; ks < 2; ++ks) {
        const int a = 8 * ks, b = 8 * ks + 4;
        const float da0 = 1.f + e[a], da1 = 1.f + e[a + 1], da2 = 1.f + e[a + 2], da3 = 1.f + e[a + 3];
        const float db0 = 1.f + e[b], db1 = 1.f + e[b + 1], db2 = 1.f + e[b + 2], db3 = 1.f + e[b + 3];
        const float pa2 = da0 * da1, pa3 = pa2 * da2, Pa = pa3 * da3;
        const float pb2 = db0 * db1, pb3 = pb2 * db2, Pb = pb3 * db3;
        const float ia = __builtin_amdgcn_rcpf(Pa), ib = __builtin_amdgcn_rcpf(Pb);
        w[a] = e[a]; w[a + 1] = e[a + 1] * da0; w[a + 2] = e[a + 2] * pa2; w[a + 3] = e[a + 3] * pa3;
        w[b] = e[b]; w[b + 1] = e[b + 1] * db0; w[b + 2] = e[b + 2] * pb2; w[b + 3] = e[b + 3] * pb3;
        ia_[ks] = ia; fb[ks] = ib; R[ks] = ia * ib;
        __builtin_amdgcn_sched_barrier(0);
    }
    const float Rp0 = __shfl_xor(R[0], 32), Rp1 = __shfl_xor(R[1], 32);
    const float T1 = R[1] * Rp1, T0 = R[0] * Rp0;
    const float L1 = hf ? carry : carry * Rp1;
    const float c0 = carry * T1, L0 = hf ? c0 : c0 * Rp0;
    carry = c0 * T0;
    { const float f0b = fb[0] * L0, f0a = ia_[0] * f0b, f1b = fb[1] * L1, f1a = ia_[1] * f1b;
#pragma unroll
      for (int jj = 0; jj < 4; ++jj) { w[jj] *= f0a; w[4 + jj] *= f0b; w[8 + jj] *= f1a; w[12 + jj] *= f1b; } }
#pragma unroll
    for (int ks = 0; ks < 2; ++ks) {
        v4u pw; pw.x = pk2(w[8 * ks], w[8 * ks + 1]); pw.y = pk2(w[8 * ks + 2], w[8 * ks + 3]); pw.z = pk2(w[8 * ks + 4], w[8 * ks + 5]); pw.w = pk2(w[8 * ks + 6], w[8 * ks + 7]);
        const bf16x8 pf = __builtin_bit_cast(bf16x8, pw);
        o0 = __builtin_amdgcn_mfma_f32_32x32x16_bf16(vf[ks], pf, o0, 0, 0, 0);
        o1 = __builtin_amdgcn_mfma_f32_32x32x16_bf16(vf[2 + ks], pf, o1, 0, 0, 0);
    }
#if ATT_EARLY_EXIT
    return __all(carry == 0.f);
#else
    return false;
#endif
}
#define ATT_LOAD(KD, VD, TJ) do { const size_t o_ = (size_t)(TJ) * 2048; _Pragma("unroll") for (int i_ = 0; i_ < 4; ++i_) { KD[i_] = *(const bf16x8*)(kbase + o_ + i_ * 512); VD[i_] = *(const bf16x8*)(vbase + o_ + i_ * 512); } \
        __builtin_amdgcn_sched_barrier(0); } while (0)
__device__ __forceinline__ void attn_task(const bf16* Q, const bf16* K, const bf16* VT, bf16* Y, int b, int h, int qb, int lane) {
    const int t = lane & 31, hf = lane >> 5, q0 = qb * 32;
    const size_t hb = (size_t)(b * 8 + h) * 64;
    const bf16* qp = Q + ((hb + qb) * 4 * 64 + lane) * 8;
    bf16x8 qr[4];
#pragma unroll
    for (int kk = 0; kk < 4; ++kk) qr[kk] = *(const bf16x8*)(qp + kk * 512);
    const bf16* kbase = K + (hb * 4 * 64 + lane) * 8;
    const bf16* vbase = VT + (hb * 4 * 64 + lane) * 8;
    f32x16 o0, o1;
#pragma unroll
    for (int r = 0; r < 16; ++r) { o0[r] = 0.f; o1[r] = 0.f; }
    float carry = 1.f;
    bf16x8 ka[4], va[4], kb[4], vb[4];
    ATT_LOAD(ka, va, qb);
    ATT_LOAD(kb, vb, qb > 0 ? qb - 1 : 0);
    __builtin_amdgcn_s_waitcnt(0x0F78);
    bool done = attn_tile(ka, va, qr, o0, o1, carry, true, t, hf);
    int j = qb - 1;
    while (!done && j >= 0) {
        __builtin_amdgcn_s_waitcnt(0x0F70);
        ATT_LOAD(ka, va, j > 0 ? j - 1 : 0);
        done = attn_tile(kb, vb, qr, o0, o1, carry, false, t, hf); --j;
        if (done || j < 0) break;
        ATT_LOAD(kb, vb, j > 0 ? j - 1 : 0);
        __builtin_amdgcn_s_waitcnt(0x0F78);
        done = attn_tile(ka, va, qr, o0, o1, carry, false, t, hf); --j;
    }
    bf16* yp = Y + (size_t)(b * SEQ + q0 + t) * DM + 256 + h * 64 + 4 * hf;
#pragma unroll
    for (int g = 0; g < 4; ++g) {
        v2u a; a.x = pk2(o0[4 * g], o0[4 * g + 1]); a.y = pk2(o0[4 * g + 2], o0[4 * g + 3]); *(v2u*)(yp + 8 * g) = a;
        v2u c; c.x = pk2(o1[4 * g], o1[4 * g + 1]); c.y = pk2(o1[4 * g + 2], o1[4 * g + 3]); *(v2u*)(yp + 32 + 8 * g) = c;
    }
}
__device__ __forceinline__ void sgu_task(const bf16* VNT, const bf16* WSB, const bf16* CU, const float* bias, bf16* Y, int task, int lane) {
    const int tb = task & 3, g = (task >> 2) & 3, c = (task >> 4) & 15, b = task >> 8;
    const int t = lane & 31, hf = lane >> 5;
    const bf16* ap = VNT + ((size_t)((b * 4 + g) * 16 + c) * 2 * 8 * 64 + lane) * 8;
    const bf16* bp = WSB + ((size_t)(g * 4 + tb) * 8 * 64 + lane) * 8;
    f32x16 a0, a1;
#pragma unroll
    for (int r = 0; r < 16; ++r) { a0[r] = 0.f; a1[r] = 0.f; }
    bf16x8 bfr[8], af0[8], af1[8];
#pragma unroll
    for (int ks = 0; ks < 8; ++ks) { bfr[ks] = *(const bf16x8*)(bp + 512 * ks); af0[ks] = *(const bf16x8*)(ap + 512 * ks); af1[ks] = *(const bf16x8*)(ap + 4096 + 512 * ks); }
#pragma unroll
    for (int ks = 0; ks < 8; ++ks) {
        a0 = __builtin_amdgcn_mfma_f32_32x32x16_bf16(af0[ks], bfr[ks], a0, 0, 0, 0);
        a1 = __builtin_amdgcn_mfma_f32_32x32x16_bf16(af1[ks], bfr[ks], a1, 0, 0, 0);
    }
    const int tok = b * SEQ + 128 * c + 32 * tb + t;
    const float bs = bias[g * 128 + 32 * tb + t];
    const bf16* up = CU + (size_t)tok * 256 + 64 * g + 4 * hf;
    bf16* yp = Y + (size_t)tok * DM + 768 + 64 * g + 4 * hf;
#pragma unroll
    for (int gg = 0; gg < 4; ++gg) {
        const v2u u0 = *(const v2u*)(up + 8 * gg), u1 = *(const v2u*)(up + 32 + 8 * gg);
        v2u a; a.x = pk2(bflo(u0.x) * (a0[4 * gg] + bs), bfhi(u0.x) * (a0[4 * gg + 1] + bs)); a.y = pk2(bflo(u0.y) * (a0[4 * gg + 2] + bs), bfhi(u0.y) * (a0[4 * gg + 3] + bs)); *(v2u*)(yp + 8 * gg) = a;
        v2u d; d.x = pk2(bflo(u1.x) * (a1[4 * gg] + bs), bfhi(u1.x) * (a1[4 * gg + 1] + bs)); d.y = pk2(bflo(u1.y) * (a1[4 * gg + 2] + bs), bfhi(u1.y) * (a1[4 * gg + 3] + bs)); *(v2u*)(yp + 32 + 8 * gg) = d;
    }
}
__device__ __forceinline__ void unpack8(const v4u w, float (&f)[8]) { f[0] = bflo(w.x); f[1] = bfhi(w.x); f[2] = bflo(w.y); f[3] = bfhi(w.y); f[4] = bflo(w.z); f[5] = bfhi(w.z); f[6] = bflo(w.w); f[7] = bfhi(w.w); }
__device__ __forceinline__ void conv_task(const bf16* CONV, const float* cwt, bf16* Y, int task, int lane) {
    const int ch = (lane & 31) * 8;
    float w0[8], w1[8], w2[8];
#pragma unroll
    for (int e = 0; e < 8; ++e) { w0[e] = cwt[ch + e]; w1[e] = cwt[256 + ch + e]; w2[e] = cwt[512 + ch + e]; }
    const bf16* ab = CONV; const bf16* ac = CONV + (size_t)SEQ * 256; const bf16* ah = CONV + (size_t)2 * SEQ * 256;
#pragma unroll
    for (int it = 0; it < 4; ++it) {
        const int tok = task * 8 + it * 2 + (lane >> 5), s = tok & (SEQ - 1);
        const size_t o = (size_t)tok * 256 + ch;
        float fb[8], c0[8], h0[8], c1[8], h1[8], c2[8], h2[8];
        unpack8(*(const v4u*)(ab + o), fb); unpack8(*(const v4u*)(ac + o), c0); unpack8(*(const v4u*)(ah + o), h0);
        const v4u zz = (v4u){0u, 0u, 0u, 0u};
        unpack8(s >= 1 ? *(const v4u*)(ac + o - 256) : zz, c1); unpack8(s >= 1 ? *(const v4u*)(ah + o - 256) : zz, h1);
        unpack8(s >= 2 ? *(const v4u*)(ac + o - 512) : zz, c2); unpack8(s >= 2 ? *(const v4u*)(ah + o - 512) : zz, h2);
        float y[8];
#pragma unroll
        for (int e = 0; e < 8; ++e) y[e] = fb[e] * (w2[e] * (c0[e] * h0[e]) + w1[e] * (c1[e] * h1[e]) + w0[e] * (c2[e] * h2[e]));
        v4u w; w.x = pk2(y[0], y[1]); w.y = pk2(y[2], y[3]); w.z = pk2(y[4], y[5]); w.w = pk2(y[6], y[7]);
        *(v4u*)(Y + (size_t)tok * DM + ch) = w;
    }
}

#define RLX_AGENT __ATOMIC_RELAXED, __HIP_MEMORY_SCOPE_AGENT
#define XB_TMO      128
#define XB_XCNT(j)  (256  + 64 * (j))
#define XB_XSUB(j)  (1280 + 64 * (j))
#define XB_XGEN(j)  (2304 + 64 * (j))
#define XB_TOP      3328
#define XB_TOPGEN   3392
#define XCD_BAR_WORDS 3456
#define XB_SPIN_CAP (1u << 18)

__device__ __forceinline__ unsigned xb_ld(unsigned* p)              { return __hip_atomic_load(p, __ATOMIC_RELAXED, __HIP_MEMORY_SCOPE_AGENT); }
__device__ __forceinline__ unsigned xb_add(unsigned* p, unsigned v) { return __hip_atomic_fetch_add(p, v, __ATOMIC_RELAXED, __HIP_MEMORY_SCOPE_AGENT); }
__device__ __forceinline__ unsigned xb_xcc_id() { return (unsigned)__builtin_amdgcn_s_getreg((3 << 11) | 20) & 0xFu; }
#define XB_SPIN(cond, bar) do { unsigned _sp = 0; while (cond) { __builtin_amdgcn_s_sleep(1); \
    if ((++_sp & 255u) == 0u) { if (xb_ld(&(bar)[XB_TMO])) break; if (_sp > XB_SPIN_CAP) { atomicAdd(&(bar)[XB_TMO], 1u); break; } } } } while (0)

struct XcdBarrier {
    int wave;
    unsigned* bar; unsigned x;
    volatile LAS unsigned* st;
};

__device__ __forceinline__ XcdBarrier xcd_barrier_post(unsigned* bar, volatile LAS unsigned* st) {
    XcdBarrier b; b.bar = bar; b.x = xb_xcc_id(); b.st = st;
    if (threadIdx.x == 0) (void)xb_add(&bar[XB_XCNT(b.x)], 1u);
    return b;
}
__device__ __forceinline__ void xcd_barrier_complete(unsigned* bar, unsigned x, unsigned& nloc, unsigned& nx) {
    const unsigned G = gridDim.x * gridDim.y * gridDim.z;
    unsigned sum, cnt, mine, sp = 0u;
    for (;;) {
        sum = 0u; cnt = 0u; mine = 0u;
#pragma unroll
        for (unsigned j = 0; j < 16; ++j) { const unsigned c = xb_ld(&bar[XB_XCNT(j)]); sum += c; cnt += (c > 0u) ? 1u : 0u; mine = (j == x) ? c : mine; }
        if (sum == G) break;
        __builtin_amdgcn_s_sleep(1);
        if ((++sp & 255u) == 0u) { if (xb_ld(&bar[XB_TMO])) break; if (sp > XB_SPIN_CAP) { atomicAdd(&bar[XB_TMO], 1u); break; } }
    }
    nloc = mine > 0u ? mine : 1u; nx = cnt > 0u ? cnt : 1u;
}

__device__ __forceinline__ void xcd_barrier(const XcdBarrier& b, bool local_seam) {
    asm volatile("s_waitcnt vmcnt(0)" ::: "memory");
    __syncthreads();
    if (b.wave == 0 && __builtin_amdgcn_mbcnt_hi(~0u, __builtin_amdgcn_mbcnt_lo(~0u, 0u)) == 0u) {
        unsigned* bar = b.bar;
        __builtin_amdgcn_s_waitcnt(0);
        unsigned nloc = b.st[0], nx = b.st[1];
        if (nloc == 0u) { xcd_barrier_complete(bar, b.x, nloc, nx); b.st[0] = nloc; b.st[1] = nx; }
        const unsigned old = xb_add(&bar[XB_XSUB(b.x)], 1u);
        const unsigned gen = old / nloc;
        const bool local = local_seam && (b.st[2] != 0u);
        if (old + 1u == (gen + 1u) * nloc) {
            if (!local) {
            __builtin_amdgcn_fence(__ATOMIC_RELEASE, "agent");
            asm volatile("s_waitcnt vmcnt(0)" ::: "memory");
            const unsigned og = xb_add(&bar[XB_TOP], 1u);
            const unsigned tg = og / nx;
            if (og + 1u == (tg + 1u) * nx) xb_add(&bar[XB_TOPGEN], 1u);
            else XB_SPIN(xb_ld(&bar[XB_TOPGEN]) == tg, bar);
            }
            __builtin_amdgcn_fence(__ATOMIC_ACQUIRE, "agent");
            xb_add(&bar[XB_XGEN(b.x)], 1u);
            asm volatile("s_waitcnt vmcnt(0)" ::: "memory");
        } else {
            XB_SPIN(xb_ld(&bar[XB_XGEN(b.x)]) == gen, bar);
            __builtin_amdgcn_fence(__ATOMIC_ACQUIRE, "agent");
            asm volatile("s_waitcnt vmcnt(0)" ::: "memory");
        }
    }
    __syncthreads();
}

struct Args { const float* in[17]; float* out; unsigned char* ws; int ph_lo, ph_hi; };
__global__ void __launch_bounds__(NWAVES * 64, 2) mk_fwd(Args a) {
    extern __shared__ __attribute__((aligned(16))) unsigned char lds_raw[];
    LAS unsigned char* lds = (LAS unsigned char*)lds_raw;
    const int tid = threadIdx.x, lane = tid & 63, wave = __builtin_amdgcn_readfirstlane(tid >> 6);
    const int G = gridDim.x; const int bx = blockIdx.x; const int vcu = (G % 8 == 0) ? (bx % 8) * (G / 8) + bx / 8 : bx;
    const int gw = vcu * NWAVES + wave, NGW = G * NWAVES;
    const int lo = a.ph_lo, hi = a.ph_hi;
    volatile LAS unsigned* bst = (volatile LAS unsigned*)(lds + RING_BYTES);
    if (tid < 4) bst[tid] = 0u;
    __syncthreads();
    XcdBarrier bar = xcd_barrier_post((unsigned*)(a.ws + WS_CTL), bst);
    bar.wave = wave;
    unsigned* xcctab = (unsigned*)(a.ws + WS_CTL) + XCD_BAR_WORDS;
    if (tid == 0) __hip_atomic_store(xcctab + bx, bar.x + 1u, __ATOMIC_RELAXED, __HIP_MEMORY_SCOPE_AGENT);
    unsigned char* ws = a.ws;
    const float* x = a.in[0]; const float* p = a.in[1];
    bf16* Wb = (bf16*)(ws + WS_W); bf16* WSBb = (bf16*)(ws + WS_WSB); float* SS = (float*)(ws + WS_SS);
    bf16* HB = (bf16*)(ws + WS_HB); bf16* LO = (bf16*)(ws + WS_LO); bf16* XB = (bf16*)(ws + WS_XB);
    unsigned char* big = ws + WS_BIG;
    bf16* BG = (bf16*)big;
    bf16* CONV = BG + O_CONV; bf16* Qb = BG + O_Q; bf16* Kb = BG + O_K; bf16* VTb = BG + O_VT; bf16* CUb = BG + O_CU; bf16* VNTb = BG + O_VNT; bf16* Yb = BG + O_Y; bf16* PBb = BG + O_PB; bf16* Fb = BG;
    LAS float* rstab = (LAS float*)(lds + RS_OFF);
    const int pm_blk = 8 * (bx & 7) + ((bx >> 3) & 7);
#define tid_now() (wave * 64 + (int)__builtin_amdgcn_mbcnt_hi(~0u, __builtin_amdgcn_mbcnt_lo(~0u, 0u)))
    const size_t bo_blk = (size_t)(bx & 7) * SLAB_E;
    float* H = a.out;
#define IN(k) (lo <= (k) && (k) < hi)
#define SEAM(k, loc) do { if (IN(k) && IN((k) + 1)) { if (a.ph_lo < 0) cg::this_grid().sync(); for (int sr_ = 0; sr_ < PROBE_SYNC; ++sr_) xcd_barrier(bar, loc); } } while (0)

    if (IN(0)) for (int rep_ = 0; rep_ < PROBE_P; ++rep_) {
        LAS float* scr = (LAS float*)(lds + wave * 16384);
        constexpr int I_IN = (DM / 64) * (NIN / 32), I_OUT = (DM / 64) * (DM / 32), I_1 = (DM / 64) * (DFF / 32), I_2 = (DFF / 64) * (DM / 32), I_G = I_OUT, I_P = (PLE / 64) * (DM / 32);
        constexpr int I_LAYER = I_IN + I_OUT + I_1 + I_2 + I_G + I_P;
#define TR_DECODE(J, IT) do { const int l_ = (IT) / I_LAYER; int r_ = (IT) % I_LAYER; bf16* wl_ = Wb + (size_t)l_ * E_WLAYER; \
            if (r_ < I_IN) { J = TrJob{a.in[3] + (size_t)l_ * DM * NIN, wl_ + E_WIN, a.in[2] + l_ * DM, DM, NIN, r_, 1}; } \
            else if ((r_ -= I_IN) < I_OUT) { J = TrJob{a.in[10] + (size_t)l_ * DM * DM, wl_ + E_WOUT, nullptr, DM, DM, r_, 0}; } \
            else if ((r_ -= I_OUT) < I_1) { J = TrJob{a.in[12] + (size_t)l_ * DM * DFF, wl_ + E_W1, a.in[11] + l_ * DM, DM, DFF, r_, 0}; } \
            else if ((r_ -= I_1) < I_2) { J = TrJob{a.in[13] + (size_t)l_ * DFF * DM, wl_ + E_W2, nullptr, DFF, DM, r_, 0}; } \
            else if ((r_ -= I_2) < I_G) { J = TrJob{a.in[15] + (size_t)l_ * DM * DM, wl_ + E_WG, a.in[14] + l_ * DM, DM, DM, r_, 0}; } \
            else { r_ -= I_G; J = TrJob{a.in[16] + (size_t)l_ * PLE * DM, wl_ + E_WP, nullptr, PLE, DM, r_, 0}; } } while (0)
        for (int it = gw; it < DEPTH * I_LAYER; it += 2 * NGW) {
            const int it2 = it + NGW; const bool has2 = it2 < DEPTH * I_LAYER;
            TrJob j1, j2; f32x4 v1[8], v2[8];
            TR_DECODE(j1, it); tr_load(j1, lane, v1);
            if (has2) { TR_DECODE(j2, it2); tr_load(j2, lane, v2); }
            tr_finish(j1, lane, v1, scr);
            if (has2) tr_finish(j2, lane, v2, scr);
        }
#undef TR_DECODE
        for (int i = gw * 64 + lane; i < DEPTH * 4 * 128 * 128; i += NGW * 64) {
            const int e8 = i & 7, ln = (i >> 3) & 63, ks = (i >> 9) & 7, tb = (i >> 12) & 3, lg = i >> 14; const int t = 32 * tb + (ln & 31), sk = 16 * ks + 8 * (ln >> 5) + e8;
            WSBb[i] = (bf16)f2bf(sk <= t ? a.in[8][((size_t)lg * 128 + t) * 128 + sk] : 0.f); }
        for (int m0 = gw; m0 < M; m0 += 2 * NGW) {
            f32x4 v[2][4]; float sq[2];
#pragma unroll
            for (int q = 0; q < 2; ++q) { const int m = m0 + q * NGW; sq[q] = 0.f; if (m < M) { const f32x4* xr = (const f32x4*)(x + (size_t)m * DM) + lane;
#pragma unroll
                for (int j = 0; j < 4; ++j) v[q][j] = xr[64 * j]; } }
#pragma unroll
            for (int q = 0; q < 2; ++q) { const int m = m0 + q * NGW; if (m < M) {
                float sacc = 0.f;
#pragma unroll
                for (int j = 0; j < 4; ++j) sacc += (v[q][j].x * v[q][j].x + v[q][j].y * v[q][j].y) + (v[q][j].z * v[q][j].z + v[q][j].w * v[q][j].w);
                sq[q] = wave_sum(sacc);
                v2u* o8 = (v2u*)(XB + (size_t)m * DM) + lane; v2u* l8 = (v2u*)(LO + (size_t)m * DM) + lane;
#pragma unroll
                for (int j = 0; j < 4; ++j) { v2u w; w.x = pk2(v[q][j].x, v[q][j].y); w.y = pk2(v[q][j].z, v[q][j].w); o8[64 * j] = w;
                    v2u d; d.x = pk2(v[q][j].x - bflo(w.x), v[q][j].y - bfhi(w.x)); d.y = pk2(v[q][j].z - bflo(w.y), v[q][j].w - bfhi(w.y)); l8[64 * j] = d; }
                if (lane < 16) SS[(size_t)m * 16 + lane] = lane == 0 ? sq[q] : 0.f; } }
        }
        for (int it = gw; it < M * PLE / 512; it += NGW) { const size_t o = (size_t)it * 512 + lane * 8; const f32x4 u0 = *(const f32x4*)(p + o), u1 = *(const f32x4*)(p + o + 4);
            v4u w; w.x = pk2(u0.x, u0.y); w.y = pk2(u0.z, u0.w); w.z = pk2(u1.x, u1.y); w.w = pk2(u1.z, u1.w); *(v4u*)(PBb + (size_t)(it >> 10) * SLAB_E + (o & (size_t)(SEQ * PLE - 1))) = w; }
        asm volatile("s_waitcnt vmcnt(0) lgkmcnt(0)" ::: "memory"); __syncthreads();
    }
    SEAM(0, false);
    if (lo == 0 && hi == NPHASE) {
        if (wave == 0) {
            bool ok = (G == 256);
            for (int i = lane; i < G; i += 64) { const unsigned me = __hip_atomic_load(xcctab + i, __ATOMIC_RELAXED, __HIP_MEMORY_SCOPE_AGENT), first = __hip_atomic_load(xcctab + (i & 7), __ATOMIC_RELAXED, __HIP_MEMORY_SCOPE_AGENT);
                ok = ok && (me != 0u) && (me == first); }
            const bool all_ok = __all(ok);
            if (lane == 0) bst[2] = all_ok ? 1u : 0u;
        }
        __syncthreads();
#ifdef PROBE_FAST
        if (bst[2] == 0u) { if (tid == 0) { const unsigned long long t0 = __builtin_amdgcn_s_memrealtime(); while (__builtin_amdgcn_s_memrealtime() - t0 < 40000ull) __builtin_amdgcn_s_sleep(8); } __syncthreads(); }
#endif
    }

    for (int l = 0; l < DEPTH; ++l) {
        const int pb = 1 + 6 * l;
        const bf16* wl = Wb + (size_t)l * E_WLAYER;
        bf16* bufX = (l & 1) ? HB : XB; bf16* bufT = (l & 1) ? XB : HB;
        float* ss1 = SS; float* ss2 = SS + (size_t)M * 16; float* ss3 = SS + (size_t)2 * M * 16; float* ss1n = ss1;
        if (IN(pb)) for (int rep_ = 0; rep_ < PROBE_A; ++rep_) {
#ifndef NO_A
            { pg8::Gemm g{bufX, wl + E_WIN, M, NIN, DM}; pg8::StaticOrder S; S.init(M, NIN, G, bx);
              fill_rs_table(rstab, ss1, pm_blk, 1.f, tid_now());
              EpiInProj E{rstab, CONV, Qb, Kb, VTb, CUb, VNTb, a.in[5] + l * 64, a.in[6] + l * 64, a.in[7] + l * 256};
              pg8::gemm_phase<EpiInProj, pg8::StaticOrder, true, true>(lds, g, S, E, wave); }
            { int kp = PLE; asm volatile("" : "+s"(kp)); pg8::Gemm g{PBb + bo_blk - (size_t)(8 * (bx & 7)) * 256 * PLE, wl + E_WP, M, DM, kp};     TSched S{bx, (M / 256 * (NIN / 256)) % G, G};
              EpiT E{bufT};
              pg8::gemm_phase<EpiT, TSched, true, true>(lds, g, S, E, wave); }
#endif
        }
        SEAM(pb, true);
        if (IN(pb + 1)) for (int rep_ = 0; rep_ < PROBE_B; ++rep_) {
            int lane_ = (int)__builtin_amdgcn_mbcnt_hi(~0u, __builtin_amdgcn_mbcnt_lo(~0u, 0u)); asm volatile("" : "+v"(lane_));
#pragma unroll 1
            for (int part = 0; part < 2; ++part) {
            if ((part == 0) == (wave < 4)) {
#ifndef NO_ATT
            for (int ra_ = 0; ra_ < PROBE_ATT; ++ra_)
            for (int pr = gw; pr < 2048; pr += NGW) { const int bh = pr >> 5, i = pr & 31;
                const size_t bo = (size_t)(bh >> 3) * SLAB_E;
                attn_task(Qb + bo, Kb + bo, VTb + bo, Yb + bo, 0, bh & 7, 63 - i, lane_);
                attn_task(Qb + bo, Kb + bo, VTb + bo, Yb + bo, 0, bh & 7, i, lane_); }
#endif
            } else {
#ifndef NO_SGU
            for (int tk = gw; tk < 2048; tk += NGW) { const size_t bo = (size_t)(tk >> 8) * SLAB_E; sgu_task(VNTb + bo, WSBb + (size_t)l * 4 * 128 * 128, CUb + bo, a.in[9] + l * 512, Yb + bo, tk & 255, lane_); }
#endif
#ifndef NO_CONV
            for (int tk = gw; tk < 2048; tk += NGW) { const size_t bo = (size_t)(tk >> 8) * SLAB_E; conv_task(CONV + bo, a.in[4] + l * 768, Yb + bo, tk & 255, lane_); }
#endif
            }
            }
            asm volatile("s_waitcnt vmcnt(0) lgkmcnt(0)" ::: "memory"); __syncthreads();
        }
        SEAM(pb + 1, true);
        if (IN(pb + 2)) {
#ifndef NO_C
#ifndef NO_O
            { pg8::Gemm g{Yb + bo_blk - (size_t)(8 * (bx & 7)) * 256 * DM, wl + E_WOUT, M, DM, DM}; pg8::StaticOrder S; S.init(M, DM, G, bx);
              EpiRes E{bufX, LO, ss2, l == 0 ? 1 : 0, 0};
              pg8::gemm_phase<EpiRes, pg8::StaticOrder, true, true>(lds, g, S, E, wave); }
#endif
#endif
        }
        SEAM(pb + 2, true);
        if (IN(pb + 3)) for (int rep_ = 0; rep_ < PROBE_D; ++rep_) {
#ifndef NO_D
            pg8::Gemm g{bufX, wl + E_W1, M, DFF, DM}; pg8::StaticOrder S; S.init(M, DFF, G, bx);
            fill_rs_table(rstab, ss2, pm_blk, 1.f, tid_now());
            EpiFF1 E{rstab, Fb};
            pg8::gemm_phase<EpiFF1, pg8::StaticOrder, true, true>(lds, g, S, E, wave);
#endif
        }
        SEAM(pb + 3, true);
        if (IN(pb + 4)) {
#ifndef NO_E
            pg8::Gemm g{Fb, wl + E_W2, M, DM, DFF}; pg8::StaticOrder S; S.init(M, DM, G, bx);
            EpiRes E{bufX, LO, ss3, 0, l == DEPTH - 1 ? 1 : 0};
            pg8::gemm_phase<EpiRes, pg8::StaticOrder, true, true>(lds, g, S, E, wave);
#endif
        }
        SEAM(pb + 4, true);
        if (IN(pb + 5)) {
            if (l + 1 < DEPTH) {
                const float* pl = p + (size_t)(l + 1) * M * PLE;
#pragma unroll 4
                for (int t_ = gw; t_ < M * PLE / 512; t_ += NGW) { const int it = ((t_ >> 8) & 7) * 1024 + (t_ >> 11) * 256 + (t_ & 255);
                    const size_t o = (size_t)it * 512 + lane * 8; const f32x4 u0 = *(const f32x4*)(pl + o), u1 = *(const f32x4*)(pl + o + 4);
                    v4u w; w.x = pk2(u0.x, u0.y); w.y = pk2(u0.z, u0.w); w.z = pk2(u1.x, u1.y); w.w = pk2(u1.z, u1.w); *(v4u*)(PBb + (size_t)(it >> 10) * SLAB_E + (o & (size_t)(SEQ * PLE - 1))) = w; }
            }
#ifndef NO_F
            pg8::Gemm g{bufX, wl + E_WG, M, DM, DM}; pg8::StaticOrder S; S.init(M, DM, G, bx);
            fill_rs_table(rstab, ss3, pm_blk, -1.4426950408889634f, tid_now());
            EpiGate E{rstab, bufX, LO, bufT, ss1n, l == DEPTH - 1 ? H : (float*)nullptr, l == DEPTH - 1 ? 1 : 0};
            pg8::gemm_phase<EpiGate, pg8::StaticOrder, true, true>(lds, g, S, E, wave);
#endif
        }
        SEAM(pb + 5, true);
    }
#undef IN
#undef SEAM
}

extern "C" void kernel_launch(void* const* d_in, const int* in_sizes, int n_in, void* d_out, int out_size, void* d_ws, size_t ws_size, hipStream_t stream) {
    static int grid = 0;
    if (grid == 0) {
        if (n_in != 17 || in_sizes[0] != M * DM || out_size != M * DM || ws_size < WS_TOTAL) { fprintf(stderr, "kernel_launch: unexpected shapes (n_in %d, in0 %d, out %d, ws %zu, need %zu)\n", n_in, n_in > 0 ? in_sizes[0] : -1, out_size, ws_size, (size_t)WS_TOTAL); grid = -1; return; }
        int dev = 0, cus = 0, per_cu = 0;
        hipGetDevice(&dev); hipDeviceGetAttribute(&cus, hipDeviceAttributeMultiprocessorCount, dev);
        if (hipFuncSetAttribute((const void*)mk_fwd, hipFuncAttributeMaxDynamicSharedMemorySize, LDS_BYTES) != hipSuccess) { fprintf(stderr, "kernel_launch: hipFuncSetAttribute failed\n"); grid = -1; return; }
        if (hipOccupancyMaxActiveBlocksPerMultiprocessor(&per_cu, (const void*)mk_fwd, NWAVES * 64, LDS_BYTES) != hipSuccess || per_cu < 1) { fprintf(stderr, "kernel_launch: occupancy query says %d\n", per_cu); per_cu = 1; }
        (void)hipGetLastError();
        grid = cus * 1;
        if (grid != 256) { fprintf(stderr, "kernel_launch: this kernel's per-batch-element workspace layout needs a 256-workgroup grid (256 CUs); found %d CUs\n", cus); grid = -1; return; }
    }
    if (grid < 0) return;
#ifdef DBG_MEMSET
    (void)hipMemsetAsync(d_ws, 0xAA, WS_END, stream); (void)hipMemsetAsync(d_out, 0xAA, (size_t)M * DM * 4, stream);
#endif
    if (hipMemsetAsync((char*)d_ws + WS_CTL, 0, CTL_BYTES, stream) != hipSuccess) { fprintf(stderr, "kernel_launch: memset of the barrier words failed\n"); return; }
    Args a{};
    for (int i = 0; i < 17; ++i) a.in[i] = (const float*)d_in[i];
    a.out = (float*)d_out; a.ws = (unsigned char*)d_ws;
#if MK_N_LAUNCHES == 1
    a.ph_lo = 0; a.ph_hi = NPHASE;
    void* args[] = {&a};
    hipError_t e = hipLaunchCooperativeKernel((const void*)mk_fwd, dim3(grid), dim3(NWAVES * 64), args, LDS_BYTES, stream);
    if (e != hipSuccess) fprintf(stderr, "cooperative launch failed: %s (grid %d)\n", hipGetErrorString(e), grid);
#else
    for (int ph = 0; ph < NPHASE; ++ph) { a.ph_lo = ph; a.ph_hi = ph + 1; hipLaunchKernelGGL(mk_fwd, dim3(grid), dim3(NWAVES * 64), LDS_BYTES, stream, a); }
#endif
}
```
